# Optimizing an MI355X kernel written in HIP

```python
import math
import jax
import jax.numpy as jnp
from jax import lax
import numpy as np


D_MODEL = 2048
BATCH = 16
SEQ = 2048
DEPTH = 1

GRID_W = 64
CTX_LEN = 256
HY_WIDTH = D_MODEL // 2
RW_WIDTH = D_MODEL - HY_WIDTH
HY_GROUP = 64
RW_HEAD = 64
RW_HEADS = RW_WIDTH // RW_HEAD
PROJ_WIDTH = 3 * HY_WIDTH + 3 * RW_WIDTH
FILTER_BANDS = 16
FILTER_EMB = 2 * FILTER_BANDS + 1
FILTER_WIDTH = 64
FILTER_TARGET = 1e-2
FAST_DECAY_PCT = 0.3
SLOW_DECAY_PCT = 1.5
DECAY_LORA = 64
ICLR_LORA = 64
GATE_LORA = 128
N_EXPERTS = 32
TOP_K = 4
D_FF = D_MODEL
SWIGLU_LIMIT = 7.0
SWIGLU_ALPHA = 1.702
EXPERT_BLOCK = 128
NORM_EPS = 1e-6
LNX_EPS = 64e-5

kernel_name = 'hyena_rwkv7_moe_prefix_dit_block'


def rmsnorm(x, g):
    xf = x.astype(jnp.float32)
    y = xf * lax.rsqrt(jnp.mean(xf * xf, axis=-1, keepdims=True) + NORM_EPS)
    return (y * g).astype(x.dtype)


def modulate(h, shift, scale):
    return h * (1 + scale) + shift


def short_conv(z, w, b):
    zp = jnp.pad(z, ((0, 0), (1, 1), (0, 0)))
    return zp[:, :-2] * w[0] + zp[:, 1:-1] * w[1] + zp[:, 2:] * w[2] + b


def group_rmsnorm(y, g, group):
    b_, l_, ch = y.shape
    yf = y.astype(jnp.float32).reshape(b_, l_, ch // group, group)
    yf = yf * lax.rsqrt(jnp.mean(yf * yf, axis=-1, keepdims=True) + NORM_EPS)
    return (yf.reshape(b_, l_, ch) * g).astype(y.dtype)


def both_dirs(a):
    return jnp.stack([a, a[:, ::-1]])


def orient(a):
    return jnp.stack([a[0], a[1][:, ::-1]])


def hyena_filter(length, w1, b1, w2, b2, w3, b3, freq, w4):
    t = jnp.linspace(0.0, 1.0, length, dtype=jnp.float32)[:, None]
    ang = (2.0 * math.pi / length) * jnp.arange(length, dtype=jnp.float32)[:, None]
    bands = jnp.linspace(1e-4, FILTER_BANDS - 1, FILTER_BANDS, dtype=jnp.float32)[None, :]
    feats = jnp.concatenate([t, jnp.cos(bands * ang), -jnp.sin(bands * ang)], axis=-1)
    h = jnp.sin(freq * (feats @ w1 + b1))
    h = jnp.sin(freq * (h @ w2 + b2))
    h = jnp.sin(freq * (h @ w3 + b3))
    h = (h @ w4).astype(jnp.float32)
    deltas = jnp.abs(jnp.linspace(math.log(FILTER_TARGET) / SLOW_DECAY_PCT,
                                  math.log(FILTER_TARGET) / FAST_DECAY_PCT, HY_WIDTH, dtype=jnp.float32))
    h = h * jnp.exp(-t * jnp.tile(deltas, 2))
    return h[:, :HY_WIDTH], h[:, HY_WIDTH:]


def long_conv(u, h_fwd, h_bwd):
    length, ch = h_fwd.shape
    taps = jnp.concatenate([h_fwd, jnp.zeros((1, ch), h_fwd.dtype), h_bwd[:0:-1]], axis=0)
    u_f = jnp.fft.rfft(u.astype(jnp.float32), n=2 * length, axis=1)
    t_f = jnp.fft.rfft(taps, n=2 * length, axis=0)
    return jnp.fft.irfft(u_f * t_f[None], n=2 * length, axis=1)[:, :length].astype(u.dtype)


def hyena_mixer(z, w1, b1, w2, b2, w3, b3, freq, w4, bias, norm_g):
    x0, x1, v = jnp.split(z, 3, axis=-1)
    h_fwd, h_bwd = hyena_filter(z.shape[1], w1, b1, w2, b2, w3, b3, freq, w4)
    u = v * x1
    y = x0 * (long_conv(u, h_fwd, h_bwd) + bias * u)
    return group_rmsnorm(y, norm_g, HY_GROUP)


def rwkv7_prep(z, h, w0, w1, w2, a0, a1, a2, k_k, k_a, r_k):
    b_, l_, _ = z.shape
    r, k, v = jnp.split(z, 3, axis=-1)
    heads = lambda t: t.reshape(*t.shape[:-1], RW_HEADS, RW_HEAD)
    kk = heads((k * k_k).astype(jnp.float32))
    kk = (kk / jnp.maximum(jnp.linalg.norm(kk, axis=-1, keepdims=True), 1e-12)).reshape(b_, l_, RW_WIDTH)
    w_log = -jax.nn.softplus(-(w0[:, None, None, :] + jnp.einsum(
        'nblr,nrc->nblc', jnp.tanh(jnp.einsum('bld,ndr->nblr', h, w1)), w2))) - 0.5
    decay = jnp.exp(-jnp.exp(w_log.astype(jnp.float32)))
    a = jax.nn.sigmoid(a0[:, None, None, :] + jnp.einsum(
        'nblr,nrc->nblc', jnp.einsum('bld,ndr->nblr', h, a1), a2))
    k_dir = k * (1 + (a - 1) * k_a)
    bonus = jnp.sum(heads(r * k_dir) * r_k, axis=-1, keepdims=True) * heads(v)
    bonus = jnp.sum(bonus, axis=0).reshape(b_, l_, RW_WIDTH)
    scan_in = (both_dirs(r), orient(decay), orient(k_dir), both_dirs(v), both_dirs(-kk), orient(kk * a))
    return scan_in, bonus


def rwkv7_scan(r, decay, k, v, aa, bb, s0):
    out_shape = r.shape

    def tm(t):
        return jnp.moveaxis(t.astype(jnp.float32).reshape(*t.shape[:3], RW_HEADS, RW_HEAD), 2, 0)

    def step(s, inp):
        r_t, w_t, k_t, v_t, a_t, b_t = inp
        sa = jnp.einsum('nbhvk,nbhk->nbhv', s, a_t)
        s = s * w_t[..., None, :] + sa[..., :, None] * b_t[..., None, :] + v_t[..., :, None] * k_t[..., None, :]
        return s, jnp.einsum('nbhvk,nbhk->nbhv', s, r_t)

    s_fin, ys = lax.scan(step, s0, (tm(r), tm(decay), tm(k), tm(v), tm(aa), tm(bb)))
    return jnp.moveaxis(ys, 0, 2).reshape(out_shape), s_fin


def rwkv7_out(ys, bonus, h, g1, g2, lnx_g, lnx_b):
    ys = orient(ys)
    b_, l_, _ = h.shape
    y = (ys[0] + ys[1]).reshape(b_, l_, RW_HEADS, RW_HEAD)
    mu = jnp.mean(y, axis=-1, keepdims=True)
    var = jnp.mean(jnp.square(y - mu), axis=-1, keepdims=True)
    y = ((y - mu) * lax.rsqrt(var + LNX_EPS)).reshape(b_, l_, RW_WIDTH) * lnx_g + lnx_b
    gate = jax.nn.sigmoid(h @ g1) @ g2
    return ((y + bonus) * gate).astype(h.dtype)


def token_mixer(hx, hc, in_w, conv_w, conv_b, hy, rw_pre, rw_post, out_w, need_ctx):
    n_hy = 3 * HY_WIDTH
    zx = short_conv(hx @ in_w, conv_w, conv_b)
    zc = short_conv(hc @ in_w, conv_w, conv_b)
    s0 = jnp.zeros((2, hc.shape[0], RW_HEADS, RW_HEAD, RW_HEAD), jnp.float32)
    ins_c, bonus_c = rwkv7_prep(zc[..., n_hy:], hc, *rw_pre)
    ys_c, s_ctx = rwkv7_scan(*ins_c, s0)
    ins_x, bonus_x = rwkv7_prep(zx[..., n_hy:], hx, *rw_pre)
    ys_x, _ = rwkv7_scan(*ins_x, s_ctx)
    y_x = jnp.concatenate([hyena_mixer(zx[..., :n_hy], *hy),
                           rwkv7_out(ys_x, bonus_x, hx, *rw_post)], axis=-1) @ out_w
    if not need_ctx:
        return y_x, None
    y_c = jnp.concatenate([hyena_mixer(zc[..., :n_hy], *hy),
                           rwkv7_out(ys_c, bonus_c, hc, *rw_post)], axis=-1) @ out_w
    return y_x, y_c


def moe_ffn(h, router_w, router_b, w_gate, b_gate, w_up, b_up, w_down, b_down):
    b_, l_, d_ = h.shape
    t = h.reshape(b_ * l_, d_)
    n_tok = t.shape[0]
    logits = (t @ router_w + router_b).astype(jnp.float32)
    top_logits, top_idx = lax.top_k(logits, TOP_K)
    gates = jax.nn.softmax(top_logits, axis=-1).astype(h.dtype)
    n_asg = n_tok * TOP_K
    e_flat = top_idx.reshape(n_asg)
    order = jnp.argsort(e_flat)
    e_sorted = e_flat[order]
    tok_sorted = (order // TOP_K).astype(jnp.int32)
    gate_sorted = gates.reshape(n_asg)[order]
    counts = jnp.bincount(e_flat, length=N_EXPERTS)
    padded = (counts + EXPERT_BLOCK - 1) // EXPERT_BLOCK * EXPERT_BLOCK
    pad_end = jnp.cumsum(padded)
    pad_start = pad_end - padded
    raw_start = jnp.cumsum(counts) - counts
    dest = pad_start[e_sorted] + jnp.arange(n_asg) - raw_start[e_sorted]
    n_blocks = -(-n_asg // EXPERT_BLOCK) + N_EXPERTS
    n_rows = n_blocks * EXPERT_BLOCK
    row_tok = jnp.zeros((n_rows,), jnp.int32).at[dest].set(tok_sorted)
    row_gate = jnp.zeros((n_rows,), h.dtype).at[dest].set(gate_sorted)
    block_expert = jnp.minimum(
        jnp.searchsorted(pad_end, jnp.arange(n_blocks) * EXPERT_BLOCK, side='right'), N_EXPERTS - 1)

    def expert_block(args):
        rows, e = args
        xb = t[rows]
        g = jnp.minimum(xb @ w_gate[e] + b_gate[e], SWIGLU_LIMIT)
        u = jnp.clip(xb @ w_up[e] + b_up[e], -SWIGLU_LIMIT, SWIGLU_LIMIT)
        return ((u + 1) * (g * jax.nn.sigmoid(SWIGLU_ALPHA * g))) @ w_down[e] + b_down[e]

    y = lax.map(expert_block, (row_tok.reshape(n_blocks, EXPERT_BLOCK), block_expert))
    y = y.reshape(n_rows, d_) * row_gate[:, None]
    return jax.ops.segment_sum(y, row_tok, num_segments=n_tok).reshape(b_, l_, d_)


def setup_inputs(seed: int = 0) -> dict:
    key = jax.random.key(seed)
    ks = iter(jax.random.split(key, 48))

    def nrm(shape, scale):
        return scale * jax.random.normal(next(ks), shape, jnp.float32)

    nl, d, e, f = DEPTH, D_MODEL, N_EXPERTS, D_FF
    conv_base = jnp.array([0.25, 0.5, 0.25], jnp.float32)[None, :, None]
    return {
        'x': nrm((BATCH, SEQ, d), 1.0),
        'c': nrm((BATCH, d), 1.0),
        'ctx': nrm((BATCH, CTX_LEN, d), 1.0),
        'c_ctx': nrm((d,), 1.0),
        'ada_w': nrm((nl, d, 6 * d), 0.5 * d ** -0.5),
        'ada_b': nrm((nl, 6 * d), 0.02),
        'norm1_g': 1.0 + nrm((nl, d), 0.05),
        'norm2_g': 1.0 + nrm((nl, d), 0.05),
        'in_w': nrm((nl, d, PROJ_WIDTH), d ** -0.5),
        'conv_w': conv_base + nrm((nl, 3, PROJ_WIDTH), 0.2),
        'conv_b': nrm((nl, PROJ_WIDTH), 0.02),
        'hy_w1': nrm((nl, FILTER_EMB, FILTER_WIDTH), FILTER_EMB ** -0.5),
        'hy_b1': nrm((nl, FILTER_WIDTH), 0.1),
        'hy_w2': nrm((nl, FILTER_WIDTH, FILTER_WIDTH), FILTER_WIDTH ** -0.5),
        'hy_b2': nrm((nl, FILTER_WIDTH), 0.1),
        'hy_w3': nrm((nl, FILTER_WIDTH, FILTER_WIDTH), FILTER_WIDTH ** -0.5),
        'hy_b3': nrm((nl, FILTER_WIDTH), 0.1),
        'hy_freq': 1.0 + nrm((nl, FILTER_WIDTH), 0.1),
        'hy_w4': nrm((nl, FILTER_WIDTH, 2 * HY_WIDTH), FILTER_WIDTH ** -0.5),
        'hy_bias': nrm((nl, HY_WIDTH), 0.5),
        'hy_norm_g': 1.0 + nrm((nl, HY_WIDTH), 0.05),
        'rw_w0': -1.0 + nrm((nl, 2, RW_WIDTH), 0.5),
        'rw_w1': nrm((nl, 2, d, DECAY_LORA), d ** -0.5),
        'rw_w2': nrm((nl, 2, DECAY_LORA, RW_WIDTH), 0.5 * DECAY_LORA ** -0.5),
        'rw_a0': nrm((nl, 2, RW_WIDTH), 0.5),
        'rw_a1': nrm((nl, 2, d, ICLR_LORA), d ** -0.5),
        'rw_a2': nrm((nl, 2, ICLR_LORA, RW_WIDTH), 0.5 * ICLR_LORA ** -0.5),
        'rw_kk': 0.85 + nrm((nl, RW_WIDTH), 0.05),
        'rw_ka': 1.0 + nrm((nl, RW_WIDTH), 0.05),
        'rw_rk': nrm((nl, RW_HEADS, RW_HEAD), 0.1),
        'rw_g1': nrm((nl, d, GATE_LORA), d ** -0.5),
        'rw_g2': nrm((nl, GATE_LORA, RW_WIDTH), GATE_LORA ** -0.5),
        'rw_lnx_g': 1.0 + nrm((nl, RW_WIDTH), 0.05),
        'rw_lnx_b': nrm((nl, RW_WIDTH), 0.02),
        'out_w': nrm((nl, HY_WIDTH + RW_WIDTH, d), (HY_WIDTH + RW_WIDTH) ** -0.5),
        'router_w': nrm((nl, d, e), d ** -0.5),
        'router_b': nrm((nl, e), 0.01),
        'ex_w_gate': nrm((nl, e, d, f), d ** -0.5),
        'ex_b_gate': nrm((nl, e, f), 0.01),
        'ex_w_up': nrm((nl, e, d, f), d ** -0.5),
        'ex_b_up': nrm((nl, e, f), 0.01),
        'ex_w_down': nrm((nl, e, f, d), f ** -0.5),
        'ex_b_down': nrm((nl, e, d), 0.01),
        'final_g': 1.0 + nrm((d,), 0.05),
    }


def reference(x, c, ctx, c_ctx, ada_w, ada_b, norm1_g, norm2_g, in_w, conv_w, conv_b,
              hy_w1, hy_b1, hy_w2, hy_b2, hy_w3, hy_b3, hy_freq, hy_w4, hy_bias, hy_norm_g,
              rw_w0, rw_w1, rw_w2, rw_a0, rw_a1, rw_a2, rw_kk, rw_ka, rw_rk,
              rw_g1, rw_g2, rw_lnx_g, rw_lnx_b, out_w,
              router_w, router_b, ex_w_gate, ex_b_gate, ex_w_up, ex_b_up, ex_w_down, ex_b_down,
              final_g):
    cond_x = jax.nn.silu(c)[:, None, :]
    cond_c = jax.nn.silu(c_ctx)[None, None, :]
    for i in range(DEPTH):
        need_ctx = i < DEPTH - 1
        mod_x = jnp.split(cond_x @ ada_w[i] + ada_b[i], 6, axis=-1)
        mod_c = jnp.split(cond_c @ ada_w[i] + ada_b[i], 6, axis=-1)
        hx = modulate(rmsnorm(x, norm1_g[i]), mod_x[0], mod_x[1])
        hc = modulate(rmsnorm(ctx, norm1_g[i]), mod_c[0], mod_c[1])
        hy = (hy_w1[i], hy_b1[i], hy_w2[i], hy_b2[i], hy_w3[i], hy_b3[i], hy_freq[i], hy_w4[i],
              hy_bias[i], hy_norm_g[i])
        rw_pre = (rw_w0[i], rw_w1[i], rw_w2[i], rw_a0[i], rw_a1[i], rw_a2[i], rw_kk[i], rw_ka[i], rw_rk[i])
        rw_post = (rw_g1[i], rw_g2[i], rw_lnx_g[i], rw_lnx_b[i])
        mix_x, mix_c = token_mixer(hx, hc, in_w[i], conv_w[i], conv_b[i], hy, rw_pre, rw_post,
                                   out_w[i], need_ctx)
        x = x + mod_x[2] * mix_x
        moe_w = (router_w[i], router_b[i], ex_w_gate[i], ex_b_gate[i], ex_w_up[i], ex_b_up[i],
                 ex_w_down[i], ex_b_down[i])
        x = x + mod_x[5] * moe_ffn(modulate(rmsnorm(x, norm2_g[i]), mod_x[3], mod_x[4]), *moe_w)
        if need_ctx:
            ctx = ctx + mod_c[2] * mix_c
            ctx = ctx + mod_c[5] * moe_ffn(modulate(rmsnorm(ctx, norm2_g[i]), mod_c[3], mod_c[4]), *moe_w)
    return rmsnorm(x, final_g)
```

```cpp
#include <hip/hip_runtime.h>
#include <cstdio>
#include <cstdint>

#ifndef MK_PER_PHASE
#define MK_PER_PHASE 1
#endif

#define GAS __attribute__((address_space(1)))
#define LAS __attribute__((address_space(3)))
typedef unsigned short bf16;
typedef unsigned v4u __attribute__((ext_vector_type(4)));
typedef unsigned v2u __attribute__((ext_vector_type(2)));
typedef float f32x4 __attribute__((ext_vector_type(4)));
typedef float f32x2 __attribute__((ext_vector_type(2)));
typedef short bf16x8 __attribute__((ext_vector_type(8)));

constexpr int NB = 16, SEQ = 2048, CTXL = 256, D = 2048;
constexpr int NLAT = NB * SEQ;
constexpr int NCTX = NB * CTXL;
constexpr int MROWS = NLAT + NCTX;
constexpr int PW = 6144;
constexpr int NIN = 6656;
constexpr int NLORA = 5120, KLORA = 512;
constexpr int NE = 32, TOPK = 4;
constexpr int NASG = NLAT * TOPK;
constexpr int MAXTILES = NASG / 256 + NE;
constexpr int SIW = 7168;

constexpr size_t MiB = 1u << 20;
constexpr size_t WS_CTL = 0;
constexpr size_t WS_MODACC = 1 * MiB;
constexpr size_t CTL_ZERO_BYTES = 2 * MiB;
constexpr size_t WS_MODT = 2 * MiB;
constexpr size_t WS_BS = 3 * MiB;
constexpr size_t WS_TOKE = 5 * MiB;
constexpr size_t WS_TOKG = 6 * MiB;
constexpr size_t WS_WCNT = 7 * MiB;
constexpr size_t WS_BCNT = 7 * MiB + 512 * 1024;
constexpr size_t WS_ETAB = 7 * MiB + 768 * 1024;
constexpr size_t WS_ROWTOK = 8 * MiB;
constexpr size_t WS_ROWDST = 9 * MiB;
constexpr size_t WS_ROWGATE = 10 * MiB;
constexpr size_t WS_G = 16 * MiB;
constexpr size_t WS_BTIN = 24 * MiB;
constexpr size_t WS_BTL = 50 * MiB;
constexpr size_t WS_BTOUT = 55 * MiB;
constexpr size_t WS_WR = 63 * MiB;
constexpr size_t WS_A1 = 64 * MiB;
constexpr size_t WS_Z = 208 * MiB;
constexpr size_t WS_AP = 640 * MiB;
constexpr size_t WS_EA = 676 * MiB;
constexpr size_t WS_SI = 1036 * MiB;
constexpr size_t WS_UT = 1540 * MiB;
constexpr size_t WS_X0T = 1604 * MiB;
constexpr size_t WS_YCT = 1668 * MiB;
constexpr size_t WS_YS = 64 * MiB;
constexpr size_t WS_A2 = 320 * MiB;
constexpr size_t WS_H2 = 64 * MiB;
constexpr size_t WS_BTGU = 192 * MiB;
constexpr size_t WS_BTD = 704 * MiB;
constexpr size_t WS_ACT = 960 * MiB;
constexpr size_t WS_SLOT = 1504 * MiB;
constexpr size_t WS_END = 2016 * MiB;

constexpr int CW_TMO = 0;
constexpr int CW_BAR = 4096;

constexpr int LDS_BYTES = 147456;
constexpr int MISC_OFF = 143360;

__device__ __forceinline__ unsigned f2bf(float f) { unsigned u = __builtin_bit_cast(unsigned, f); return (u + 0x7fffu + ((u >> 16) & 1u)) >> 16; }
__device__ __forceinline__ unsigned pk2(float lo, float hi) { return f2bf(lo) | (f2bf(hi) << 16); }
__device__ __forceinline__ float bf2f(unsigned b) { return __builtin_bit_cast(float, b << 16); }
__device__ __forceinline__ float bflo(unsigned w) { return __builtin_bit_cast(float, w << 16); }
__device__ __forceinline__ float bfhi(unsigned w) { return __builtin_bit_cast(float, w & 0xffff0000u); }
__device__ __forceinline__ float fsigmoid(float x) { return 1.0f / (1.0f + __expf(-x)); }
__device__ __forceinline__ float ftanh(float x) { const float e = __expf(2.0f * x); return 1.0f - 2.0f / (e + 1.0f); }
#define LDS_WAIT() asm volatile("s_waitcnt lgkmcnt(0)" ::: "memory")
#define VM_WAIT() asm volatile("s_waitcnt vmcnt(0)" ::: "memory")

#define XB_TMO      128
#define XB_XCNT(j)  (256  + 64 * (j))
#define XB_XSUB(j)  (1280 + 64 * (j))
#define XB_XGEN(j)  (2304 + 64 * (j))
#define XB_TOP      3328
#define XB_TOPGEN   3392
#define XCD_BAR_WORDS 3456
#define XB_SPIN_CAP (1u << 20)

__device__ __forceinline__ unsigned xb_ld(unsigned* p)              { return __hip_atomic_load(p, __ATOMIC_RELAXED, __HIP_MEMORY_SCOPE_AGENT); }
__device__ __forceinline__ unsigned xb_add(unsigned* p, unsigned v) { return __hip_atomic_fetch_add(p, v, __ATOMIC_RELAXED, __HIP_MEMORY_SCOPE_AGENT); }
__device__ __forceinline__ unsigned xb_xcc_id() { return (unsigned)__builtin_amdgcn_s_getreg((3 << 11) | 20) & 0xFu; }
#define XB_SPIN(cond, bar) do { unsigned _sp = 0; while (cond) { __builtin_amdgcn_s_sleep(1); \
    if ((++_sp & 255u) == 0u) { if (xb_ld(&(bar)[XB_TMO])) break; if (_sp > XB_SPIN_CAP) { atomicAdd(&(bar)[XB_TMO], 1u); break; } } } } while (0)

struct XcdBarrier { unsigned* bar; unsigned x; volatile LAS unsigned* st; };

__device__ __forceinline__ XcdBarrier xcd_barrier_post(unsigned* bar, volatile LAS unsigned* st) {
    XcdBarrier b; b.bar = bar; b.x = xb_xcc_id(); b.st = st;
    if (threadIdx.x == 0) (void)xb_add(&bar[XB_XCNT(b.x)], 1u);
    return b;
}
__device__ __forceinline__ void xcd_barrier_complete(unsigned* bar, unsigned x, unsigned& nloc, unsigned& nx) {
    const unsigned G = gridDim.x * gridDim.y * gridDim.z;
    unsigned sum, cnt, mine, sp = 0u;
    for (;;) {
        sum = 0u; cnt = 0u; mine = 0u;
#pragma unroll
        for (unsigned j = 0; j < 16; ++j) { const unsigned c = xb_ld(&bar[XB_XCNT(j)]); sum += c; cnt += (c > 0u) ? 1u : 0u; mine = (j == x) ? c : mine; }
        if (sum == G) break;
        __builtin_amdgcn_s_sleep(1);
        if ((++sp & 255u) == 0u) { if (xb_ld(&bar[XB_TMO])) break; if (sp > XB_SPIN_CAP) { atomicAdd(&bar[XB_TMO], 1u); break; } }
    }
    nloc = mine > 0u ? mine : 1u; nx = cnt > 0u ? cnt : 1u;
}
__device__ __forceinline__ void xcd_barrier(const XcdBarrier& b) {
    asm volatile("s_waitcnt vmcnt(0)" ::: "memory");
    __syncthreads();
    if (threadIdx.x == 0) {
        unsigned* bar = b.bar;
        __builtin_amdgcn_s_waitcnt(0);
        unsigned nloc = b.st[0], nx = b.st[1];
        if (nloc == 0u) { xcd_barrier_complete(bar, b.x, nloc, nx); b.st[0] = nloc; b.st[1] = nx; }
        const unsigned old = xb_add(&bar[XB_XSUB(b.x)], 1u);
        const unsigned gen = old / nloc;
        if (old + 1u == (gen + 1u) * nloc) {
            __builtin_amdgcn_fence(__ATOMIC_RELEASE, "agent");
            asm volatile("s_waitcnt vmcnt(0)" ::: "memory");
            const unsigned og = xb_add(&bar[XB_TOP], 1u);
            const unsigned tg = og / nx;
            if (og + 1u == (tg + 1u) * nx) xb_add(&bar[XB_TOPGEN], 1u);
            else XB_SPIN(xb_ld(&bar[XB_TOPGEN]) == tg, bar);
            __builtin_amdgcn_fence(__ATOMIC_ACQUIRE, "agent");
            xb_add(&bar[XB_XGEN(b.x)], 1u);
            asm volatile("s_waitcnt vmcnt(0)" ::: "memory");
        } else {
            XB_SPIN(xb_ld(&bar[XB_XGEN(b.x)]) == gen, bar);
            __builtin_amdgcn_fence(__ATOMIC_ACQUIRE, "agent");
            asm volatile("s_waitcnt vmcnt(0)" ::: "memory");
        }
    }
    __syncthreads();
}

namespace pg8 {
constexpr int BM = 256, BK = 64, HALF = 128, HTB = HALF * BK * 2, STAGE_BYTES = 8 * HTB, NXCD = 8, WGM = 8;
__device__ __forceinline__ int lds_byte(int r, int c) { const int st = (r >> 4) * 2 + (c >> 5), rr = r & 15, cc = c & 31, ob = rr * 64 + cc * 2; return st * 1024 + (ob ^ (((ob >> 9) & 1) << 5)); }
__device__ __forceinline__ void stage_rc(int b, int& R, int& C) { const int st = b / 1024, sb = b % 1024, swz = sb ^ (((sb >> 9) & 1) << 5); R = (st >> 1) * 16 + swz / 64; C = (st & 1) * 32 + (swz % 64) / 2; }
__device__ __forceinline__ int perm32(int rho) { const int n = rho >> 4, i = rho & 15; return 8 * (i >> 2) + 4 * n + (i & 3); }

struct Unit { int pm, pn, e; };
struct Gemm { const bf16* A; const bf16* Bt; int K; size_t bstrideE; };

__device__ __forceinline__ unsigned cvt_pk_bf16(float lo, float hi) { unsigned r; asm volatile("v_cvt_pk_bf16_f32 %0, %1, %2" : "=v"(r) : "v"(lo), "v"(hi)); return r; }

template <bool GATHER, class Epi, class Sched>
__device__ __forceinline__ void gemm_phase(LAS unsigned char* lds, const Gemm g, const Sched& S, const Epi& E) {
    const int tid = threadIdx.x, wid = __builtin_amdgcn_readfirstlane(tid >> 6), lane = tid & 63, wr = wid >> 2, wc = wid & 3, fr = lane & 15, fq = lane >> 4;
    const int K = g.K, nt = K / BK;
    unsigned voffB[2]; int RA[2], CA[2];
#pragma unroll
    for (int i = 0; i < 2; ++i) { int R, C; stage_rc(tid * 16 + i * 8192, R, C); const int Rb = Epi::PERM ? ((R & ~31) + perm32(R & 31)) : R;
        RA[i] = R; CA[i] = C; voffB[i] = (unsigned)(Rb * K + C) * 2u; }
    const size_t kstep = (size_t)(BK * 2);
    const size_t hstep = (size_t)HALF * K * 2;
    const size_t tstep = 2 * hstep;
    const unsigned ldsw = (unsigned)wid * 1024u;
    const int aoff = lds_byte(wr * 64 + fr, fq * 8), boff = lds_byte(wc * 32 + fr, fq * 8);
#define PG8_SA(b, h) (((b) * 2 + (h)) * HTB)
#define PG8_SB(b, h) ((4 + (b) * 2 + (h)) * HTB)
#define PG8_STAGE(bufoff, gbase, voff) do { _Pragma("unroll") for (int _i = 0; _i < 2; ++_i) \
        __builtin_amdgcn_global_load_lds((const unsigned*)((const char*)(gbase) + (voff)[_i]), (LAS unsigned*)(lds + (bufoff) + ldsw + _i * 8192), 16, 0, 0); } while (0)
#define PG8_LDA(dst, b, h) do { _Pragma("unroll") for (int m = 0; m < 4; ++m) _Pragma("unroll") for (int k = 0; k < 2; ++k) dst[m][k] = *(const LAS bf16x8*)(lds + PG8_SA(b, h) + aoff + m * 2048 + k * 1024); } while (0)
#define PG8_LDB(dst, b, h) do { _Pragma("unroll") for (int n = 0; n < 2; ++n) _Pragma("unroll") for (int k = 0; k < 2; ++k) dst[n][k] = *(const LAS bf16x8*)(lds + PG8_SB(b, h) + boff + n * 2048 + k * 1024); } while (0)
#define PG8_MMA(ai, bj, At, Bt) do { __builtin_amdgcn_s_setprio(1); _Pragma("unroll") for (int m = 0; m < 4; ++m) _Pragma("unroll") for (int n = 0; n < 2; ++n) _Pragma("unroll") for (int k = 0; k < 2; ++k) \
        acc[ai][bj][m][n] = __builtin_amdgcn_mfma_f32_16x16x32_bf16(Bt[n][k], At[m][k], acc[ai][bj][m][n], 0, 0, 0); __builtin_amdgcn_s_setprio(0); } while (0)
#define PG8_WAIT_V(n) asm volatile("s_waitcnt vmcnt(" #n ")" ::: "memory")
#define PG8_WAIT_L(n) asm volatile("s_waitcnt lgkmcnt(" #n ")" ::: "memory")
#define PG8_BAR __builtin_amdgcn_s_barrier()
#define PG8_SCHED __builtin_amdgcn_sched_barrier(0)
    Unit cur, nxt; int ui = 0;
    if (!S.next(0, cur)) return;
    f32x4 acc[2][2][4][2];
#pragma unroll
    for (int a = 0; a < 2; ++a)
#pragma unroll
        for (int b = 0; b < 2; ++b)
#pragma unroll
            for (int m = 0; m < 4; ++m)
#pragma unroll
                for (int n = 0; n < 2; ++n) acc[a][b][m][n] = (f32x4){0.f, 0.f, 0.f, 0.f};
    bf16x8 At[4][2], B0[2][2], B1[2][2];
    unsigned vA0[2], vA1[2], vN0[2], vN1[2];
    const char* cA; const char* cB;
    if constexpr (GATHER) {
        cA = (const char*)g.A;
#pragma unroll
        for (int i = 0; i < 2; ++i) { vA0[i] = (unsigned)(S.arow(cur, RA[i]) * K + CA[i]) * 2u; vA1[i] = (unsigned)(S.arow(cur, HALF + RA[i]) * K + CA[i]) * 2u; }
    } else {
        cA = (const char*)g.A + (size_t)cur.pm * tstep;
#pragma unroll
        for (int i = 0; i < 2; ++i) { vA0[i] = (unsigned)(RA[i] * K + CA[i]) * 2u; vA1[i] = vA0[i] + (unsigned)hstep; }
    }
#pragma unroll
    for (int i = 0; i < 2; ++i) { vN0[i] = vA0[i]; vN1[i] = vA1[i]; }
    cB = (const char*)g.Bt + (size_t)cur.e * g.bstrideE + (size_t)cur.pn * tstep;
    PG8_STAGE(PG8_SB(0, 0), cB, voffB); PG8_STAGE(PG8_SA(0, 0), cA, vA0); PG8_STAGE(PG8_SB(0, 1), cB + hstep, voffB); PG8_STAGE(PG8_SA(0, 1), cA, vA1);
    if (wr == 1) PG8_BAR;
    PG8_WAIT_V(4); PG8_BAR;
    PG8_STAGE(PG8_SB(1, 0), cB + kstep, voffB); PG8_STAGE(PG8_SA(1, 0), cA + kstep, vA0); PG8_STAGE(PG8_SB(1, 1), cB + hstep + kstep, voffB);
    PG8_WAIT_V(6); PG8_BAR;
    for (;;) {
        const bool has_next = S.next(ui + 1, nxt);
        const char* nA; const char* nB;
        if (has_next) {
            nB = (const char*)g.Bt + (size_t)nxt.e * g.bstrideE + (size_t)nxt.pn * tstep;
            if constexpr (GATHER) { nA = cA;
#pragma unroll
                for (int i = 0; i < 2; ++i) { vN0[i] = (unsigned)(S.arow(nxt, RA[i]) * K + CA[i]) * 2u; vN1[i] = (unsigned)(S.arow(nxt, HALF + RA[i]) * K + CA[i]) * 2u; }
            } else nA = (const char*)g.A + (size_t)nxt.pm * tstep;
        } else { nA = cA; nB = cB;
#pragma unroll
            for (int i = 0; i < 2; ++i) { vN0[i] = vA0[i]; vN1[i] = vA1[i]; } }
        for (int t = 0; t < nt; t += 2) {
            const bool last = (t == nt - 2);
            const char* a1 = cA + (size_t)(t + 1) * kstep;
            const char* a2 = last ? nA : cA + (size_t)(t + 2) * kstep; const char* b2 = last ? nB : cB + (size_t)(t + 2) * kstep;
            const char* a3 = a2 + kstep; const char* b3 = b2 + kstep;
            unsigned w0[2], w1[2];
#pragma unroll
            for (int i = 0; i < 2; ++i) { if constexpr (GATHER) { w0[i] = last ? vN0[i] : vA0[i]; w1[i] = last ? vN1[i] : vA1[i]; } else { w0[i] = vA0[i]; w1[i] = vA1[i]; } }
            PG8_LDB(B0, 0, 0); PG8_SCHED; PG8_LDA(At, 0, 0); PG8_STAGE(PG8_SA(1, 1), a1, vA1);
            PG8_WAIT_L(8); PG8_BAR; PG8_WAIT_L(0); PG8_MMA(0, 0, At, B0); PG8_BAR; PG8_SCHED;
            PG8_LDB(B1, 0, 1); PG8_STAGE(PG8_SB(0, 0), b2, voffB);
            PG8_BAR; PG8_WAIT_L(0); PG8_MMA(0, 1, At, B1); PG8_BAR;
            PG8_LDA(At, 0, 1); PG8_STAGE(PG8_SA(0, 0), a2, w0);
            PG8_BAR; PG8_WAIT_L(0); PG8_MMA(1, 0, At, B0); PG8_BAR; PG8_SCHED;
            PG8_STAGE(PG8_SB(0, 1), b2 + hstep, voffB);
            PG8_WAIT_V(6); PG8_BAR; PG8_MMA(1, 1, At, B1); PG8_BAR;
            PG8_LDB(B0, 1, 0); PG8_SCHED; PG8_LDA(At, 1, 0); PG8_STAGE(PG8_SA(0, 1), a2, w1);
            PG8_WAIT_L(8); PG8_BAR; PG8_WAIT_L(0); PG8_MMA(0, 0, At, B0); PG8_BAR; PG8_SCHED;
            PG8_LDB(B1, 1, 1); PG8_STAGE(PG8_SB(1, 0), b3, voffB);
            PG8_BAR; PG8_WAIT_L(0); PG8_MMA(0, 1, At, B1); PG8_BAR;
            PG8_LDA(At, 1, 1); PG8_STAGE(PG8_SA(1, 0), a3, w0);
            PG8_BAR; PG8_WAIT_L(0); PG8_MMA(1, 0, At, B0); PG8_BAR; PG8_SCHED;
            PG8_STAGE(PG8_SB(1, 1), b3 + hstep, voffB);
            PG8_WAIT_V(6); PG8_BAR; PG8_MMA(1, 1, At, B1); PG8_BAR;
        }
        E(acc, cur, wr, wc, fr, fq);
        if (!has_next) break;
#pragma unroll
        for (int a = 0; a < 2; ++a)
#pragma unroll
            for (int b = 0; b < 2; ++b)
#pragma unroll
                for (int m = 0; m < 4; ++m)
#pragma unroll
                    for (int n = 0; n < 2; ++n) acc[a][b][m][n] = (f32x4){0.f, 0.f, 0.f, 0.f};
        cur = nxt; cA = nA; cB = nB; ++ui;
#pragma unroll
        for (int i = 0; i < 2; ++i) { vA0[i] = vN0[i]; vA1[i] = vN1[i]; }
    }
    PG8_WAIT_V(0);
    if (wr == 0) PG8_BAR;
    PG8_BAR;
#undef PG8_SA
#undef PG8_SB
#undef PG8_STAGE
#undef PG8_LDA
#undef PG8_LDB
#undef PG8_MMA
#undef PG8_WAIT_V
#undef PG8_WAIT_L
#undef PG8_BAR
#undef PG8_SCHED
}
}

struct Args { const float* in[44]; float* out; unsigned char* ws; int ph_lo, ph_hi; };
enum InIdx { I_X = 0, I_C, I_CTX, I_CCTX, I_ADAW, I_ADAB, I_N1G, I_N2G, I_INW, I_CONVW, I_CONVB, I_HW1, I_HB1, I_HW2, I_HB2, I_HW3, I_HB3, I_HFREQ, I_HW4, I_HBIAS, I_HNG,
             I_RW0, I_RW1, I_RW2, I_RA0, I_RA1, I_RA2, I_RKK, I_RKA, I_RRK, I_RG1, I_RG2, I_LNG, I_LNB, I_OUTW, I_ROUTW, I_ROUTB, I_EWG, I_EBG, I_EWU, I_EBU, I_EWD, I_EBD, I_FING };

struct Frame {
    LAS unsigned char* lds;
    const float* const* in;
    float* out; unsigned char* ws;
    int tid, lane, wave, G, bid;
};
template <class T> __device__ __forceinline__ T* wsp(const Frame& F, size_t off) { return (T*)(F.ws + off); }

template <int CTRL> __device__ __forceinline__ float dpp_mov(float x) { return __builtin_bit_cast(float, __builtin_amdgcn_update_dpp(0, __builtin_bit_cast(int, x), CTRL, 0xF, 0xF, true)); }
__device__ __forceinline__ float row16_sum(float v) {
    v += dpp_mov<0x128>(v);
    v += dpp_mov<0x124>(v);
    v += dpp_mov<0x122>(v);
    v += dpp_mov<0x121>(v);
    return v;
}

__device__ __forceinline__ float rdlane(float v, int l) { return __builtin_bit_cast(float, __builtin_amdgcn_readlane(__builtin_bit_cast(int, v), l)); }
__device__ __forceinline__ float wave_sum(float v) { v = row16_sum(v); return (rdlane(v, 0) + rdlane(v, 16)) + (rdlane(v, 32) + rdlane(v, 48)); }

__device__ __forceinline__ void tr_item(const float* src, size_t ld_src, int k0, int n0, bf16* dst, bf16* dlo, size_t ld_dst, int drow0, int dk0, LAS float* scr, int lane) {
    const int c = lane & 7;
    if (src == nullptr) {
#pragma unroll
        for (int j = 0; j < 4; ++j) { const int n = (lane >> 3) + 8 * j; *(GAS v4u*)(dst + (size_t)(drow0 + n) * ld_dst + dk0 + 8 * c) = (v4u){0u, 0u, 0u, 0u}; }
        return;
    }
#pragma unroll 8
    for (int i = 0; i < 32; ++i) { const int kk = 2 * i + (lane >> 5); scr[kk * 33 + (lane & 31)] = src[(size_t)(k0 + kk) * ld_src + n0 + (lane & 31)]; }
    LDS_WAIT(); asm volatile("" ::: "memory");
#pragma unroll
    for (int j = 0; j < 4; ++j) { const int n = (lane >> 3) + 8 * j; const LAS float* s = scr + (8 * c) * 33 + n;
        float v[8];
#pragma unroll
        for (int q = 0; q < 8; ++q) v[q] = s[q * 33];
        v4u o; o.x = pk2(v[0], v[1]); o.y = pk2(v[2], v[3]); o.z = pk2(v[4], v[5]); o.w = pk2(v[6], v[7]);
        *(GAS v4u*)(dst + (size_t)(drow0 + n) * ld_dst + dk0 + 8 * c) = o;
        if (dlo) { float r[8];
#pragma unroll
            for (int q = 0; q < 8; ++q) r[q] = v[q] - bf2f(f2bf(v[q]));
            v4u p; p.x = pk2(r[0], r[1]); p.y = pk2(r[2], r[3]); p.z = pk2(r[4], r[5]); p.w = pk2(r[6], r[7]);
            *(GAS v4u*)(dlo + (size_t)(drow0 + n) * ld_dst + dk0 + 8 * c) = p; } }
    LDS_WAIT(); asm volatile("" ::: "memory");
}

__device__ __forceinline__ void p0_small_weights(Frame& F) {
    LAS float* scr = (LAS float*)(F.lds + F.wave * 8448);
    const int gw = F.bid * 8 + F.wave, NGW = F.G * 8;
    constexpr int I_T1 = 32 * 192, I_T2 = 128, I_T3 = 128, I_T4 = 128, I_T5 = 128, I_T6 = 32 * 64, I_T7 = 160 * 8, I_T8 = 32;
    constexpr int NITEMS = I_T1 + I_T2 + I_T3 + I_T4 + I_T5 + I_T6 + I_T7 + I_T8;
    bf16* BtIn = wsp<bf16>(F, WS_BTIN); bf16* BtL = wsp<bf16>(F, WS_BTL); bf16* BtOut = wsp<bf16>(F, WS_BTOUT); bf16* Wr = wsp<bf16>(F, WS_WR);
    for (int it = gw; it < NITEMS; it += NGW) {
        int r = it;
        if (r < I_T1) { const int kb = r / 192, nb = r % 192; tr_item(F.in[I_INW], PW, 64 * kb, 32 * nb, BtIn, nullptr, D, 32 * nb, 64 * kb, scr, F.lane); continue; } r -= I_T1;
        if (r < I_T2) { const int dir = r / 64, q = r % 64, kb = q / 2, nb = q % 2; tr_item(F.in[I_RW1] + (size_t)dir * D * 64, 64, 64 * kb, 32 * nb, BtIn, nullptr, D, 6144 + 64 * dir + 32 * nb, 64 * kb, scr, F.lane); continue; } r -= I_T2;
        if (r < I_T3) { const int dir = r / 64, q = r % 64, kb = q / 2, nb = q % 2; tr_item(F.in[I_RA1] + (size_t)dir * D * 64, 64, 64 * kb, 32 * nb, BtIn, nullptr, D, 6272 + 64 * dir + 32 * nb, 64 * kb, scr, F.lane); continue; } r -= I_T3;
        if (r < I_T4) { const int kb = r / 4, nb = r % 4; tr_item(F.in[I_RG1], 128, 64 * kb, 32 * nb, BtIn, nullptr, D, 6400 + 32 * nb, 64 * kb, scr, F.lane); continue; } r -= I_T4;
        if (r < I_T5) { const int kb = r / 4, nb = r % 4; tr_item(nullptr, 0, 0, 0, BtIn, nullptr, D, 6528 + 32 * nb, 64 * kb, scr, F.lane); continue; } r -= I_T5;
        if (r < I_T6) { const int kb = r / 64, nb = r % 64; tr_item(F.in[I_OUTW], D, 64 * kb, 32 * nb, BtOut, nullptr, D, 32 * nb, 64 * kb, scr, F.lane); continue; } r -= I_T6;
        if (r < I_T7) { const int nb = r / 8, kb = r % 8, j = nb / 32, n0 = (nb % 32) * 32; const float* src = nullptr; int k0 = 0;
            if (j == 0 && kb == 0) src = F.in[I_RW2];
            else if (j == 1 && kb == 1) src = F.in[I_RW2] + 64 * 1024;
            else if (j == 2 && kb == 2) src = F.in[I_RA2];
            else if (j == 3 && kb == 3) src = F.in[I_RA2] + 64 * 1024;
            else if (j == 4 && (kb == 4 || kb == 5)) { src = F.in[I_RG2]; k0 = 64 * (kb - 4); }
            tr_item(src, 1024, k0, n0, BtL, nullptr, KLORA, 32 * nb, 64 * kb, scr, F.lane); continue; } r -= I_T7;
        { const int kb = r; tr_item(F.in[I_ROUTW], 32, 64 * kb, 0, Wr, Wr + 32 * D, D, 0, 64 * kb, scr, F.lane); }
    }
}

__device__ __forceinline__ void p0_adaln(Frame& F) {
    if (F.bid >= 192) return;
    const int kc = F.bid / 6, cg = F.bid % 6, k0 = 64 * kc;
    LAS float* sc = (LAS float*)(F.lds + 73728);
    for (int i = F.tid; i < 17 * 64; i += 512) { const int b = i / 64, k = i % 64; const float c = (b < 16) ? F.in[I_C][b * D + k0 + k] : F.in[I_CCTX][k0 + k]; sc[i] = c * fsigmoid(c); }
    __syncthreads();
    const int col = cg * 2048 + F.wave * 256 + F.lane * 4;
    f32x4 acc[17];
#pragma unroll
    for (int b = 0; b < 17; ++b) acc[b] = (f32x4){0.f, 0.f, 0.f, 0.f};
    const float* W = F.in[I_ADAW] + (size_t)k0 * 12288 + col;
    for (int k = 0; k < 64; k += 4) {
        f32x4 w[4];
#pragma unroll
        for (int j = 0; j < 4; ++j) w[j] = *(const GAS f32x4*)(W + (size_t)(k + j) * 12288);
#pragma unroll
        for (int b = 0; b < 17; ++b) { const f32x4 s = *(const LAS f32x4*)(sc + b * 64 + k);
            acc[b] += s.x * w[0]; acc[b] += s.y * w[1]; acc[b] += s.z * w[2]; acc[b] += s.w * w[3]; }
    }
    float* macc = wsp<float>(F, WS_MODACC);
#pragma unroll
    for (int b = 0; b < 17; ++b) { float* p = macc + (size_t)b * 12288 + col; atomicAdd(p + 0, acc[b].x); atomicAdd(p + 1, acc[b].y); atomicAdd(p + 2, acc[b].z); atomicAdd(p + 3, acc[b].w); }
    __syncthreads();
}

__device__ __forceinline__ void p0_filter(Frame& F) {
    LAS float* hs = (LAS float*)(F.lds + 81920 + F.wave * 256);
    const int gw = F.bid * 8 + F.wave, NGW = F.G * 8, j = F.lane;
    const float freq = F.in[I_HFREQ][j];
    bf16* Gt = wsp<bf16>(F, WS_G);
    for (int t = gw; t < SEQ; t += NGW) {
        const float tl = (float)t * (1.0f / 2047.0f);
        float pre = F.in[I_HB1][j] + tl * F.in[I_HW1][j];
#pragma unroll 4
        for (int i = 0; i < 16; ++i) {
            const float band = 1e-4f + (float)i * ((15.0f - 1e-4f) / 15.0f);
            float rev = band * (float)t * (1.0f / 2048.0f); rev = rev - floorf(rev);
            const float cs = __builtin_amdgcn_cosf(rev), sn = __builtin_amdgcn_sinf(rev);
            pre += cs * F.in[I_HW1][(1 + i) * 64 + j] - sn * F.in[I_HW1][(17 + i) * 64 + j];
        }
        float h = __sinf(freq * pre);
        hs[j] = h; LDS_WAIT(); asm volatile("" ::: "memory");
        pre = F.in[I_HB2][j];
#pragma unroll 8
        for (int i = 0; i < 64; ++i) pre += hs[i] * F.in[I_HW2][i * 64 + j];
        h = __sinf(freq * pre);
        LDS_WAIT(); asm volatile("" ::: "memory");
        hs[j] = h; LDS_WAIT(); asm volatile("" ::: "memory");
        pre = F.in[I_HB3][j];
#pragma unroll 8
        for (int i = 0; i < 64; ++i) pre += hs[i] * F.in[I_HW3][i * 64 + j];
        h = __sinf(freq * pre);
        LDS_WAIT(); asm volatile("" ::: "memory");
        hs[j] = h; LDS_WAIT(); asm volatile("" ::: "memory");
        f32x4 o[8];
#pragma unroll
        for (int m = 0; m < 8; ++m) o[m] = (f32x4){0.f, 0.f, 0.f, 0.f};
#pragma unroll 2
        for (int i = 0; i < 64; ++i) { const float hv = hs[i]; const float* w4 = F.in[I_HW4] + (size_t)i * 2048 + 4 * j;
#pragma unroll
            for (int m = 0; m < 8; ++m) o[m] += hv * *(const GAS f32x4*)(w4 + 256 * m); }
        LDS_WAIT(); asm volatile("" ::: "memory");
        const float dlo = -3.0701134573253945f, dhi = -15.350567286626973f;
#pragma unroll
        for (int m = 0; m < 8; ++m)
#pragma unroll
            for (int q = 0; q < 4; ++q) { const int n = 256 * m + 4 * j + q, c = n & 1023;
                const float delta = fabsf(dlo + (dhi - dlo) * ((float)c * (1.0f / 1023.0f)));
                const float val = o[m][q] * __expf(-tl * delta);
                if (n < 1024) Gt[(size_t)c * 4096 + (2048 - t)] = (bf16)f2bf(val);
                else if (t > 0) Gt[(size_t)c * 4096 + (2048 + t)] = (bf16)f2bf(val);
                else Gt[(size_t)c * 4096] = 0; }
    }
}

__device__ __forceinline__ void p1_norm1(Frame& F) {
    const int gw = F.bid * 8 + F.wave, NGW = F.G * 8, lane = F.lane;
    const float* macc = wsp<float>(F, WS_MODACC); const float* adab = F.in[I_ADAB];
    bf16* A1 = wsp<bf16>(F, WS_A1);
    f32x4 g[8];
#pragma unroll
    for (int j = 0; j < 8; ++j) g[j] = *(const GAS f32x4*)(F.in[I_N1G] + 4 * lane + 256 * j);
    for (int row = gw; row < MROWS; row += NGW) {
        const int b = row < NLAT ? row / SEQ : 16;
        const float* xr = row < NLAT ? F.in[I_X] + (size_t)row * D : F.in[I_CTX] + (size_t)(row - NLAT) * D;
        f32x4 v[8]; float ss = 0.f;
#pragma unroll
        for (int j = 0; j < 8; ++j) { v[j] = *(const GAS f32x4*)(xr + 4 * lane + 256 * j); ss += (v[j].x * v[j].x + v[j].y * v[j].y) + (v[j].z * v[j].z + v[j].w * v[j].w); }
        const float rstd = 1.0f / sqrtf(wave_sum(ss) * (1.0f / D) + 1e-6f);
        const float* mrow = macc + (size_t)b * 12288;
#pragma unroll
        for (int j = 0; j < 8; ++j) { const int c = 4 * lane + 256 * j;
            const f32x4 sh = *(const GAS f32x4*)(mrow + c) + *(const GAS f32x4*)(adab + c);
            const f32x4 sc = *(const GAS f32x4*)(mrow + 2048 + c) + *(const GAS f32x4*)(adab + 2048 + c);
            const f32x4 y = v[j] * rstd * g[j] * (1.0f + sc) + sh;
            v2u o; o.x = pk2(y.x, y.y); o.y = pk2(y.z, y.w);
            *(GAS v2u*)(A1 + (size_t)row * D + c) = o; }
    }
    if (F.bid < 16) { const int b = F.bid; float* T = wsp<float>(F, WS_MODT) + (size_t)b * 4096; const float* mrow = macc + (size_t)b * 12288;
        for (int k = F.tid; k < D; k += 512) { const float sh = mrow[3 * 2048 + k] + adab[3 * 2048 + k], sc = mrow[4 * 2048 + k] + adab[4 * 2048 + k];
            T[k] = F.in[I_N2G][k] * (1.0f + sc); T[2048 + k] = sh; } }
}

namespace pg8 {
__device__ __forceinline__ void static_unit(int L, int nM, int nN, Unit& u) {
    const int nwg = nM * nN; int wgid = L;
    { const int q = nwg / NXCD, r = nwg % NXCD, xcd = wgid % NXCD, off = wgid / NXCD; wgid = (xcd < r ? xcd * (q + 1) : r * (q + 1) + (xcd - r) * q) + off; }
    const int nig = WGM * nN, gid = wgid / nig, fm = gid * WGM, gsz = (nM - fm) < WGM ? (nM - fm) : WGM;
    u.pm = fm + ((wgid % nig) % gsz); u.pn = (wgid % nig) / gsz; u.e = 0;
}
struct StaticOrder {
    int nM, nN, nwg, G, c;
    __device__ void init(int M, int N, int G_, int c_) { nM = M / BM; nN = N / BM; nwg = nM * nN; G = G_; c = c_; }
    __device__ __forceinline__ bool next(int i, Unit& u) const { const long L = (long)i * G + c; if (L >= nwg) return false; static_unit((int)L, nM, nN, u); return true; }
    __device__ __forceinline__ int arow(const Unit&, int) const { return 0; }
};
struct InProjOrder {
    int G, c;
    __device__ __forceinline__ bool next(int i, Unit& u) const {
        long L = (long)i * G + c;
        if (L < 128 * 26) { static_unit((int)L, 128, 26, u); return true; }
        L -= 128 * 26; if (L >= 16 * 13) return false;
        u.pm = 128 + (int)(L % 16); u.pn = 12 + (int)(L / 16); u.e = 0; return true;
    }
    __device__ __forceinline__ int arow(const Unit&, int) const { return 0; }
};
struct MoeOrder {
    int G, c, nN, ntiles; const int* tile_e; const int* rowtok; const int* pad_start; const int* total;
    __device__ __forceinline__ bool next(int i, Unit& u) const {
        const long L0 = (long)i * G;
        const long L = L0 + (long)(c % 8) * (G / 8) + (c / 8);
        if (L >= (long)ntiles * nN) return false;
        u.pm = (int)(L / nN); u.pn = (int)(L % nN); u.e = tile_e[u.pm]; return true;
    }
    __device__ __forceinline__ int arow(const Unit& u, int r) const { const int row = u.pm * 256 + r; const bool valid = (row - pad_start[u.e]) < total[u.e]; return valid ? rowtok[row] : 0; }
};

struct EpiInProj {
    static constexpr bool PERM = true;
    bf16* Z; bf16* AP;
    __device__ __forceinline__ void operator()(const f32x4 (&acc)[2][2][4][2], const Unit& u, int wr, int wc, int fr, int fq) const {
        const int row0 = u.pm * BM + wr * 64 + fr;
        const bool lora = u.pn >= 24;
        bf16* base = lora ? AP : Z; const int ldc = lora ? KLORA : PW;
        const int col0 = (lora ? (u.pn - 24) * BM : u.pn * BM) + wc * 32 + 8 * fq;
#pragma unroll
        for (int ai = 0; ai < 2; ++ai)
#pragma unroll
            for (int m = 0; m < 4; ++m) { bf16* rowp = base + (size_t)(row0 + ai * HALF + m * 16) * ldc + col0;
#pragma unroll
                for (int bj = 0; bj < 2; ++bj) { f32x4 v0 = acc[ai][bj][m][0], v1 = acc[ai][bj][m][1];
                    if (lora) { const int act = (u.pn == 24) ? (bj == 0 ? 1 : 0) : (bj == 0 ? 2 : 0);
                        if (act == 1) {
#pragma unroll
                            for (int j = 0; j < 4; ++j) { v0[j] = ftanh(v0[j]); v1[j] = ftanh(v1[j]); } }
                        if (act == 2) {
#pragma unroll
                            for (int j = 0; j < 4; ++j) { v0[j] = fsigmoid(v0[j]); v1[j] = fsigmoid(v1[j]); } } }
                    v4u w; w.x = cvt_pk_bf16(v0[0], v0[1]); w.y = cvt_pk_bf16(v0[2], v0[3]); w.z = cvt_pk_bf16(v1[0], v1[1]); w.w = cvt_pk_bf16(v1[2], v1[3]);
                    *(v4u*)(rowp + bj * HALF) = w; } }
    }
};
struct EpiLora {
    static constexpr bool PERM = true;
    bf16* EA; const float* w0; const float* a0;
    __device__ __forceinline__ void operator()(const f32x4 (&acc)[2][2][4][2], const Unit& u, int wr, int wc, int fr, int fq) const {
        const int row0 = u.pm * BM + wr * 64 + fr, col0 = u.pn * BM + wc * 32 + 8 * fq;
        const int blk = u.pn >> 2;
        const float* bias = blk < 2 ? w0 + col0 : (blk < 4 ? a0 + (col0 - 2048) : nullptr);
        const float scale = blk < 2 ? 0.60653065971263342f : 1.0f;
        f32x4 bv[2][2];
#pragma unroll
        for (int bj = 0; bj < 2; ++bj)
#pragma unroll
            for (int n = 0; n < 2; ++n) bv[bj][n] = bias ? *(const f32x4*)(bias + bj * HALF + 4 * n) : (f32x4){0.f, 0.f, 0.f, 0.f};
#pragma unroll
        for (int ai = 0; ai < 2; ++ai)
#pragma unroll
            for (int m = 0; m < 4; ++m) { bf16* rowp = EA + (size_t)(row0 + ai * HALF + m * 16) * NLORA + col0;
#pragma unroll
                for (int bj = 0; bj < 2; ++bj) { f32x4 v0 = acc[ai][bj][m][0] + bv[bj][0], v1 = acc[ai][bj][m][1] + bv[bj][1];
                    if (blk < 4) {
#pragma unroll
                        for (int j = 0; j < 4; ++j) { v0[j] = scale * fsigmoid(v0[j]); v1[j] = scale * fsigmoid(v1[j]); } }
                    v4u w; w.x = cvt_pk_bf16(v0[0], v0[1]); w.y = cvt_pk_bf16(v0[2], v0[3]); w.z = cvt_pk_bf16(v1[0], v1[1]); w.w = cvt_pk_bf16(v1[2], v1[3]);
                    *(v4u*)(rowp + bj * HALF) = w; } }
    }
};
struct EpiOutProj {
    static constexpr bool PERM = false;
    const float* X; float* X1; const float* macc; const float* adab;
    __device__ __forceinline__ void operator()(const f32x4 (&acc)[2][2][4][2], const Unit& u, int wr, int wc, int fr, int fq) const {
        const int row0 = u.pm * BM + wr * 64 + fr, col0 = u.pn * BM + wc * 32 + 4 * fq;
        const int b = (u.pm * BM) / SEQ;
        f32x4 gv[2][2];
#pragma unroll
        for (int bj = 0; bj < 2; ++bj)
#pragma unroll
            for (int n = 0; n < 2; ++n) { const int c = col0 + bj * HALF + n * 16; gv[bj][n] = *(const f32x4*)(macc + (size_t)b * 12288 + 2 * 2048 + c) + *(const f32x4*)(adab + 2 * 2048 + c); }
#pragma unroll
        for (int ai = 0; ai < 2; ++ai)
#pragma unroll
            for (int m = 0; m < 4; ++m) { const size_t off = (size_t)(row0 + ai * HALF + m * 16) * D + col0;
#pragma unroll
                for (int bj = 0; bj < 2; ++bj)
#pragma unroll
                    for (int n = 0; n < 2; ++n) { const f32x4 xv = *(const f32x4*)(X + off + bj * HALF + n * 16); *(f32x4*)(X1 + off + bj * HALF + n * 16) = xv + gv[bj][n] * acc[ai][bj][m][n]; } }
    }
};
struct EpiSwiglu {
    static constexpr bool PERM = true;
    bf16* ACT; const float* bg; const float* bu;
    __device__ __forceinline__ void operator()(const f32x4 (&acc)[2][2][4][2], const Unit& u, int wr, int wc, int fr, int fq) const {
        const int row0 = u.pm * BM + wr * 64 + fr, col0 = u.pn * HALF + wc * 32 + 8 * fq;
        const float* pg = bg + (size_t)u.e * 2048 + col0; const float* pu = bu + (size_t)u.e * 2048 + col0;
        f32x4 bgv[2], buv[2];
#pragma unroll
        for (int n = 0; n < 2; ++n) { bgv[n] = *(const f32x4*)(pg + 4 * n); buv[n] = *(const f32x4*)(pu + 4 * n); }
#pragma unroll
        for (int ai = 0; ai < 2; ++ai)
#pragma unroll
            for (int m = 0; m < 4; ++m) { bf16* rowp = ACT + (size_t)(row0 + ai * HALF + m * 16) * 2048 + col0; float o[8];
#pragma unroll
                for (int n = 0; n < 2; ++n) { const f32x4 gq = acc[ai][0][m][n] + bgv[n], uq = acc[ai][1][m][n] + buv[n];
#pragma unroll
                    for (int j = 0; j < 4; ++j) { const float gg = fminf(gq[j], 7.0f), uu = fminf(fmaxf(uq[j], -7.0f), 7.0f); o[4 * n + j] = (uu + 1.0f) * (gg * fsigmoid(1.702f * gg)); } }
                v4u w; w.x = cvt_pk_bf16(o[0], o[1]); w.y = cvt_pk_bf16(o[2], o[3]); w.z = cvt_pk_bf16(o[4], o[5]); w.w = cvt_pk_bf16(o[6], o[7]);
                *(v4u*)rowp = w; }
    }
};
struct EpiDown {
    static constexpr bool PERM = true;
    bf16* SLOT; const float* bd; const int* rowdst; const float* rowgate; const int* pad_start; const int* total;
    __device__ __forceinline__ void operator()(const f32x4 (&acc)[2][2][4][2], const Unit& u, int wr, int wc, int fr, int fq) const {
        const int row0 = u.pm * BM + wr * 64 + fr, col0 = u.pn * BM + wc * 32 + 8 * fq;
        const float* pb = bd + (size_t)u.e * 2048 + col0;
        const int lim = pad_start[u.e] + total[u.e];
        f32x4 bv[2][2];
#pragma unroll
        for (int bj = 0; bj < 2; ++bj)
#pragma unroll
            for (int n = 0; n < 2; ++n) bv[bj][n] = *(const f32x4*)(pb + bj * HALF + 4 * n);
#pragma unroll
        for (int ai = 0; ai < 2; ++ai)
#pragma unroll
            for (int m = 0; m < 4; ++m) { const int row = row0 + ai * HALF + m * 16;
                if (row < lim) { const int dst = rowdst[row]; const float gt = rowgate[row]; bf16* rowp = SLOT + (size_t)dst * 2048 + col0;
#pragma unroll
                    for (int bj = 0; bj < 2; ++bj) { const f32x4 v0 = (acc[ai][bj][m][0] + bv[bj][0]) * gt, v1 = (acc[ai][bj][m][1] + bv[bj][1]) * gt;
                        v4u w; w.x = cvt_pk_bf16(v0[0], v0[1]); w.y = cvt_pk_bf16(v0[2], v0[3]); w.z = cvt_pk_bf16(v1[0], v1[1]); w.w = cvt_pk_bf16(v1[2], v1[3]);
                        *(v4u*)(rowp + bj * HALF) = w; } } }
    }
};
}

__device__ __forceinline__ f32x4 unpk4(v2u w) { return (f32x4){bflo(w.x), bfhi(w.x), bflo(w.y), bfhi(w.y)}; }
__device__ __forceinline__ v2u pk4(f32x4 v) { v2u o; o.x = pk2(v.x, v.y); o.y = pk2(v.z, v.w); return o; }
__device__ __forceinline__ f32x4 ldz4(const bf16* p, bool ok) { return ok ? unpk4(*(const GAS v2u*)p) : (f32x4){0.f, 0.f, 0.f, 0.f}; }

__device__ __forceinline__ void p4_prep(Frame& F) {
    const int gw = F.bid * 8 + F.wave, NGW = F.G * 8, lane = F.lane;
    const bf16* Z = wsp<bf16>(F, WS_Z); const bf16* EA = wsp<bf16>(F, WS_EA); bf16* SI = wsp<bf16>(F, WS_SI);
    bf16* UT = wsp<bf16>(F, WS_UT); bf16* X0T = wsp<bf16>(F, WS_X0T); float* BS = wsp<float>(F, WS_BS);
    const float* cw = F.in[I_CONVW]; const float* cb = F.in[I_CONVB];
    constexpr int NU_LAT = 16 * 64 * 8, NU = NU_LAT + 16 * 8 * 4;
    for (int u = gw; u < NU; u += NGW) {
        int b, chunk, slice; bool lat;
        if (u < NU_LAT) { lat = true; b = u / 512; const int rem = u % 512; chunk = rem / 8; slice = rem % 8; }
        else { lat = false; const int v = u - NU_LAT; b = v / 32; chunk = (v % 32) / 4; slice = 4 + (v % 4); }
        const int Ls = lat ? SEQ : CTXL, rowbase = lat ? b * SEQ : NLAT + b * CTXL, t0 = chunk * 32;
        if (slice < 4) {
            const int c0 = 256 * slice + 4 * lane;
            f32x4 w[3][3], bi[3];
#pragma unroll
            for (int a = 0; a < 3; ++a) { bi[a] = *(const GAS f32x4*)(cb + a * 1024 + c0);
#pragma unroll
                for (int tp = 0; tp < 3; ++tp) w[a][tp] = *(const GAS f32x4*)(cw + (size_t)tp * PW + a * 1024 + c0); }
            f32x4 pv[3], cu[3], nx[3];
#pragma unroll
            for (int a = 0; a < 3; ++a) { pv[a] = ldz4(Z + (size_t)(rowbase + t0 - 1) * PW + a * 1024 + c0, t0 > 0); cu[a] = ldz4(Z + (size_t)(rowbase + t0) * PW + a * 1024 + c0, true); }
            for (int g8 = 0; g8 < 4; ++g8) {
                float x0v[4][8], uv[4][8];
#pragma unroll
                for (int i = 0; i < 8; ++i) { const int t = t0 + 8 * g8 + i;
                    f32x4 zc[3];
#pragma unroll
                    for (int a = 0; a < 3; ++a) { nx[a] = ldz4(Z + (size_t)(rowbase + t + 1) * PW + a * 1024 + c0, t + 1 < Ls);
                        zc[a] = pv[a] * w[a][0] + cu[a] * w[a][1] + nx[a] * w[a][2] + bi[a]; pv[a] = cu[a]; cu[a] = nx[a]; }
                    const f32x4 uu = zc[2] * zc[1];
#pragma unroll
                    for (int j = 0; j < 4; ++j) { x0v[j][i] = zc[0][j]; uv[j][i] = uu[j]; } }
#pragma unroll
                for (int j = 0; j < 4; ++j) { const size_t o = ((size_t)(c0 + j) * 16 + b) * SEQ + t0 + 8 * g8;
                    v4u a, c; a.x = pk2(x0v[j][0], x0v[j][1]); a.y = pk2(x0v[j][2], x0v[j][3]); a.z = pk2(x0v[j][4], x0v[j][5]); a.w = pk2(x0v[j][6], x0v[j][7]);
                    c.x = pk2(uv[j][0], uv[j][1]); c.y = pk2(uv[j][2], uv[j][3]); c.z = pk2(uv[j][4], uv[j][5]); c.w = pk2(uv[j][6], uv[j][7]);
                    *(GAS v4u*)(X0T + o) = a; *(GAS v4u*)(UT + o) = c; }
            }
        } else {
            const int q = slice - 4, c0 = 256 * q + 4 * lane;
            f32x4 w[3][3], bi[3];
#pragma unroll
            for (int a = 0; a < 3; ++a) { bi[a] = *(const GAS f32x4*)(cb + 3072 + a * 1024 + c0);
#pragma unroll
                for (int tp = 0; tp < 3; ++tp) w[a][tp] = *(const GAS f32x4*)(cw + (size_t)tp * PW + 3072 + a * 1024 + c0); }
            const f32x4 kkw = *(const GAS f32x4*)(F.in[I_RKK] + c0), kaw = *(const GAS f32x4*)(F.in[I_RKA] + c0), rkw = *(const GAS f32x4*)(F.in[I_RRK] + c0);
            f32x4 pv[3], cu[3], nx[3];
#pragma unroll
            for (int a = 0; a < 3; ++a) { pv[a] = ldz4(Z + (size_t)(rowbase + t0 - 1) * PW + 3072 + a * 1024 + c0, t0 > 0); cu[a] = ldz4(Z + (size_t)(rowbase + t0) * PW + 3072 + a * 1024 + c0, true); }
            for (int i = 0; i < 32; ++i) { const int t = t0 + i, row = rowbase + t;
                f32x4 zc[3];
#pragma unroll
                for (int a = 0; a < 3; ++a) { nx[a] = ldz4(Z + (size_t)(row + 1) * PW + 3072 + a * 1024 + c0, t + 1 < Ls);
                    zc[a] = pv[a] * w[a][0] + cu[a] * w[a][1] + nx[a] * w[a][2] + bi[a]; pv[a] = cu[a]; cu[a] = nx[a]; }
                const f32x4 a0 = unpk4(*(const GAS v2u*)(EA + (size_t)row * NLORA + 2048 + c0)), a1 = unpk4(*(const GAS v2u*)(EA + (size_t)row * NLORA + 3072 + c0));
                const f32x4 zr = zc[0], zk = zc[1], zv = zc[2];
                const f32x4 kk = zk * kkw;
                const float n2 = row16_sum((kk.x * kk.x + kk.y * kk.y) + (kk.z * kk.z + kk.w * kk.w));
                const float inv = 1.0f / fmaxf(sqrtf(n2), 1e-12f);
                const f32x4 kkn = kk * inv;
                const f32x4 kd0 = zk * (1.0f + (a0 - 1.0f) * kaw), kd1 = zk * (1.0f + (a1 - 1.0f) * kaw);
                const f32x4 b0 = kkn * a0, b1 = kkn * a1;
                const f32x4 bt = zr * (kd0 + kd1) * rkw;
                const float bsum = row16_sum((bt.x + bt.y) + (bt.z + bt.w));
                bf16* so = SI + (size_t)row * SIW + c0;
                *(GAS v2u*)(so) = pk4(zr); *(GAS v2u*)(so + 1024) = pk4(zv); *(GAS v2u*)(so + 2048) = pk4(kkn);
                *(GAS v2u*)(so + 3072) = pk4(b0); *(GAS v2u*)(so + 4096) = pk4(kd0); *(GAS v2u*)(so + 5120) = pk4(b1); *(GAS v2u*)(so + 6144) = pk4(kd1);
                if (lat && (lane & 15) == 0) BS[(size_t)row * 16 + 4 * q + (lane >> 4)] = bsum;
            }
        }
    }
}

__device__ __forceinline__ int scan_row(int s, int dir, int b) {
    return s < CTXL ? NLAT + b * CTXL + (dir ? CTXL - 1 - s : s) : b * SEQ + (dir ? SEQ - 1 - (s - CTXL) : (s - CTXL));
}
__device__ __forceinline__ void p5_scan(Frame& F) {
    const int cwv = F.wave >> 2, w4 = F.wave & 3, lane = F.lane, tc = F.tid & 255, rg = lane >> 4, kc = lane & 15;
    const bf16* SI = wsp<bf16>(F, WS_SI); const bf16* EA = wsp<bf16>(F, WS_EA); float* YS = wsp<float>(F, WS_YS);
    for (int cp = F.bid; cp < 256; cp += F.G) {
        const int chain = cp * 2 + cwv, dir = chain >> 8, b = (chain >> 4) & 15, h = chain & 15;
        LAS float* buf0 = (LAS float*)(F.lds + cwv * 49152);
        const int sl = tc >> 4, jj = tc & 15, coff = h * 64 + 4 * jj;
        v2u ld[6];
#define SCAN_ISSUE(ck_) do { const int row_ = scan_row((ck_) * 16 + sl, dir, b); const bf16* sr_ = SI + (size_t)row_ * SIW + coff; \
            ld[0] = *(const GAS v2u*)(sr_ + 2048); ld[1] = *(const GAS v2u*)(EA + (size_t)row_ * NLORA + dir * 1024 + coff); ld[2] = *(const GAS v2u*)(sr_ + 3072 + dir * 2048); \
            ld[3] = *(const GAS v2u*)(sr_ + 4096 + dir * 2048); ld[4] = *(const GAS v2u*)(sr_); ld[5] = *(const GAS v2u*)(sr_ + 1024); } while (0)
#define SCAN_COMMIT(p_) do { LAS float* d_ = buf0 + (p_) * 6144 + sl * 384 + 4 * jj; \
            const f32x4 kk_ = unpk4(ld[0]), e_ = unpk4(ld[1]); \
            *(LAS f32x4*)(d_) = -kk_; \
            *(LAS f32x4*)(d_ + 64) = (f32x4){__expf(-e_.x), __expf(-e_.y), __expf(-e_.z), __expf(-e_.w)}; \
            *(LAS f32x4*)(d_ + 128) = unpk4(ld[2]); *(LAS f32x4*)(d_ + 192) = unpk4(ld[3]); *(LAS f32x4*)(d_ + 256) = unpk4(ld[4]); *(LAS f32x4*)(d_ + 320) = unpk4(ld[5]); } while (0)
        f32x4 S[4];
#pragma unroll
        for (int i = 0; i < 4; ++i) S[i] = (f32x4){0.f, 0.f, 0.f, 0.f};
        SCAN_ISSUE(0); SCAN_COMMIT(0); __syncthreads();
        const int v0 = 16 * w4 + 4 * rg;
        constexpr int NCK = (CTXL + SEQ) / 16;
        for (int ck = 0; ck < NCK; ++ck) {
            const int p = ck & 1;
            if (ck + 1 < NCK) SCAN_ISSUE(ck + 1);
            const LAS float* bs = buf0 + p * 6144;
#pragma unroll 4
            for (int s = 0; s < 16; ++s) {
                const LAS float* q = bs + s * 384;
                const f32x4 a4 = *(const LAS f32x4*)(q + 4 * kc), wv = *(const LAS f32x4*)(q + 64 + 4 * kc), b4 = *(const LAS f32x4*)(q + 128 + 4 * kc),
                            kd = *(const LAS f32x4*)(q + 192 + 4 * kc), r4 = *(const LAS f32x4*)(q + 256 + 4 * kc), vv = *(const LAS f32x4*)(q + 320 + v0);
                float sa[4];
#pragma unroll
                for (int i = 0; i < 4; ++i) sa[i] = row16_sum((S[i].x * a4.x + S[i].y * a4.y) + (S[i].z * a4.z + S[i].w * a4.w));
#pragma unroll
                for (int i = 0; i < 4; ++i) S[i] = S[i] * wv + sa[i] * b4 + vv[i] * kd;
                f32x4 y;
#pragma unroll
                for (int i = 0; i < 4; ++i) y[i] = row16_sum((S[i].x * r4.x + S[i].y * r4.y) + (S[i].z * r4.z + S[i].w * r4.w));
                const int sg = ck * 16 + s;
                if (sg >= CTXL && kc == 0) { const int row = scan_row(sg, dir, b); *(GAS f32x4*)(YS + ((size_t)dir * NLAT + row) * 1024 + h * 64 + v0) = y; }
            }
            if (ck + 1 < NCK) SCAN_COMMIT(p ^ 1);
            __syncthreads();
        }
    }
}

constexpr int HY_UROW = 4128, HY_GOFF = 16 * HY_UROW, HY_CS = 8208;
__device__ __forceinline__ void p6_hyena(Frame& F) {
    const int lane = F.lane, tl = lane & 15, q = lane >> 4, wave = F.wave, tid = F.tid;
    const bf16* UT = wsp<bf16>(F, WS_UT); const bf16* Gt = wsp<bf16>(F, WS_G); bf16* YCT = wsp<bf16>(F, WS_YCT);
    LAS unsigned char* lds = F.lds;
    const int r = (8 - (tl & 7)) & 7;
    const int abase = HY_GOFF + r * HY_CS + 2 * (2048 + 8 * q - (tl + r)) - 32 * (16 * wave);
    const int bbase = tl * HY_UROW + 16 * q;
    for (int c = F.bid; c < 1024; c += F.G) {
#pragma unroll
        for (int i = 0; i < 8; ++i) { const int id = tid + 512 * i, bb = id >> 8, ch = id & 255;
            const v4u v = *(const GAS v4u*)(UT + ((size_t)c * 16 + bb) * SEQ + 8 * ch); *(LAS v4u*)(lds + bb * HY_UROW + 16 * ch) = v; }
        { const v4u v = *(const GAS v4u*)(Gt + (size_t)c * 4096 + 8 * tid); *(LAS v4u*)(lds + HY_GOFF + 16 * tid) = v; }
        __syncthreads();
        { unsigned d[8]; const v4u lo = *(const LAS v4u*)(lds + HY_GOFF + 16 * tid); const v4u hi = tid < 511 ? *(const LAS v4u*)(lds + HY_GOFF + 16 * tid + 16) : (v4u){0u, 0u, 0u, 0u};
            d[0] = lo.x; d[1] = lo.y; d[2] = lo.z; d[3] = lo.w; d[4] = hi.x; d[5] = hi.y; d[6] = hi.z; d[7] = hi.w;
#pragma unroll
            for (int rr = 1; rr < 8; ++rr) { v4u o;
                if ((rr & 1) == 0) { o.x = d[rr / 2]; o.y = d[rr / 2 + 1]; o.z = d[rr / 2 + 2]; o.w = d[rr / 2 + 3]; }
                else { const int e = (rr - 1) / 2; o.x = __builtin_amdgcn_alignbit(d[e + 1], d[e], 16); o.y = __builtin_amdgcn_alignbit(d[e + 2], d[e + 1], 16);
                       o.z = __builtin_amdgcn_alignbit(d[e + 3], d[e + 2], 16); o.w = __builtin_amdgcn_alignbit(d[e + 4], d[e + 3], 16); }
                *(LAS v4u*)(lds + HY_GOFF + rr * HY_CS + 16 * tid) = o; } }
        __syncthreads();
        f32x4 acc[16]; bf16x8 P[16];
#pragma unroll
        for (int it = 0; it < 16; ++it) acc[it] = (f32x4){0.f, 0.f, 0.f, 0.f};
#pragma unroll
        for (int it = 2; it < 16; ++it) P[it] = *(const LAS bf16x8*)(lds + abase - 32 * it);
        for (int i8 = 0; i8 < 8; ++i8) {
#pragma unroll
            for (int u = 0; u < 8; ++u) {
                const int isb = i8 * 8 + u;
                const bf16x8 bf = *(const LAS bf16x8*)(lds + bbase + 64 * isb);
                P[(16 - 2 * u) & 15] = *(const LAS bf16x8*)(lds + abase + 64 * isb);
                P[(17 - 2 * u) & 15] = *(const LAS bf16x8*)(lds + abase + 64 * isb - 32);
#pragma unroll
                for (int k = 0; k < 16; ++k) { const int it = (k + 2) & 15;
                    acc[it] = __builtin_amdgcn_mfma_f32_16x16x32_bf16(P[(it - 2 * u) & 15], bf, acc[it], 0, 0, 0); }
            }
        }
#pragma unroll
        for (int it = 0; it < 16; ++it) { v2u o; o.x = pk2(acc[it].x, acc[it].y); o.y = pk2(acc[it].z, acc[it].w);
            *(GAS v2u*)(YCT + ((size_t)c * 16 + tl) * SEQ + 256 * wave + 16 * it + 4 * q) = o; }
        __syncthreads();
    }
}

__device__ __forceinline__ void p7_assemble(Frame& F) {
    const int gw = F.bid * 8 + F.wave, NGW = F.G * 8, lane = F.lane;
    bf16* A2 = wsp<bf16>(F, WS_A2);
    const bf16* YCT = wsp<bf16>(F, WS_YCT); const bf16* X0T = wsp<bf16>(F, WS_X0T); const bf16* UT = wsp<bf16>(F, WS_UT);
    const float* YS = wsp<float>(F, WS_YS); const float* BS = wsp<float>(F, WS_BS); const bf16* SI = wsp<bf16>(F, WS_SI); const bf16* EA = wsp<bf16>(F, WS_EA);
    LAS unsigned char* tile = F.lds + F.wave * 9216;
    constexpr int NU_H = 16 * 32 * 16, NU = NU_H + (NLAT / 16) * 4;
    for (int u = gw; u < NU; u += NGW) {
        if (u < NU_H) {
            const int b = u / 512, rem = u % 512, tb = rem / 16, g = rem % 16, ci = lane >> 3, tq = lane & 7;
            float val[8][8]; float ss[8];
#pragma unroll
            for (int k = 0; k < 8; ++k) ss[k] = 0.f;
#pragma unroll
            for (int i = 0; i < 8; ++i) { const int ch = g * 64 + 8 * ci + i; const size_t o = ((size_t)ch * 16 + b) * SEQ + 64 * tb + 8 * tq;
                const v4u yc = *(const GAS v4u*)(YCT + o), x0 = *(const GAS v4u*)(X0T + o), uu = *(const GAS v4u*)(UT + o); const float bias = F.in[I_HBIAS][ch];
                const unsigned ycw[4] = {yc.x, yc.y, yc.z, yc.w}, x0w[4] = {x0.x, x0.y, x0.z, x0.w}, uw[4] = {uu.x, uu.y, uu.z, uu.w};
#pragma unroll
                for (int k = 0; k < 4; ++k) { const float v0 = bflo(x0w[k]) * (bflo(ycw[k]) + bias * bflo(uw[k])), v1 = bfhi(x0w[k]) * (bfhi(ycw[k]) + bias * bfhi(uw[k]));
                    val[i][2 * k] = v0; val[i][2 * k + 1] = v1; ss[2 * k] += v0 * v0; ss[2 * k + 1] += v1 * v1; } }
#pragma unroll
            for (int k = 0; k < 8; ++k) { float s = ss[k]; s += __shfl_xor(s, 8); s += __shfl_xor(s, 16); s += __shfl_xor(s, 32); ss[k] = 1.0f / sqrtf(s * (1.0f / 64.0f) + 1e-6f); }
            float ng[8];
#pragma unroll
            for (int i = 0; i < 8; ++i) ng[i] = F.in[I_HNG][g * 64 + 8 * ci + i];
#pragma unroll
            for (int k = 0; k < 8; ++k) { v4u o; o.x = pk2(val[0][k] * ss[k] * ng[0], val[1][k] * ss[k] * ng[1]); o.y = pk2(val[2][k] * ss[k] * ng[2], val[3][k] * ss[k] * ng[3]);
                o.z = pk2(val[4][k] * ss[k] * ng[4], val[5][k] * ss[k] * ng[5]); o.w = pk2(val[6][k] * ss[k] * ng[6], val[7][k] * ss[k] * ng[7]);
                *(LAS v4u*)(tile + (8 * tq + k) * 144 + 16 * ci) = o; }
            LDS_WAIT(); asm volatile("" ::: "memory");
#pragma unroll
            for (int i = 0; i < 8; ++i) { const int t = (lane >> 3) + 8 * i, pc = lane & 7; const v4u o = *(const LAS v4u*)(tile + t * 144 + 16 * pc);
                *(GAS v4u*)(A2 + (size_t)(b * SEQ + 64 * tb + t) * D + g * 64 + 8 * pc) = o; }
            LDS_WAIT(); asm volatile("" ::: "memory");
        } else {
            const int v = u - NU_H, tk = v / 4, q = v % 4, c0 = 256 * q + 4 * lane;
            const f32x4 lg = *(const GAS f32x4*)(F.in[I_LNG] + c0), lb = *(const GAS f32x4*)(F.in[I_LNB] + c0);
            for (int i = 0; i < 16; ++i) { const int row = tk * 16 + i;
                const f32x4 y = *(const GAS f32x4*)(YS + (size_t)row * 1024 + c0) + *(const GAS f32x4*)(YS + ((size_t)NLAT + row) * 1024 + c0);
                const float mu = row16_sum((y.x + y.y) + (y.z + y.w)) * (1.0f / 64.0f);
                const f32x4 d = y - mu;
                const float var = row16_sum((d.x * d.x + d.y * d.y) + (d.z * d.z + d.w * d.w)) * (1.0f / 64.0f);
                const float rs = 1.0f / sqrtf(var + 64e-5f);
                const f32x4 vv = unpk4(*(const GAS v2u*)(SI + (size_t)row * SIW + 1024 + c0)), gt = unpk4(*(const GAS v2u*)(EA + (size_t)row * NLORA + 4096 + c0));
                const float bsc = BS[(size_t)row * 16 + 4 * q + (lane >> 4)];
                const f32x4 o = (d * rs * lg + lb + bsc * vv) * gt;
                *(GAS v2u*)(A2 + (size_t)row * D + 1024 + c0) = pk4(o); }
        }
    }
}

__device__ __forceinline__ void p9_router(Frame& F) {
    const int lane = F.lane, rw = lane & 15, q = lane >> 4, wave = F.wave;
    const float* X1 = F.out; const float* MT = wsp<float>(F, WS_MODT); bf16* H2 = wsp<bf16>(F, WS_H2); const bf16* Wr = wsp<bf16>(F, WS_WR);
    int* TOKE = wsp<int>(F, WS_TOKE); float* TOKG = wsp<float>(F, WS_TOKG); int* WCNT = wsp<int>(F, WS_WCNT); int* BCNT = wsp<int>(F, WS_BCNT);
    LAS float* lg = (LAS float*)(F.lds + wave * 2048);
    LAS int* wc = (LAS int*)(F.lds + 16384 + wave * 128);
    {
        const int gw = F.bid * 8 + wave, tok0 = gw * 16, token = tok0 + rw, b = token / SEQ;
        const float* xr = X1 + (size_t)token * D + 8 * q;
        float ss = 0.f;
        for (int ks = 0; ks < 64; ++ks) { const f32x4 a = *(const GAS f32x4*)(xr + 32 * ks), c = *(const GAS f32x4*)(xr + 32 * ks + 4);
            ss += (a.x * a.x + a.y * a.y) + (a.z * a.z + a.w * a.w) + (c.x * c.x + c.y * c.y) + (c.z * c.z + c.w * c.w); }
        ss += __shfl_xor(ss, 16); ss += __shfl_xor(ss, 32);
        const float rstd = 1.0f / sqrtf(ss * (1.0f / D) + 1e-6f);
        const float* t0 = MT + (size_t)b * 4096 + 8 * q; const float* t1 = t0 + 2048;
        f32x4 acc[2] = {(f32x4){0.f, 0.f, 0.f, 0.f}, (f32x4){0.f, 0.f, 0.f, 0.f}};
        for (int ks = 0; ks < 64; ++ks) {
            const f32x4 xa = *(const GAS f32x4*)(xr + 32 * ks), xb = *(const GAS f32x4*)(xr + 32 * ks + 4);
            const f32x4 ma = *(const GAS f32x4*)(t0 + 32 * ks), mb = *(const GAS f32x4*)(t0 + 32 * ks + 4), sa = *(const GAS f32x4*)(t1 + 32 * ks), sb = *(const GAS f32x4*)(t1 + 32 * ks + 4);
            const f32x4 ha = xa * rstd * ma + sa, hb = xb * rstd * mb + sb;
            const float hv[8] = {ha.x, ha.y, ha.z, ha.w, hb.x, hb.y, hb.z, hb.w};
            unsigned hi[8], lo[8];
#pragma unroll
            for (int j = 0; j < 8; ++j) { hi[j] = f2bf(hv[j]); lo[j] = f2bf(hv[j] - bf2f(hi[j])); }
            v4u ph, pl; ph.x = hi[0] | (hi[1] << 16); ph.y = hi[2] | (hi[3] << 16); ph.z = hi[4] | (hi[5] << 16); ph.w = hi[6] | (hi[7] << 16);
            pl.x = lo[0] | (lo[1] << 16); pl.y = lo[2] | (lo[3] << 16); pl.z = lo[4] | (lo[5] << 16); pl.w = lo[6] | (lo[7] << 16);
            *(GAS v4u*)(H2 + (size_t)token * D + 32 * ks + 8 * q) = ph;
            const bf16x8 Ah = __builtin_bit_cast(bf16x8, ph), Al = __builtin_bit_cast(bf16x8, pl);
#pragma unroll
            for (int nb = 0; nb < 2; ++nb) { const bf16* wp = Wr + (size_t)(16 * nb + rw) * D + 32 * ks + 8 * q;
                const bf16x8 Bh = *(const GAS bf16x8*)wp, Bl = *(const GAS bf16x8*)(wp + 32 * D);
                acc[nb] = __builtin_amdgcn_mfma_f32_16x16x32_bf16(Ah, Bh, acc[nb], 0, 0, 0);
                acc[nb] = __builtin_amdgcn_mfma_f32_16x16x32_bf16(Ah, Bl, acc[nb], 0, 0, 0);
                acc[nb] = __builtin_amdgcn_mfma_f32_16x16x32_bf16(Al, Bh, acc[nb], 0, 0, 0); }
        }
#pragma unroll
        for (int nb = 0; nb < 2; ++nb) { const float rb = F.in[I_ROUTB][16 * nb + rw];
#pragma unroll
            for (int j = 0; j < 4; ++j) lg[(4 * q + j) * 32 + 16 * nb + rw] = acc[nb][j] + rb; }
        if (lane < 32) wc[lane] = 0;
        LDS_WAIT(); asm volatile("" ::: "memory");
        if (lane < 16) {
            float lv[32];
#pragma unroll
            for (int e4 = 0; e4 < 8; ++e4) { const f32x4 t = *(const LAS f32x4*)(lg + lane * 32 + 4 * e4); lv[4 * e4] = t.x; lv[4 * e4 + 1] = t.y; lv[4 * e4 + 2] = t.z; lv[4 * e4 + 3] = t.w; }
            int sel[4]; float sv[4];
#pragma unroll
            for (int k = 0; k < 4; ++k) { float best = -3.0e38f; int bi = 0;
#pragma unroll
                for (int e = 0; e < 32; ++e) { bool taken = false;
#pragma unroll
                    for (int kk = 0; kk < k; ++kk) taken = taken || (sel[kk] == e);
                    if (!taken && lv[e] > best) { best = lv[e]; bi = e; } }
                sel[k] = bi; sv[k] = best; }
            const float e1 = __expf(sv[1] - sv[0]), e2 = __expf(sv[2] - sv[0]), e3 = __expf(sv[3] - sv[0]), inv = 1.0f / (1.0f + e1 + e2 + e3);
            const int tk = tok0 + lane;
            *(GAS v4u*)(TOKE + (size_t)tk * 4) = (v4u){(unsigned)sel[0], (unsigned)sel[1], (unsigned)sel[2], (unsigned)sel[3]};
            *(GAS f32x4*)(TOKG + (size_t)tk * 4) = (f32x4){inv, e1 * inv, e2 * inv, e3 * inv};
#pragma unroll
            for (int k = 0; k < 4; ++k) __hip_atomic_fetch_add(&wc[sel[k]], 1, __ATOMIC_RELAXED, __HIP_MEMORY_SCOPE_WORKGROUP);
        }
        LDS_WAIT(); asm volatile("" ::: "memory");
        if (lane < 32) WCNT[(size_t)gw * 32 + lane] = wc[lane];
        __syncthreads();
        if (wave == 0 && lane < 32) { int s = 0;
#pragma unroll
            for (int w = 0; w < 8; ++w) s += ((LAS int*)(F.lds + 16384 + w * 128))[lane];
            BCNT[F.bid * 32 + lane] = s; }
        __syncthreads();
    }
    {
        LAS float* scr = (LAS float*)(F.lds + 32768 + wave * 8448);
        const int gw = F.bid * 8 + wave, NGW = F.G * 8;
        bf16* BtGU = wsp<bf16>(F, WS_BTGU); bf16* BtD = wsp<bf16>(F, WS_BTD);
        for (int it = gw; it < NE * 6144; it += NGW) {
            const int e = it / 6144, r = it % 6144;
            if (r < 4096) { const int s = r / 2048, rr = r % 2048, kb = rr / 64, nb = rr % 64;
                tr_item((s ? F.in[I_EWU] : F.in[I_EWG]) + (size_t)e * D * D, D, 64 * kb, 32 * nb, BtGU + (size_t)e * 4096 * D, nullptr, D, 256 * (nb / 4) + 128 * s + 32 * (nb % 4), 64 * kb, scr, lane); }
            else { const int rr = r - 4096, kb = rr / 64, nb = rr % 64;
                tr_item(F.in[I_EWD] + (size_t)e * D * D, D, 64 * kb, 32 * nb, BtD + (size_t)e * D * D, nullptr, D, 32 * nb, 64 * kb, scr, lane); }
        }
    }
}

__device__ __forceinline__ void p10_sort(Frame& F) {
    const int lane = F.lane, wave = F.wave, gw = F.bid * 8 + wave;
    const int* TOKE = wsp<int>(F, WS_TOKE); const float* TOKG = wsp<float>(F, WS_TOKG); const int* WCNT = wsp<int>(F, WS_WCNT); const int* BCNT = wsp<int>(F, WS_BCNT);
    int* ETAB = wsp<int>(F, WS_ETAB); int* ROWTOK = wsp<int>(F, WS_ROWTOK); int* ROWDST = wsp<int>(F, WS_ROWDST); float* ROWGATE = wsp<float>(F, WS_ROWGATE);
    const int e = lane & 31, half = lane >> 5;
    int tot = 0, pre = 0;
    for (int bb = half; bb < 256; bb += 2) { const int c = BCNT[bb * 32 + e]; tot += c; pre += (bb < F.bid) ? c : 0; }
    tot += __shfl_xor(tot, 32); pre += __shfl_xor(pre, 32);
    for (int w = 0; w < wave; ++w) pre += WCNT[(size_t)(F.bid * 8 + w) * 32 + e];
    const int padded = ((tot + 255) / 256) * 256;
    int incl = padded;
#pragma unroll
    for (int o = 1; o < 32; o <<= 1) { const int t = __shfl_up(incl, o, 32); if (e >= o) incl += t; }
    const int pstart = incl - padded;
    if (gw == 0) {
        if (lane < 32) { ETAB[e] = pstart; ETAB[64 + e] = tot; if (e == 31) { ETAB[32] = incl; ETAB[128] = incl / 256; } }
        for (int t = lane; t < MAXTILES; t += 64) { int te = 0;
            for (int x = 0; x < 32; ++x) { const int ps = __shfl(pstart, x), pd = __shfl(padded, x); if (t * 256 >= ps && t * 256 < ps + pd) te = x; }
            ETAB[256 + t] = te; }
    }
    const int token = 16 * gw + (lane >> 2), slot = lane & 3;
    const int me = TOKE[(size_t)token * 4 + slot]; const float mg = TOKG[(size_t)token * 4 + slot];
    int rank = 0;
    for (int x = 0; x < 32; ++x) { const unsigned long long m = __ballot(me == x); if (me == x) rank = __popcll(m & ((1ull << lane) - 1ull)); }
    const int row = __shfl(pstart, me) + __shfl(pre, me) + rank;
    ROWTOK[row] = token; ROWDST[row] = token * 4 + slot; ROWGATE[row] = mg;
}

__device__ __forceinline__ void p13_final(Frame& F) {
    const int gw = F.bid * 8 + F.wave, NGW = F.G * 8, lane = F.lane;
    const float* macc = wsp<float>(F, WS_MODACC); const float* adab = F.in[I_ADAB]; const bf16* SLOT = wsp<bf16>(F, WS_SLOT);
    for (int row = gw; row < NLAT; row += NGW) {
        int l4 = 4 * lane; asm volatile("" : "+v"(l4));
        const int b = row / SEQ; float* xr = F.out + (size_t)row * D;
        f32x4 v[8]; float ss = 0.f;
#pragma unroll
        for (int j = 0; j < 8; ++j) { const int c = l4 + 256 * j;
            f32x4 m = (f32x4){0.f, 0.f, 0.f, 0.f};
#pragma unroll
            for (int s = 0; s < 4; ++s) m += unpk4(*(const GAS v2u*)(SLOT + ((size_t)row * 4 + s) * D + c));
            const f32x4 g5 = *(const GAS f32x4*)(macc + (size_t)b * 12288 + 5 * 2048 + c) + *(const GAS f32x4*)(adab + 5 * 2048 + c);
            v[j] = *(const GAS f32x4*)(xr + c) + g5 * m;
            ss += (v[j].x * v[j].x + v[j].y * v[j].y) + (v[j].z * v[j].z + v[j].w * v[j].w); }
        const float rstd = 1.0f / sqrtf(wave_sum(ss) * (1.0f / D) + 1e-6f);
#pragma unroll
        for (int j = 0; j < 8; ++j) *(GAS f32x4*)(xr + l4 + 256 * j) = v[j] * rstd * *(const GAS f32x4*)(F.in[I_FING] + l4 + 256 * j);
    }
}

constexpr int NPH = 13;
__global__ void __launch_bounds__(512, 2) mk_fwd(Args args) {
    extern __shared__ __attribute__((aligned(16))) unsigned char lds_raw[];
    Frame F;
    F.lds = (LAS unsigned char*)lds_raw; F.in = args.in; F.out = args.out; F.ws = args.ws;
    F.tid = threadIdx.x; F.lane = F.tid & 63; F.wave = __builtin_amdgcn_readfirstlane(F.tid >> 6); F.G = gridDim.x; F.bid = blockIdx.x;
    volatile LAS unsigned* MISC = (volatile LAS unsigned*)(F.lds + MISC_OFF);
    if (F.tid < 32) MISC[F.tid] = 0u;
    __syncthreads();
    const int lo = args.ph_lo, hi = args.ph_hi;
    unsigned* ctl = (unsigned*)(F.ws + WS_CTL);
    XcdBarrier bar; bar.bar = ctl + CW_BAR; bar.x = 0; bar.st = nullptr;
    if (hi - lo > 1) bar = xcd_barrier_post(ctl + CW_BAR, MISC + 8);
#ifndef PH_MASK
#define PH_MASK 0x1FFF
#endif
#define IN(k) (((PH_MASK >> (k)) & 1) && lo <= (k) && (k) < hi)
#define SEAM(k) do { if (IN(k) && IN((k) + 1)) xcd_barrier(bar); } while (0)

    if (IN(0)) { p0_adaln(F); p0_small_weights(F); p0_filter(F); }
    SEAM(0);
    if (IN(1)) { p1_norm1(F); }
    SEAM(1);
    if (IN(2)) {
        pg8::Gemm g{wsp<bf16>(F, WS_A1), wsp<bf16>(F, WS_BTIN), D, 0};
        pg8::InProjOrder S{F.G, F.bid};
        pg8::EpiInProj E{wsp<bf16>(F, WS_Z), wsp<bf16>(F, WS_AP)};
        pg8::gemm_phase<false>(F.lds, g, S, E);
    }
    SEAM(2);
    if (IN(3)) {
        pg8::Gemm g{wsp<bf16>(F, WS_AP), wsp<bf16>(F, WS_BTL), KLORA, 0};
        pg8::StaticOrder S; S.init(MROWS, NLORA, F.G, F.bid);
        pg8::EpiLora E{wsp<bf16>(F, WS_EA), F.in[I_RW0], F.in[I_RA0]};
        pg8::gemm_phase<false>(F.lds, g, S, E);
    }
    SEAM(3);
    if (IN(4)) { p4_prep(F); }
    SEAM(4);
    if (IN(5)) { p5_scan(F); p6_hyena(F); }
    SEAM(5);
    if (IN(6)) { p7_assemble(F); }
    SEAM(6);
    if (IN(7)) {
        pg8::Gemm g{wsp<bf16>(F, WS_A2), wsp<bf16>(F, WS_BTOUT), D, 0};
        pg8::StaticOrder S; S.init(NLAT, D, F.G, F.bid);
        pg8::EpiOutProj E{F.in[I_X], F.out, wsp<float>(F, WS_MODACC), F.in[I_ADAB]};
        pg8::gemm_phase<false>(F.lds, g, S, E);
    }
    SEAM(7);
    if (IN(8)) { p9_router(F); }
    SEAM(8);
    if (IN(9)) { p10_sort(F); }
    SEAM(9);
    if (IN(10)) {
        const int* ET = wsp<int>(F, WS_ETAB);
        pg8::Gemm g{wsp<bf16>(F, WS_H2), wsp<bf16>(F, WS_BTGU), D, (size_t)4096 * D * 2};
        pg8::MoeOrder S{F.G, F.bid, 16, ET[128], ET + 256, wsp<int>(F, WS_ROWTOK), ET, ET + 64};
        pg8::EpiSwiglu E{wsp<bf16>(F, WS_ACT), F.in[I_EBG], F.in[I_EBU]};
        pg8::gemm_phase<true>(F.lds, g, S, E);
    }
    SEAM(10);
    if (IN(11)) {
        const int* ET = wsp<int>(F, WS_ETAB);
        pg8::Gemm g{wsp<bf16>(F, WS_ACT), wsp<bf16>(F, WS_BTD), D, (size_t)D * D * 2};
        pg8::MoeOrder S{F.G, F.bid, 8, ET[128], ET + 256, wsp<int>(F, WS_ROWTOK), ET, ET + 64};
        pg8::EpiDown E{wsp<bf16>(F, WS_SLOT), F.in[I_EBD], wsp<int>(F, WS_ROWDST), wsp<float>(F, WS_ROWGATE), ET, ET + 64};
        pg8::gemm_phase<false>(F.lds, g, S, E);
    }
    SEAM(11);
    if (IN(12)) { p13_final(F); }
#undef IN
#undef SEAM
}

extern "C" void kernel_launch(void* const* d_in, const int* in_sizes, int n_in, void* d_out, int out_size, void* d_ws, size_t ws_size, hipStream_t stream) {
    static int grid = 0;
    if (grid == 0) {
        if (n_in != 44 || out_size != NLAT * D || ws_size < WS_END) { fprintf(stderr, "kernel_launch: unexpected problem (n_in %d, out %d, ws %zu)\n", n_in, out_size, ws_size); grid = -1; return; }
        if (hipFuncSetAttribute((const void*)mk_fwd, hipFuncAttributeMaxDynamicSharedMemorySize, LDS_BYTES) != hipSuccess) { fprintf(stderr, "kernel_launch: hipFuncSetAttribute failed\n"); grid = -1; return; }
        int per_cu = 0;
        if (hipOccupancyMaxActiveBlocksPerMultiprocessor(&per_cu, (const void*)mk_fwd, 512, LDS_BYTES) != hipSuccess || per_cu < 1) fprintf(stderr, "kernel_launch: occupancy query says %d blocks per CU\n", per_cu);
        (void)hipGetLastError();
        grid = 256;
    }
    if (grid < 0) return;
    (void)hipMemsetAsync((char*)d_ws + WS_CTL, 0, CTL_ZERO_BYTES, stream);
    Args a{};
    for (int i = 0; i < 44; ++i) a.in[i] = (const float*)d_in[i];
    a.out = (float*)d_out; a.ws = (unsigned char*)d_ws;
#if MK_PER_PHASE
    for (int ph = 0; ph < NPH; ++ph) { a.ph_lo = ph; a.ph_hi = ph + 1; hipLaunchKernelGGL(mk_fwd, dim3(grid), dim3(512), LDS_BYTES, stream, a); }
#else
    a.ph_lo = 0; a.ph_hi = NPH;
    hipLaunchKernelGGL(mk_fwd, dim3(grid), dim3(512), LDS_BYTES, stream, a);
#endif
    const hipError_t le = hipPeekAtLastError();
    if (le != hipSuccess) fprintf(stderr, "kernel_launch: launch failed: %s\n", hipGetErrorName(le));
}
```

```cpp
#include <hip/hip_runtime.h>
#include <cstdio>
#include <cstdint>

#ifndef MK_PER_PHASE
#define MK_PER_PHASE 0
#endif

#define GAS __attribute__((address_space(1)))
#define LAS __attribute__((address_space(3)))
typedef unsigned short bf16;
typedef unsigned v4u __attribute__((ext_vector_type(4)));
typedef unsigned v2u __attribute__((ext_vector_type(2)));
typedef float f32x4 __attribute__((ext_vector_type(4)));
typedef float f32x2 __attribute__((ext_vector_type(2)));
typedef short bf16x8 __attribute__((ext_vector_type(8)));

constexpr int NB = 16, SEQ = 2048, CTXL = 256, D = 2048;
constexpr int NLAT = NB * SEQ;
constexpr int NCTX = NB * CTXL;
constexpr int MROWS = NLAT + NCTX;
constexpr int PW = 6144;
constexpr int NIN = 6656;
constexpr int NLORA = 5120, KLORA = 512;
constexpr int NE = 32, TOPK = 4;
constexpr int NASG = NLAT * TOPK;
constexpr int MAXTILES = NASG / 256 + NE;
constexpr int SIW = 7168;

constexpr size_t MiB = 1u << 20;
constexpr size_t WS_CTL = 0;
constexpr size_t WS_MODACC = 1 * MiB;
constexpr size_t CTL_ZERO_BYTES = 2 * MiB;
constexpr size_t WS_MODT = 2 * MiB;
constexpr size_t WS_BS = 3 * MiB;
constexpr size_t WS_TOKE = 5 * MiB;
constexpr size_t WS_TOKG = 6 * MiB;
constexpr size_t WS_WCNT = 7 * MiB;
constexpr size_t WS_BCNT = 7 * MiB + 512 * 1024;
constexpr size_t WS_ETAB = 7 * MiB + 768 * 1024;
constexpr size_t WS_ROWTOK = 8 * MiB;
constexpr size_t WS_ROWDST = 9 * MiB;
constexpr size_t WS_ROWGATE = 10 * MiB;
constexpr size_t WS_G = 16 * MiB;
constexpr size_t WS_BTIN = 24 * MiB;
constexpr size_t WS_BTL = 50 * MiB;
constexpr size_t WS_BTOUT = 55 * MiB;
constexpr size_t WS_WR = 63 * MiB;
constexpr size_t WS_A1 = 64 * MiB;
constexpr size_t WS_Z = 208 * MiB;
constexpr size_t WS_AP = 640 * MiB;
constexpr size_t WS_EA = 676 * MiB;
constexpr size_t WS_SI = 1036 * MiB;
constexpr size_t WS_UT = 1540 * MiB;
constexpr size_t WS_X0T = 1604 * MiB;
constexpr size_t WS_YCT = 1668 * MiB;
constexpr size_t WS_YS = 64 * MiB;
constexpr size_t WS_A2 = 320 * MiB;
constexpr size_t WS_H2 = 64 * MiB;
constexpr size_t WS_BTGU = 192 * MiB;
constexpr size_t WS_BTD = 704 * MiB;
constexpr size_t WS_ACT = 960 * MiB;
constexpr size_t WS_SLOT = 1504 * MiB;
constexpr size_t WS_END = 2016 * MiB;

constexpr int CW_TMO = 0;
constexpr int CW_BAR = 4096;

constexpr int LDS_BYTES = 147456;
constexpr int MISC_OFF = 143360;

__device__ __forceinline__ unsigned f2bf(float f) { unsigned u = __builtin_bit_cast(unsigned, f); return (u + 0x7fffu + ((u >> 16) & 1u)) >> 16; }
__device__ __forceinline__ unsigned pk2(float lo, float hi) { return f2bf(lo) | (f2bf(hi) << 16); }
__device__ __forceinline__ float bf2f(unsigned b) { return __builtin_bit_cast(float, b << 16); }
__device__ __forceinline__ float bflo(unsigned w) { return __builtin_bit_cast(float, w << 16); }
__device__ __forceinline__ float bfhi(unsigned w) { return __builtin_bit_cast(float, w & 0xffff0000u); }
__device__ __forceinline__ float fsigmoid(float x) { return 1.0f / (1.0f + __expf(-x)); }
__device__ __forceinline__ float ftanh(float x) { const float e = __expf(2.0f * x); return 1.0f - 2.0f / (e + 1.0f); }
#define LDS_WAIT() asm volatile("s_waitcnt lgkmcnt(0)" ::: "memory")
#define VM_WAIT() asm volatile("s_waitcnt vmcnt(0)" ::: "memory")

#define XB_TMO      128
#define XB_XCNT(j)  (256  + 64 * (j))
#define XB_XSUB(j)  (1280 + 64 * (j))
#define XB_XGEN(j)  (2304 + 64 * (j))
#define XB_TOP      3328
#define XB_TOPGEN   3392
#define XCD_BAR_WORDS 3456
#define XB_SPIN_CAP (1u << 20)

__device__ __forceinline__ unsigned xb_ld(unsigned* p)              { return __hip_atomic_load(p, __ATOMIC_RELAXED, __HIP_MEMORY_SCOPE_AGENT); }
__device__ __forceinline__ unsigned xb_add(unsigned* p, unsigned v) { return __hip_atomic_fetch_add(p, v, __ATOMIC_RELAXED, __HIP_MEMORY_SCOPE_AGENT); }
__device__ __forceinline__ unsigned xb_xcc_id() { return (unsigned)__builtin_amdgcn_s_getreg((3 << 11) | 20) & 0xFu; }
#define XB_SPIN(cond, bar) do { unsigned _sp = 0; while (cond) { __builtin_amdgcn_s_sleep(1); \
    if ((++_sp & 255u) == 0u) { if (xb_ld(&(bar)[XB_TMO])) break; if (_sp > XB_SPIN_CAP) { atomicAdd(&(bar)[XB_TMO], 1u); break; } } } } while (0)

struct XcdBarrier { unsigned* bar; unsigned x; volatile LAS unsigned* st; };

__device__ __forceinline__ XcdBarrier xcd_barrier_post(unsigned* bar, volatile LAS unsigned* st) {
    XcdBarrier b; b.bar = bar; b.x = xb_xcc_id(); b.st = st;
    if (threadIdx.x == 0) (void)xb_add(&bar[XB_XCNT(b.x)], 1u);
    return b;
}
__device__ __forceinline__ void xcd_barrier_complete(unsigned* bar, unsigned x, unsigned& nloc, unsigned& nx) {
    const unsigned G = gridDim.x * gridDim.y * gridDim.z;
    unsigned sum, cnt, mine, sp = 0u;
    for (;;) {
        sum = 0u; cnt = 0u; mine = 0u;
#pragma unroll
        for (unsigned j = 0; j < 16; ++j) { const unsigned c = xb_ld(&bar[XB_XCNT(j)]); sum += c; cnt += (c > 0u) ? 1u : 0u; mine = (j == x) ? c : mine; }
        if (sum == G) break;
        __builtin_amdgcn_s_sleep(1);
        if ((++sp & 255u) == 0u) { if (xb_ld(&bar[XB_TMO])) break; if (sp > XB_SPIN_CAP) { atomicAdd(&bar[XB_TMO], 1u); break; } }
    }
    nloc = mine > 0u ? mine : 1u; nx = cnt > 0u ? cnt : 1u;
}
__device__ __forceinline__ void xcd_barrier(const XcdBarrier& b) {
    asm volatile("s_waitcnt vmcnt(0)" ::: "memory");
    __syncthreads();
    if (threadIdx.x == 0) {
        unsigned* bar = b.bar;
        __builtin_amdgcn_s_waitcnt(0);
        unsigned nloc = b.st[0], nx = b.st[1];
        if (nloc == 0u) { xcd_barrier_complete(bar, b.x, nloc, nx); b.st[0] = nloc; b.st[1] = nx; }
        const unsigned old = xb_add(&bar[XB_XSUB(b.x)], 1u);
        const unsigned gen = old / nloc;
        if (old + 1u == (gen + 1u) * nloc) {
            __builtin_amdgcn_fence(__ATOMIC_RELEASE, "agent");
            asm volatile("s_waitcnt vmcnt(0)" ::: "memory");
            const unsigned og = xb_add(&bar[XB_TOP], 1u);
            const unsigned tg = og / nx;
            if (og + 1u == (tg + 1u) * nx) xb_add(&bar[XB_TOPGEN], 1u);
            else XB_SPIN(xb_ld(&bar[XB_TOPGEN]) == tg, bar);
            __builtin_amdgcn_fence(__ATOMIC_ACQUIRE, "agent");
            xb_add(&bar[XB_XGEN(b.x)], 1u);
            asm volatile("s_waitcnt vmcnt(0)" ::: "memory");
        } else {
            XB_SPIN(xb_ld(&bar[XB_XGEN(b.x)]) == gen, bar);
            __builtin_amdgcn_fence(__ATOMIC_ACQUIRE, "agent");
            asm volatile("s_waitcnt vmcnt(0)" ::: "memory");
        }
    }
    __syncthreads();
}

namespace pg8 {
constexpr int BM = 256, BK = 64, HALF = 128, HTB = HALF * BK * 2, STAGE_BYTES = 8 * HTB, NXCD = 8, WGM = 8;
__device__ __forceinline__ int lds_byte(int r, int c) { const int st = (r >> 4) * 2 + (c >> 5), rr = r & 15, cc = c & 31, ob = rr * 64 + cc * 2; return st * 1024 + (ob ^ (((ob >> 9) & 1) << 5)); }
__device__ __forceinline__ void stage_rc(int b, int& R, int& C) { const int st = b / 1024, sb = b % 1024, swz = sb ^ (((sb >> 9) & 1) << 5); R = (st >> 1) * 16 + swz / 64; C = (st & 1) * 32 + (swz % 64) / 2; }
__device__ __forceinline__ int perm32(int rho) { const int n = rho >> 4, i = rho & 15; return 8 * (i >> 2) + 4 * n + (i & 3); }

struct Unit { int pm, pn, e; };
struct Gemm { const bf16* A; const bf16* Bt; int K; size_t bstrideE; };

__device__ __forceinline__ unsigned cvt_pk_bf16(float lo, float hi) { unsigned r; asm volatile("v_cvt_pk_bf16_f32 %0, %1, %2" : "=v"(r) : "v"(lo), "v"(hi)); return r; }

template <bool GATHER, class Epi, class Sched>
__device__ __forceinline__ void gemm_phase(LAS unsigned char* lds, const Gemm g, const Sched& S, const Epi& E) {
    const int tid = threadIdx.x, wid = __builtin_amdgcn_readfirstlane(tid >> 6), lane = tid & 63, wr = wid >> 2, wc = wid & 3, fr = lane & 15, fq = lane >> 4;
    const int K = g.K, nt = K / BK;
    unsigned voffB[2]; int RA[2], CA[2];
#pragma unroll
    for (int i = 0; i < 2; ++i) { int R, C; stage_rc(tid * 16 + i * 8192, R, C); const int Rb = Epi::PERM ? ((R & ~31) + perm32(R & 31)) : R;
        RA[i] = R; CA[i] = C; voffB[i] = (unsigned)(Rb * K + C) * 2u; }
    const size_t kstep = (size_t)(BK * 2);
    const size_t hstep = (size_t)HALF * K * 2;
    const size_t tstep = 2 * hstep;
    const unsigned ldsw = (unsigned)wid * 1024u;
    const int aoff = lds_byte(wr * 64 + fr, fq * 8), boff = lds_byte(wc * 32 + fr, fq * 8);
#define PG8_SA(b, h) (((b) * 2 + (h)) * HTB)
#define PG8_SB(b, h) ((4 + (b) * 2 + (h)) * HTB)
#define PG8_STAGE(bufoff, gbase, voff) do { _Pragma("unroll") for (int _i = 0; _i < 2; ++_i) \
        __builtin_amdgcn_global_load_lds((const unsigned*)((const char*)(gbase) + (voff)[_i]), (LAS unsigned*)(lds + (bufoff) + ldsw + _i * 8192), 16, 0, 0); } while (0)
#define PG8_LDA(dst, b, h) do { _Pragma("unroll") for (int m = 0; m < 4; ++m) _Pragma("unroll") for (int k = 0; k < 2; ++k) dst[m][k] = *(const LAS bf16x8*)(lds + PG8_SA(b, h) + aoff + m * 2048 + k * 1024); } while (0)
#define PG8_LDB(dst, b, h) do { _Pragma("unroll") for (int n = 0; n < 2; ++n) _Pragma("unroll") for (int k = 0; k < 2; ++k) dst[n][k] = *(const LAS bf16x8*)(lds + PG8_SB(b, h) + boff + n * 2048 + k * 1024); } while (0)
#define PG8_MMA(ai, bj, At, Bt) do { __builtin_amdgcn_s_setprio(1); _Pragma("unroll") for (int m = 0; m < 4; ++m) _Pragma("unroll") for (int n = 0; n < 2; ++n) _Pragma("unroll") for (int k = 0; k < 2; ++k) \
        acc[ai][bj][m][n] = __builtin_amdgcn_mfma_f32_16x16x32_bf16(Bt[n][k], At[m][k], acc[ai][bj][m][n], 0, 0, 0); __builtin_amdgcn_s_setprio(0); } while (0)
#define PG8_WAIT_V(n) asm volatile("s_waitcnt vmcnt(" #n ")" ::: "memory")
#define PG8_WAIT_L(n) asm volatile("s_waitcnt lgkmcnt(" #n ")" ::: "memory")
#define PG8_BAR __builtin_amdgcn_s_barrier()
#define PG8_SCHED __builtin_amdgcn_sched_barrier(0)
    Unit cur, nxt; int ui = 0;
    if (!S.next(0, cur)) return;
    f32x4 acc[2][2][4][2];
#pragma unroll
    for (int a = 0; a < 2; ++a)
#pragma unroll
        for (int b = 0; b < 2; ++b)
#pragma unroll
            for (int m = 0; m < 4; ++m)
#pragma unroll
                for (int n = 0; n < 2; ++n) acc[a][b][m][n] = (f32x4){0.f, 0.f, 0.f, 0.f};
    bf16x8 At[4][2], B0[2][2], B1[2][2];
    unsigned vA0[2], vA1[2], vN0[2], vN1[2];
    const char* cA; const char* cB;
    if constexpr (GATHER) {
        cA = (const char*)g.A;
#pragma unroll
        for (int i = 0; i < 2; ++i) { vA0[i] = (unsigned)(S.arow(cur, RA[i]) * K + CA[i]) * 2u; vA1[i] = (unsigned)(S.arow(cur, HALF + RA[i]) * K + CA[i]) * 2u; }
    } else {
        cA = (const char*)g.A + (size_t)cur.pm * tstep;
#pragma unroll
        for (int i = 0; i < 2; ++i) { vA0[i] = (unsigned)(RA[i] * K + CA[i]) * 2u; vA1[i] = vA0[i] + (unsigned)hstep; }
    }
#pragma unroll
    for (int i = 0; i < 2; ++i) { vN0[i] = vA0[i]; vN1[i] = vA1[i]; }
    cB = (const char*)g.Bt + (size_t)cur.e * g.bstrideE + (size_t)cur.pn * tstep;
    PG8_STAGE(PG8_SB(0, 0), cB, voffB); PG8_STAGE(PG8_SA(0, 0), cA, vA0); PG8_STAGE(PG8_SB(0, 1), cB + hstep, voffB); PG8_STAGE(PG8_SA(0, 1), cA, vA1);
    if (wr == 1) PG8_BAR;
    PG8_WAIT_V(4); PG8_BAR;
    PG8_STAGE(PG8_SB(1, 0), cB + kstep, voffB); PG8_STAGE(PG8_SA(1, 0), cA + kstep, vA0); PG8_STAGE(PG8_SB(1, 1), cB + hstep + kstep, voffB);
    PG8_WAIT_V(6); PG8_BAR;
    for (;;) {
        const bool has_next = S.next(ui + 1, nxt);
        const char* nA; const char* nB;
        if (has_next) {
            nB = (const char*)g.Bt + (size_t)nxt.e * g.bstrideE + (size_t)nxt.pn * tstep;
            if constexpr (GATHER) { nA = cA;
#pragma unroll
                for (int i = 0; i < 2; ++i) { vN0[i] = (unsigned)(S.arow(nxt, RA[i]) * K + CA[i]) * 2u; vN1[i] = (unsigned)(S.arow(nxt, HALF + RA[i]) * K + CA[i]) * 2u; }
            } else nA = (const char*)g.A + (size_t)nxt.pm * tstep;
        } else { nA = cA; nB = cB;
#pragma unroll
            for (int i = 0; i < 2; ++i) { vN0[i] = vA0[i]; vN1[i] = vA1[i]; } }
        for (int t = 0; t < nt; t += 2) {
            const bool last = (t == nt - 2);
            const char* a1 = cA + (size_t)(t + 1) * kstep;
            const char* a2 = last ? nA : cA + (size_t)(t + 2) * kstep; const char* b2 = last ? nB : cB + (size_t)(t + 2) * kstep;
            const char* a3 = a2 + kstep; const char* b3 = b2 + kstep;
            unsigned w0[2], w1[2];
#pragma unroll
            for (int i = 0; i < 2; ++i) { if constexpr (GATHER) { w0[i] = last ? vN0[i] : vA0[i]; w1[i] = last ? vN1[i] : vA1[i]; } else { w0[i] = vA0[i]; w1[i] = vA1[i]; } }
            PG8_LDB(B0, 0, 0); PG8_SCHED; PG8_LDA(At, 0, 0); PG8_STAGE(PG8_SA(1, 1), a1, vA1);
            PG8_WAIT_L(8); PG8_BAR; PG8_WAIT_L(0); PG8_MMA(0, 0, At, B0); PG8_BAR; PG8_SCHED;
            PG8_LDB(B1, 0, 1); PG8_STAGE(PG8_SB(0, 0), b2, voffB);
            PG8_BAR; PG8_WAIT_L(0); PG8_MMA(0, 1, At, B1); PG8_BAR;
            PG8_LDA(At, 0, 1); PG8_STAGE(PG8_SA(0, 0), a2, w0);
            PG8_BAR; PG8_WAIT_L(0); PG8_MMA(1, 0, At, B0); PG8_BAR; PG8_SCHED;
            PG8_STAGE(PG8_SB(0, 1), b2 + hstep, voffB);
            PG8_WAIT_V(6); PG8_BAR; PG8_MMA(1, 1, At, B1); PG8_BAR;
            PG8_LDB(B0, 1, 0); PG8_SCHED; PG8_LDA(At, 1, 0); PG8_STAGE(PG8_SA(0, 1), a2, w1);
            PG8_WAIT_L(8); PG8_BAR; PG8_WAIT_L(0); PG8_MMA(0, 0, At, B0); PG8_BAR; PG8_SCHED;
            PG8_LDB(B1, 1, 1); PG8_STAGE(PG8_SB(1, 0), b3, voffB);
            PG8_BAR; PG8_WAIT_L(0); PG8_MMA(0, 1, At, B1); PG8_BAR;
            PG8_LDA(At, 1, 1); PG8_STAGE(PG8_SA(1, 0), a3, w0);
            PG8_BAR; PG8_WAIT_L(0); PG8_MMA(1, 0, At, B0); PG8_BAR; PG8_SCHED;
            PG8_STAGE(PG8_SB(1, 1), b3 + hstep, voffB);
            PG8_WAIT_V(6); PG8_BAR; PG8_MMA(1, 1, At, B1); PG8_BAR;
        }
        E(acc, cur, wr, wc, fr, fq);
        if (!has_next) break;
#pragma unroll
        for (int a = 0; a < 2; ++a)
#pragma unroll
            for (int b = 0; b < 2; ++b)
#pragma unroll
                for (int m = 0; m < 4; ++m)
#pragma unroll
                    for (int n = 0; n < 2; ++n) acc[a][b][m][n] = (f32x4){0.f, 0.f, 0.f, 0.f};
        cur = nxt; cA = nA; cB = nB; ++ui;
#pragma unroll
        for (int i = 0; i < 2; ++i) { vA0[i] = vN0[i]; vA1[i] = vN1[i]; }
    }
    PG8_WAIT_V(0);
    if (wr == 0) PG8_BAR;
    PG8_BAR;
#undef PG8_SA
#undef PG8_SB
#undef PG8_STAGE
#undef PG8_LDA
#undef PG8_LDB
#undef PG8_MMA
#undef PG8_WAIT_V
#undef PG8_WAIT_L
#undef PG8_BAR
#undef PG8_SCHED
}
}

struct Args { const float* in[44]; float* out; unsigned char* ws; int ph_lo, ph_hi; };
enum InIdx { I_X = 0, I_C, I_CTX, I_CCTX, I_ADAW, I_ADAB, I_N1G, I_N2G, I_INW, I_CONVW, I_CONVB, I_HW1, I_HB1, I_HW2, I_HB2, I_HW3, I_HB3, I_HFREQ, I_HW4, I_HBIAS, I_HNG,
             I_RW0, I_RW1, I_RW2, I_RA0, I_RA1, I_RA2, I_RKK, I_RKA, I_RRK, I_RG1, I_RG2, I_LNG, I_LNB, I_OUTW, I_ROUTW, I_ROUTB, I_EWG, I_EBG, I_EWU, I_EBU, I_EWD, I_EBD, I_FING };

struct Frame {
    LAS unsigned char* lds;
    const float* const* in;
    float* out; unsigned char* ws;
    int tid, lane, wave, G, bid;
};
template <class T> __device__ __forceinline__ T* wsp(const Frame& F, size_t off) { return (T*)(F.ws + off); }

template <int CTRL> __device__ __forceinline__ float dpp_mov(float x) { return __builtin_bit_cast(float, __builtin_amdgcn_update_dpp(0, __builtin_bit_cast(int, x), CTRL, 0xF, 0xF, true)); }
__device__ __forceinline__ float row16_sum(float v) {
    v += dpp_mov<0x128>(v);
    v += dpp_mov<0x124>(v);
    v += dpp_mov<0x122>(v);
    v += dpp_mov<0x121>(v);
    return v;
}

__device__ __forceinline__ float rdlane(float v, int l) { return __builtin_bit_cast(float, __builtin_amdgcn_readlane(__builtin_bit_cast(int, v), l)); }
__device__ __forceinline__ float wave_sum(float v) { v = row16_sum(v); return (rdlane(v, 0) + rdlane(v, 16)) + (rdlane(v, 32) + rdlane(v, 48)); }

__device__ __forceinline__ void tr_item(const float* src, size_t ld_src, int k0, int n0, bf16* dst, bf16* dlo, size_t ld_dst, int drow0, int dk0, LAS float* scr, int lane) {
    const int c = lane & 7;
    if (src == nullptr) {
#pragma unroll
        for (int j = 0; j < 4; ++j) { const int n = (lane >> 3) + 8 * j; *(GAS v4u*)(dst + (size_t)(drow0 + n) * ld_dst + dk0 + 8 * c) = (v4u){0u, 0u, 0u, 0u}; }
        return;
    }
#pragma unroll 8
    for (int i = 0; i < 32; ++i) { const int kk = 2 * i + (lane >> 5); scr[kk * 33 + (lane & 31)] = src[(size_t)(k0 + kk) * ld_src + n0 + (lane & 31)]; }
    LDS_WAIT(); asm volatile("" ::: "memory");
#pragma unroll
    for (int j = 0; j < 4; ++j) { const int n = (lane >> 3) + 8 * j; const LAS float* s = scr + (8 * c) * 33 + n;
        float v[8];
#pragma unroll
        for (int q = 0; q < 8; ++q) v[q] = s[q * 33];
        v4u o; o.x = pk2(v[0], v[1]); o.y = pk2(v[2], v[3]); o.z = pk2(v[4], v[5]); o.w = pk2(v[6], v[7]);
        *(GAS v4u*)(dst + (size_t)(drow0 + n) * ld_dst + dk0 + 8 * c) = o;
        if (dlo) { float r[8];
#pragma unroll
            for (int q = 0; q < 8; ++q) r[q] = v[q] - bf2f(f2bf(v[q]));
            v4u p; p.x = pk2(r[0], r[1]); p.y = pk2(r[2], r[3]); p.z = pk2(r[4], r[5]); p.w = pk2(r[6], r[7]);
            *(GAS v4u*)(dlo + (size_t)(drow0 + n) * ld_dst + dk0 + 8 * c) = p; } }
    LDS_WAIT(); asm volatile("" ::: "memory");
}

__device__ __forceinline__ void p0_small_weights(Frame& F) {
    LAS float* scr = (LAS float*)(F.lds + F.wave * 8448);
    const int gw = F.bid * 8 + F.wave, NGW = F.G * 8;
    constexpr int I_T1 = 32 * 192, I_T2 = 128, I_T3 = 128, I_T4 = 128, I_T5 = 128, I_T6 = 32 * 64, I_T7 = 160 * 8, I_T8 = 32;
    constexpr int NITEMS = I_T1 + I_T2 + I_T3 + I_T4 + I_T5 + I_T6 + I_T7 + I_T8;
    bf16* BtIn = wsp<bf16>(F, WS_BTIN); bf16* BtL = wsp<bf16>(F, WS_BTL); bf16* BtOut = wsp<bf16>(F, WS_BTOUT); bf16* Wr = wsp<bf16>(F, WS_WR);
    for (int it = gw; it < NITEMS; it += NGW) {
        int r = it;
        if (r < I_T1) { const int kb = r / 192, nb = r % 192; tr_item(F.in[I_INW], PW, 64 * kb, 32 * nb, BtIn, nullptr, D, 32 * nb, 64 * kb, scr, F.lane); continue; } r -= I_T1;
        if (r < I_T2) { const int dir = r / 64, q = r % 64, kb = q / 2, nb = q % 2; tr_item(F.in[I_RW1] + (size_t)dir * D * 64, 64, 64 * kb, 32 * nb, BtIn, nullptr, D, 6144 + 64 * dir + 32 * nb, 64 * kb, scr, F.lane); continue; } r -= I_T2;
        if (r < I_T3) { const int dir = r / 64, q = r % 64, kb = q / 2, nb = q % 2; tr_item(F.in[I_RA1] + (size_t)dir * D * 64, 64, 64 * kb, 32 * nb, BtIn, nullptr, D, 6272 + 64 * dir + 32 * nb, 64 * kb, scr, F.lane); continue; } r -= I_T3;
        if (r < I_T4) { const int kb = r / 4, nb = r % 4; tr_item(F.in[I_RG1], 128, 64 * kb, 32 * nb, BtIn, nullptr, D, 6400 + 32 * nb, 64 * kb, scr, F.lane); continue; } r -= I_T4;
        if (r < I_T5) { const int kb = r / 4, nb = r % 4; tr_item(nullptr, 0, 0, 0, BtIn, nullptr, D, 6528 + 32 * nb, 64 * kb, scr, F.lane); continue; } r -= I_T5;
        if (r < I_T6) { const int kb = r / 64, nb = r % 64; tr_item(F.in[I_OUTW], D, 64 * kb, 32 * nb, BtOut, nullptr, D, 32 * nb, 64 * kb, scr, F.lane); continue; } r -= I_T6;
        if (r < I_T7) { const int nb = r / 8, kb = r % 8, j = nb / 32, n0 = (nb % 32) * 32; const float* src = nullptr; int k0 = 0;
            if (j == 0 && kb == 0) src = F.in[I_RW2];
            else if (j == 1 && kb == 1) src = F.in[I_RW2] + 64 * 1024;
            else if (j == 2 && kb == 2) src = F.in[I_RA2];
            else if (j == 3 && kb == 3) src = F.in[I_RA2] + 64 * 1024;
            else if (j == 4 && (kb == 4 || kb == 5)) { src = F.in[I_RG2]; k0 = 64 * (kb - 4); }
            tr_item(src, 1024, k0, n0, BtL, nullptr, KLORA, 32 * nb, 64 * kb, scr, F.lane); continue; } r -= I_T7;
        { const int kb = r; tr_item(F.in[I_ROUTW], 32, 64 * kb, 0, Wr, Wr + 32 * D, D, 0, 64 * kb, scr, F.lane); }
    }
}

__device__ __forceinline__ void p0_adaln(Frame& F) {
    if (F.bid >= 192) return;
    const int kc = F.bid / 6, cg = F.bid % 6, k0 = 64 * kc;
    LAS float* sc = (LAS float*)(F.lds + 73728);
    for (int i = F.tid; i < 17 * 64; i += 512) { const int b = i / 64, k = i % 64; const float c = (b < 16) ? F.in[I_C][b * D + k0 + k] : F.in[I_CCTX][k0 + k]; sc[i] = c * fsigmoid(c); }
    __syncthreads();
    const int col = cg * 2048 + F.wave * 256 + F.lane * 4;
    f32x4 acc[17];
#pragma unroll
    for (int b = 0; b < 17; ++b) acc[b] = (f32x4){0.f, 0.f, 0.f, 0.f};
    const float* W = F.in[I_ADAW] + (size_t)k0 * 12288 + col;
    for (int k = 0; k < 64; k += 4) {
        f32x4 w[4];
#pragma unroll
        for (int j = 0; j < 4; ++j) w[j] = *(const GAS f32x4*)(W + (size_t)(k + j) * 12288);
#pragma unroll
        for (int b = 0; b < 17; ++b) { const f32x4 s = *(const LAS f32x4*)(sc + b * 64 + k);
            acc[b] += s.x * w[0]; acc[b] += s.y * w[1]; acc[b] += s.z * w[2]; acc[b] += s.w * w[3]; }
    }
    float* macc = wsp<float>(F, WS_MODACC);
#pragma unroll
    for (int b = 0; b < 17; ++b) { float* p = macc + (size_t)b * 12288 + col; atomicAdd(p + 0, acc[b].x); atomicAdd(p + 1, acc[b].y); atomicAdd(p + 2, acc[b].z); atomicAdd(p + 3, acc[b].w); }
    __syncthreads();
}

__device__ __forceinline__ void p0_filter(Frame& F) {
    LAS float* hs = (LAS float*)(F.lds + 81920 + F.wave * 256);
    const int gw = F.bid * 8 + F.wave, NGW = F.G * 8, j = F.lane;
    const float freq = F.in[I_HFREQ][j];
    bf16* Gt = wsp<bf16>(F, WS_G);
    for (int t = gw; t < SEQ; t += NGW) {
        const float tl = (float)t * (1.0f / 2047.0f);
        float pre = F.in[I_HB1][j] + tl * F.in[I_HW1][j];
#pragma unroll 4
        for (int i = 0; i < 16; ++i) {
            const float band = 1e-4f + (float)i * ((15.0f - 1e-4f) / 15.0f);
            float rev = band * (float)t * (1.0f / 2048.0f); rev = rev - floorf(rev);
            const float cs = __builtin_amdgcn_cosf(rev), sn = __builtin_amdgcn_sinf(rev);
            pre += cs * F.in[I_HW1][(1 + i) * 64 + j] - sn * F.in[I_HW1][(17 + i) * 64 + j];
        }
        float h = __sinf(freq * pre);
        hs[j] = h; LDS_WAIT(); asm volatile("" ::: "memory");
        pre = F.in[I_HB2][j];
#pragma unroll 8
        for (int i = 0; i < 64; ++i) pre += hs[i] * F.in[I_HW2][i * 64 + j];
        h = __sinf(freq * pre);
        LDS_WAIT(); asm volatile("" ::: "memory");
        hs[j] = h; LDS_WAIT(); asm volatile("" ::: "memory");
        pre = F.in[I_HB3][j];
#pragma unroll 8
        for (int i = 0; i < 64; ++i) pre += hs[i] * F.in[I_HW3][i * 64 + j];
        h = __sinf(freq * pre);
        LDS_WAIT(); asm volatile("" ::: "memory");
        hs[j] = h; LDS_WAIT(); asm volatile("" ::: "memory");
        f32x4 o[8];
#pragma unroll
        for (int m = 0; m < 8; ++m) o[m] = (f32x4){0.f, 0.f, 0.f, 0.f};
#pragma unroll 2
        for (int i = 0; i < 64; ++i) { const float hv = hs[i]; const float* w4 = F.in[I_HW4] + (size_t)i * 2048 + 4 * j;
#pragma unroll
            for (int m = 0; m < 8; ++m) o[m] += hv * *(const GAS f32x4*)(w4 + 256 * m); }
        LDS_WAIT(); asm volatile("" ::: "memory");
        const float dlo = -3.0701134573253945f, dhi = -15.350567286626973f;
#pragma unroll
        for (int m = 0; m < 8; ++m)
#pragma unroll
            for (int q = 0; q < 4; ++q) { const int n = 256 * m + 4 * j + q, c = n & 1023;
                const float delta = fabsf(dlo + (dhi - dlo) * ((float)c * (1.0f / 1023.0f)));
                const float val = o[m][q] * __expf(-tl * delta);
                if (n < 1024) Gt[(size_t)c * 4096 + (2048 - t)] = (bf16)f2bf(val);
                else if (t > 0) Gt[(size_t)c * 4096 + (2048 + t)] = (bf16)f2bf(val);
                else Gt[(size_t)c * 4096] = 0; }
    }
}

__device__ __forceinline__ void p1_norm1(Frame& F) {
    const int gw = F.bid * 8 + F.wave, NGW = F.G * 8, lane = F.lane;
    const float* macc = wsp<float>(F, WS_MODACC); const float* adab = F.in[I_ADAB];
    bf16* A1 = wsp<bf16>(F, WS_A1);
    f32x4 g[8];
#pragma unroll
    for (int j = 0; j < 8; ++j) g[j] = *(const GAS f32x4*)(F.in[I_N1G] + 4 * lane + 256 * j);
    for (int row = gw; row < MROWS; row += NGW) {
        const int b = row < NLAT ? row / SEQ : 16;
        const float* xr = row < NLAT ? F.in[I_X] + (size_t)row * D : F.in[I_CTX] + (size_t)(row - NLAT) * D;
        f32x4 v[8]; float ss = 0.f;
#pragma unroll
        for (int j = 0; j < 8; ++j) { v[j] = *(const GAS f32x4*)(xr + 4 * lane + 256 * j); ss += (v[j].x * v[j].x + v[j].y * v[j].y) + (v[j].z * v[j].z + v[j].w * v[j].w); }
        const float rstd = 1.0f / sqrtf(wave_sum(ss) * (1.0f / D) + 1e-6f);
        const float* mrow = macc + (size_t)b * 12288;
#pragma unroll
        for (int j = 0; j < 8; ++j) { const int c = 4 * lane + 256 * j;
            const f32x4 sh = *(const GAS f32x4*)(mrow + c) + *(const GAS f32x4*)(adab + c);
            const f32x4 sc = *(const GAS f32x4*)(mrow + 2048 + c) + *(const GAS f32x4*)(adab + 2048 + c);
            const f32x4 y = v[j] * rstd * g[j] * (1.0f + sc) + sh;
            v2u o; o.x = pk2(y.x, y.y); o.y = pk2(y.z, y.w);
            *(GAS v2u*)(A1 + (size_t)row * D + c) = o; }
    }
    if (F.bid < 16) { const int b = F.bid; float* T = wsp<float>(F, WS_MODT) + (size_t)b * 4096; const float* mrow = macc + (size_t)b * 12288;
        for (int k = F.tid; k < D; k += 512) { const float sh = mrow[3 * 2048 + k] + adab[3 * 2048 + k], sc = mrow[4 * 2048 + k] + adab[4 * 2048 + k];
            T[k] = F.in[I_N2G][k] * (1.0f + sc); T[2048 + k] = sh; } }
}

namespace pg8 {
__device__ __forceinline__ void static_unit(int L, int nM, int nN, Unit& u) {
    const int nwg = nM * nN; int wgid = L;
    { const int q = nwg / NXCD, r = nwg % NXCD, xcd = wgid % NXCD, off = wgid / NXCD; wgid = (xcd < r ? xcd * (q + 1) : r * (q + 1) + (xcd - r) * q) + off; }
    const int nig = WGM * nN, gid = wgid / nig, fm = gid * WGM, gsz = (nM - fm) < WGM ? (nM - fm) : WGM;
    u.pm = fm + ((wgid % nig) % gsz); u.pn = (wgid % nig) / gsz; u.e = 0;
}
struct StaticOrder {
    int nM, nN, nwg, G, c;
    __device__ void init(int M, int N, int G_, int c_) { nM = M / BM; nN = N / BM; nwg = nM * nN; G = G_; c = c_; }
    __device__ __forceinline__ bool next(int i, Unit& u) const { const long L = (long)i * G + c; if (L >= nwg) return false; static_unit((int)L, nM, nN, u); return true; }
    __device__ __forceinline__ int arow(const Unit&, int) const { return 0; }
};
struct InProjOrder {
    int G, c;
    __device__ __forceinline__ bool next(int i, Unit& u) const {
        long L = (long)i * G + c;
        if (L < 128 * 26) { static_unit((int)L, 128, 26, u); return true; }
        L -= 128 * 26; if (L >= 16 * 13) return false;
        u.pm = 128 + (int)(L % 16); u.pn = 12 + (int)(L / 16); u.e = 0; return true;
    }
    __device__ __forceinline__ int arow(const Unit&, int) const { return 0; }
};
struct MoeOrder {
    int G, c, nN, ntiles; const int* tile_e; const int* rowtok; const int* pad_start; const int* total;
    __device__ __forceinline__ bool next(int i, Unit& u) const {
        const long L0 = (long)i * G;
        const long L = L0 + (long)(c % 8) * (G / 8) + (c / 8);
        if (L >= (long)ntiles * nN) return false;
        u.pm = (int)(L / nN); u.pn = (int)(L % nN); u.e = tile_e[u.pm]; return true;
    }
    __device__ __forceinline__ int arow(const Unit& u, int r) const { const int row = u.pm * 256 + r; const bool valid = (row - pad_start[u.e]) < total[u.e]; return valid ? rowtok[row] : 0; }
};

struct EpiInProj {
    static constexpr bool PERM = true;
    bf16* Z; bf16* AP;
    __device__ __forceinline__ void operator()(const f32x4 (&acc)[2][2][4][2], const Unit& u, int wr, int wc, int fr, int fq) const {
        const int row0 = u.pm * BM + wr * 64 + fr;
        const bool lora = u.pn >= 24;
        bf16* base = lora ? AP : Z; const int ldc = lora ? KLORA : PW;
        const int col0 = (lora ? (u.pn - 24) * BM : u.pn * BM) + wc * 32 + 8 * fq;
#pragma unroll
        for (int ai = 0; ai < 2; ++ai)
#pragma unroll
            for (int m = 0; m < 4; ++m) { bf16* rowp = base + (size_t)(row0 + ai * HALF + m * 16) * ldc + col0;
#pragma unroll
                for (int bj = 0; bj < 2; ++bj) { f32x4 v0 = acc[ai][bj][m][0], v1 = acc[ai][bj][m][1];
                    if (lora) { const int act = (u.pn == 24) ? (bj == 0 ? 1 : 0) : (bj == 0 ? 2 : 0);
                        if (act == 1) {
#pragma unroll
                            for (int j = 0; j < 4; ++j) { v0[j] = ftanh(v0[j]); v1[j] = ftanh(v1[j]); } }
                        if (act == 2) {
#pragma unroll
                            for (int j = 0; j < 4; ++j) { v0[j] = fsigmoid(v0[j]); v1[j] = fsigmoid(v1[j]); } } }
                    v4u w; w.x = cvt_pk_bf16(v0[0], v0[1]); w.y = cvt_pk_bf16(v0[2], v0[3]); w.z = cvt_pk_bf16(v1[0], v1[1]); w.w = cvt_pk_bf16(v1[2], v1[3]);
                    *(v4u*)(rowp + bj * HALF) = w; } }
    }
};
struct EpiLora {
    static constexpr bool PERM = true;
    bf16* EA; const float* w0; const float* a0;
    __device__ __forceinline__ void operator()(const f32x4 (&acc)[2][2][4][2], const Unit& u, int wr, int wc, int fr, int fq) const {
        const int row0 = u.pm * BM + wr * 64 + fr, col0 = u.pn * BM + wc * 32 + 8 * fq;
        const int blk = u.pn >> 2;
        const float* bias = blk < 2 ? w0 + col0 : (blk < 4 ? a0 + (col0 - 2048) : nullptr);
        const float scale = blk < 2 ? 0.60653065971263342f : 1.0f;
        f32x4 bv[2][2];
#pragma unroll
        for (int bj = 0; bj < 2; ++bj)
#pragma unroll
            for (int n = 0; n < 2; ++n) bv[bj][n] = bias ? *(const f32x4*)(bias + bj * HALF + 4 * n) : (f32x4){0.f, 0.f, 0.f, 0.f};
#pragma unroll
        for (int ai = 0; ai < 2; ++ai)
#pragma unroll
            for (int m = 0; m < 4; ++m) { bf16* rowp = EA + (size_t)(row0 + ai * HALF + m * 16) * NLORA + col0;
#pragma unroll
                for (int bj = 0; bj < 2; ++bj) { f32x4 v0 = acc[ai][bj][m][0] + bv[bj][0], v1 = acc[ai][bj][m][1] + bv[bj][1];
                    if (blk < 4) {
#pragma unroll
                        for (int j = 0; j < 4; ++j) { v0[j] = scale * fsigmoid(v0[j]); v1[j] = scale * fsigmoid(v1[j]); } }
                    v4u w; w.x = cvt_pk_bf16(v0[0], v0[1]); w.y = cvt_pk_bf16(v0[2], v0[3]); w.z = cvt_pk_bf16(v1[0], v1[1]); w.w = cvt_pk_bf16(v1[2], v1[3]);
                    *(v4u*)(rowp + bj * HALF) = w; } }
    }
};
struct EpiOutProj {
    static constexpr bool PERM = false;
    const float* X; float* X1; const float* macc; const float* adab;
    __device__ __forceinline__ void operator()(const f32x4 (&acc)[2][2][4][2], const Unit& u, int wr, int wc, int fr, int fq) const {
        const int row0 = u.pm * BM + wr * 64 + fr, col0 = u.pn * BM + wc * 32 + 4 * fq;
        const int b = (u.pm * BM) / SEQ;
        f32x4 gv[2][2];
#pragma unroll
        for (int bj = 0; bj < 2; ++bj)
#pragma unroll
            for (int n = 0; n < 2; ++n) { const int c = col0 + bj * HALF + n * 16; gv[bj][n] = *(const f32x4*)(macc + (size_t)b * 12288 + 2 * 2048 + c) + *(const f32x4*)(adab + 2 * 2048 + c); }
#pragma unroll
        for (int ai = 0; ai < 2; ++ai)
#pragma unroll
            for (int m = 0; m < 4; ++m) { const size_t off = (size_t)(row0 + ai * HALF + m * 16) * D + col0;
#pragma unroll
                for (int bj = 0; bj < 2; ++bj)
#pragma unroll
                    for (int n = 0; n < 2; ++n) { const f32x4 xv = *(const f32x4*)(X + off + bj * HALF + n * 16); *(f32x4*)(X1 + off + bj * HALF + n * 16) = xv + gv[bj][n] * acc[ai][bj][m][n]; } }
    }
};
struct EpiSwiglu {
    static constexpr bool PERM = true;
    bf16* ACT; const float* bg; const float* bu;
    __device__ __forceinline__ void operator()(const f32x4 (&acc)[2][2][4][2], const Unit& u, int wr, int wc, int fr, int fq) const {
        const int row0 = u.pm * BM + wr * 64 + fr, col0 = u.pn * HALF + wc * 32 + 8 * fq;
        const float* pg = bg + (size_t)u.e * 2048 + col0; const float* pu = bu + (size_t)u.e * 2048 + col0;
        f32x4 bgv[2], buv[2];
#pragma unroll
        for (int n = 0; n < 2; ++n) { bgv[n] = *(const f32x4*)(pg + 4 * n); buv[n] = *(const f32x4*)(pu + 4 * n); }
#pragma unroll
        for (int ai = 0; ai < 2; ++ai)
#pragma unroll
            for (int m = 0; m < 4; ++m) { bf16* rowp = ACT + (size_t)(row0 + ai * HALF + m * 16) * 2048 + col0; float o[8];
#pragma unroll
                for (int n = 0; n < 2; ++n) { const f32x4 gq = acc[ai][0][m][n] + bgv[n], uq = acc[ai][1][m][n] + buv[n];
#pragma unroll
                    for (int j = 0; j < 4; ++j) { const float gg = fminf(gq[j], 7.0f), uu = fminf(fmaxf(uq[j], -7.0f), 7.0f); o[4 * n + j] = (uu + 1.0f) * (gg * fsigmoid(1.702f * gg)); } }
                v4u w; w.x = cvt_pk_bf16(o[0], o[1]); w.y = cvt_pk_bf16(o[2], o[3]); w.z = cvt_pk_bf16(o[4], o[5]); w.w = cvt_pk_bf16(o[6], o[7]);
                *(v4u*)rowp = w; }
    }
};
struct EpiDown {
    static constexpr bool PERM = true;
    bf16* SLOT; const float* bd; const int* rowdst; const float* rowgate; const int* pad_start; const int* total;
    __device__ __forceinline__ void operator()(const f32x4 (&acc)[2][2][4][2], const Unit& u, int wr, int wc, int fr, int fq) const {
        const int row0 = u.pm * BM + wr * 64 + fr, col0 = u.pn * BM + wc * 32 + 8 * fq;
        const float* pb = bd + (size_t)u.e * 2048 + col0;
        const int lim = pad_start[u.e] + total[u.e];
        f32x4 bv[2][2];
#pragma unroll
        for (int bj = 0; bj < 2; ++bj)
#pragma unroll
            for (int n = 0; n < 2; ++n) bv[bj][n] = *(const f32x4*)(pb + bj * HALF + 4 * n);
#pragma unroll
        for (int ai = 0; ai < 2; ++ai)
#pragma unroll
            for (int m = 0; m < 4; ++m) { const int row = row0 + ai * HALF + m * 16;
                if (row < lim) { const int dst = rowdst[row]; const float gt = rowgate[row]; bf16* rowp = SLOT + (size_t)dst * 2048 + col0;
#pragma unroll
                    for (int bj = 0; bj < 2; ++bj) { const f32x4 v0 = (acc[ai][bj][m][0] + bv[bj][0]) * gt, v1 = (acc[ai][bj][m][1] + bv[bj][1]) * gt;
                        v4u w; w.x = cvt_pk_bf16(v0[0], v0[1]); w.y = cvt_pk_bf16(v0[2], v0[3]); w.z = cvt_pk_bf16(v1[0], v1[1]); w.w = cvt_pk_bf16(v1[2], v1[3]);
                        *(v4u*)(rowp + bj * HALF) = w; } } }
    }
};
}

__device__ __forceinline__ f32x4 unpk4(v2u w) { return (f32x4){bflo(w.x), bfhi(w.x), bflo(w.y), bfhi(w.y)}; }
__device__ __forceinline__ v2u pk4(f32x4 v) { v2u o; o.x = pk2(v.x, v.y); o.y = pk2(v.z, v.w); return o; }
__device__ __forceinline__ f32x4 ldz4(const bf16* p, bool ok) { return ok ? unpk4(*(const GAS v2u*)p) : (f32x4){0.f, 0.f, 0.f, 0.f}; }

__device__ __forceinline__ void p4_prep(Frame& F) {
    const int gw = F.bid * 8 + F.wave, NGW = F.G * 8, lane = F.lane;
    const bf16* Z = wsp<bf16>(F, WS_Z); const bf16* EA = wsp<bf16>(F, WS_EA); bf16* SI = wsp<bf16>(F, WS_SI);
    bf16* UT = wsp<bf16>(F, WS_UT); bf16* X0T = wsp<bf16>(F, WS_X0T); float* BS = wsp<float>(F, WS_BS);
    const float* cw = F.in[I_CONVW]; const float* cb = F.in[I_CONVB];
    constexpr int NU_LAT = 16 * 64 * 8, NU = NU_LAT + 16 * 8 * 4;
    for (int u = gw; u < NU; u += NGW) {
        int b, chunk, slice; bool lat;
        if (u < NU_LAT) { lat = true; b = u / 512; const int rem = u % 512; chunk = rem / 8; slice = rem % 8; }
        else { lat = false; const int v = u - NU_LAT; b = v / 32; chunk = (v % 32) / 4; slice = 4 + (v % 4); }
        const int Ls = lat ? SEQ : CTXL, rowbase = lat ? b * SEQ : NLAT + b * CTXL, t0 = chunk * 32;
        if (slice < 4) {
            const int c0 = 256 * slice + 4 * lane;
            f32x4 w[3][3], bi[3];
#pragma unroll
            for (int a = 0; a < 3; ++a) { bi[a] = *(const GAS f32x4*)(cb + a * 1024 + c0);
#pragma unroll
                for (int tp = 0; tp < 3; ++tp) w[a][tp] = *(const GAS f32x4*)(cw + (size_t)tp * PW + a * 1024 + c0); }
            f32x4 pv[3], cu[3], nx[3];
#pragma unroll
            for (int a = 0; a < 3; ++a) { pv[a] = ldz4(Z + (size_t)(rowbase + t0 - 1) * PW + a * 1024 + c0, t0 > 0); cu[a] = ldz4(Z + (size_t)(rowbase + t0) * PW + a * 1024 + c0, true); }
            for (int g8 = 0; g8 < 4; ++g8) {
                float x0v[4][8], uv[4][8];
#pragma unroll
                for (int i = 0; i < 8; ++i) { const int t = t0 + 8 * g8 + i;
                    f32x4 zc[3];
#pragma unroll
                    for (int a = 0; a < 3; ++a) { nx[a] = ldz4(Z + (size_t)(rowbase + t + 1) * PW + a * 1024 + c0, t + 1 < Ls);
                        zc[a] = pv[a] * w[a][0] + cu[a] * w[a][1] + nx[a] * w[a][2] + bi[a]; pv[a] = cu[a]; cu[a] = nx[a]; }
                    const f32x4 uu = zc[2] * zc[1];
#pragma unroll
                    for (int j = 0; j < 4; ++j) { x0v[j][i] = zc[0][j]; uv[j][i] = uu[j]; } }
#pragma unroll
                for (int j = 0; j < 4; ++j) { const size_t o = ((size_t)(c0 + j) * 16 + b) * SEQ + t0 + 8 * g8;
                    v4u a, c; a.x = pk2(x0v[j][0], x0v[j][1]); a.y = pk2(x0v[j][2], x0v[j][3]); a.z = pk2(x0v[j][4], x0v[j][5]); a.w = pk2(x0v[j][6], x0v[j][7]);
                    c.x = pk2(uv[j][0], uv[j][1]); c.y = pk2(uv[j][2], uv[j][3]); c.z = pk2(uv[j][4], uv[j][5]); c.w = pk2(uv[j][6], uv[j][7]);
                    *(GAS v4u*)(X0T + o) = a; *(GAS v4u*)(UT + o) = c; }
            }
        } else {
            const int q = slice - 4, c0 = 256 * q + 4 * lane;
            f32x4 w[3][3], bi[3];
#pragma unroll
            for (int a = 0; a < 3; ++a) { bi[a] = *(const GAS f32x4*)(cb + 3072 + a * 1024 + c0);
#pragma unroll
                for (int tp = 0; tp < 3; ++tp) w[a][tp] = *(const GAS f32x4*)(cw + (size_t)tp * PW + 3072 + a * 1024 + c0); }
            const f32x4 kkw = *(const GAS f32x4*)(F.in[I_RKK] + c0), kaw = *(const GAS f32x4*)(F.in[I_RKA] + c0), rkw = *(const GAS f32x4*)(F.in[I_RRK] + c0);
            f32x4 pv[3], cu[3], nx[3];
#pragma unroll
            for (int a = 0; a < 3; ++a) { pv[a] = ldz4(Z + (size_t)(rowbase + t0 - 1) * PW + 3072 + a * 1024 + c0, t0 > 0); cu[a] = ldz4(Z + (size_t)(rowbase + t0) * PW + 3072 + a * 1024 + c0, true); }
            for (int i = 0; i < 32; ++i) { const int t = t0 + i, row = rowbase + t;
                f32x4 zc[3];
#pragma unroll
                for (int a = 0; a < 3; ++a) { nx[a] = ldz4(Z + (size_t)(row + 1) * PW + 3072 + a * 1024 + c0, t + 1 < Ls);
                    zc[a] = pv[a] * w[a][0] + cu[a] * w[a][1] + nx[a] * w[a][2] + bi[a]; pv[a] = cu[a]; cu[a] = nx[a]; }
                const f32x4 a0 = unpk4(*(const GAS v2u*)(EA + (size_t)row * NLORA + 2048 + c0)), a1 = unpk4(*(const GAS v2u*)(EA + (size_t)row * NLORA + 3072 + c0));
                const f32x4 zr = zc[0], zk = zc[1], zv = zc[2];
                const f32x4 kk = zk * kkw;
                const float n2 = row16_sum((kk.x * kk.x + kk.y * kk.y) + (kk.z * kk.z + kk.w * kk.w));
                const float inv = 1.0f / fmaxf(sqrtf(n2), 1e-12f);
                const f32x4 kkn = kk * inv;
                const f32x4 kd0 = zk * (1.0f + (a0 - 1.0f) * kaw), kd1 = zk * (1.0f + (a1 - 1.0f) * kaw);
                const f32x4 b0 = kkn * a0, b1 = kkn * a1;
                const f32x4 bt = zr * (kd0 + kd1) * rkw;
                const float bsum = row16_sum((bt.x + bt.y) + (bt.z + bt.w));
                bf16* so = SI + (size_t)row * SIW + c0;
                *(GAS v2u*)(so) = pk4(zr); *(GAS v2u*)(so + 1024) = pk4(zv); *(GAS v2u*)(so + 2048) = pk4(kkn);
                *(GAS v2u*)(so + 3072) = pk4(b0); *(GAS v2u*)(so + 4096) = pk4(kd0); *(GAS v2u*)(so + 5120) = pk4(b1); *(GAS v2u*)(so + 6144) = pk4(kd1);
                if (lat && (lane & 15) == 0) BS[(size_t)row * 16 + 4 * q + (lane >> 4)] = bsum;
            }
        }
    }
}

__device__ __forceinline__ int scan_row(int s, int dir, int b) {
    return s < CTXL ? NLAT + b * CTXL + (dir ? CTXL - 1 - s : s) : b * SEQ + (dir ? SEQ - 1 - (s - CTXL) : (s - CTXL));
}
__device__ __forceinline__ void p5_scan(Frame& F) {
    const int cwv = F.wave >> 2, w4 = F.wave & 3, lane = F.lane, tc = F.tid & 255, rg = lane >> 4, kc = lane & 15;
    const bf16* SI = wsp<bf16>(F, WS_SI); const bf16* EA = wsp<bf16>(F, WS_EA); float* YS = wsp<float>(F, WS_YS);
    for (int cp = F.bid; cp < 256; cp += F.G) {
        const int chain = cp * 2 + cwv, dir = chain >> 8, b = (chain >> 4) & 15, h = chain & 15;
        LAS float* buf0 = (LAS float*)(F.lds + cwv * 49152);
        const int sl = tc >> 4, jj = tc & 15, coff = h * 64 + 4 * jj;
        v2u ld[6];
#define SCAN_ISSUE(ck_) do { const int row_ = scan_row((ck_) * 16 + sl, dir, b); const bf16* sr_ = SI + (size_t)row_ * SIW + coff; \
            ld[0] = *(const GAS v2u*)(sr_ + 2048); ld[1] = *(const GAS v2u*)(EA + (size_t)row_ * NLORA + dir * 1024 + coff); ld[2] = *(const GAS v2u*)(sr_ + 3072 + dir * 2048); \
            ld[3] = *(const GAS v2u*)(sr_ + 4096 + dir * 2048); ld[4] = *(const GAS v2u*)(sr_); ld[5] = *(const GAS v2u*)(sr_ + 1024); } while (0)
#define SCAN_COMMIT(p_) do { LAS float* d_ = buf0 + (p_) * 6144 + sl * 384 + 4 * jj; \
            const f32x4 kk_ = unpk4(ld[0]), e_ = unpk4(ld[1]); \
            *(LAS f32x4*)(d_) = -kk_; \
            *(LAS f32x4*)(d_ + 64) = (f32x4){__expf(-e_.x), __expf(-e_.y), __expf(-e_.z), __expf(-e_.w)}; \
            *(LAS f32x4*)(d_ + 128) = unpk4(ld[2]); *(LAS f32x4*)(d_ + 192) = unpk4(ld[3]); *(LAS f32x4*)(d_ + 256) = unpk4(ld[4]); *(LAS f32x4*)(d_ + 320) = unpk4(ld[5]); } while (0)
        f32x4 S[4];
#pragma unroll
        for (int i = 0; i < 4; ++i) S[i] = (f32x4){0.f, 0.f, 0.f, 0.f};
        SCAN_ISSUE(0); SCAN_COMMIT(0); __syncthreads();
        const int v0 = 16 * w4 + 4 * rg;
        constexpr int NCK = (CTXL + SEQ) / 16;
        for (int ck = 0; ck < NCK; ++ck) {
            const int p = ck & 1;
            if (ck + 1 < NCK) SCAN_ISSUE(ck + 1);
            const LAS float* bs = buf0 + p * 6144;
#pragma unroll 4
            for (int s = 0; s < 16; ++s) {
                const LAS float* q = bs + s * 384;
                const f32x4 a4 = *(const LAS f32x4*)(q + 4 * kc), wv = *(const LAS f32x4*)(q + 64 + 4 * kc), b4 = *(const LAS f32x4*)(q + 128 + 4 * kc),
                            kd = *(const LAS f32x4*)(q + 192 + 4 * kc), r4 = *(const LAS f32x4*)(q + 256 + 4 * kc), vv = *(const LAS f32x4*)(q + 320 + v0);
                float sa[4];
#pragma unroll
                for (int i = 0; i < 4; ++i) sa[i] = row16_sum((S[i].x * a4.x + S[i].y * a4.y) + (S[i].z * a4.z + S[i].w * a4.w));
#pragma unroll
                for (int i = 0; i < 4; ++i) S[i] = S[i] * wv + sa[i] * b4 + vv[i] * kd;
                f32x4 y;
#pragma unroll
                for (int i = 0; i < 4; ++i) y[i] = row16_sum((S[i].x * r4.x + S[i].y * r4.y) + (S[i].z * r4.z + S[i].w * r4.w));
                const int sg = ck * 16 + s;
                if (sg >= CTXL && kc == 0) { const int row = scan_row(sg, dir, b); *(GAS f32x4*)(YS + ((size_t)dir * NLAT + row) * 1024 + h * 64 + v0) = y; }
            }
            if (ck + 1 < NCK) SCAN_COMMIT(p ^ 1);
            __syncthreads();
        }
    }
}

constexpr int HY_UROW = 4128, HY_GOFF = 16 * HY_UROW, HY_CS = 8208;
__device__ __forceinline__ void p6_hyena(Frame& F) {
    const int lane = F.lane, tl = lane & 15, q = lane >> 4, wave = F.wave, tid = F.tid;
    const bf16* UT = wsp<bf16>(F, WS_UT); const bf16* Gt = wsp<bf16>(F, WS_G); bf16* YCT = wsp<bf16>(F, WS_YCT);
    LAS unsigned char* lds = F.lds;
    const int r = (8 - (tl & 7)) & 7;
    const int abase = HY_GOFF + r * HY_CS + 2 * (2048 + 8 * q - (tl + r)) - 32 * (16 * wave);
    const int bbase = tl * HY_UROW + 16 * q;
    for (int c = F.bid; c < 1024; c += F.G) {
#pragma unroll
        for (int i = 0; i < 8; ++i) { const int id = tid + 512 * i, bb = id >> 8, ch = id & 255;
            const v4u v = *(const GAS v4u*)(UT + ((size_t)c * 16 + bb) * SEQ + 8 * ch); *(LAS v4u*)(lds + bb * HY_UROW + 16 * ch) = v; }
        { const v4u v = *(const GAS v4u*)(Gt + (size_t)c * 4096 + 8 * tid); *(LAS v4u*)(lds + HY_GOFF + 16 * tid) = v; }
        __syncthreads();
        { unsigned d[8]; const v4u lo = *(const LAS v4u*)(lds + HY_GOFF + 16 * tid); const v4u hi = tid < 511 ? *(const LAS v4u*)(lds + HY_GOFF + 16 * tid + 16) : (v4u){0u, 0u, 0u, 0u};
            d[0] = lo.x; d[1] = lo.y; d[2] = lo.z; d[3] = lo.w; d[4] = hi.x; d[5] = hi.y; d[6] = hi.z; d[7] = hi.w;
#pragma unroll
            for (int rr = 1; rr < 8; ++rr) { v4u o;
                if ((rr & 1) == 0) { o.x = d[rr / 2]; o.y = d[rr / 2 + 1]; o.z = d[rr / 2 + 2]; o.w = d[rr / 2 + 3]; }
                else { const int e = (rr - 1) / 2; o.x = __builtin_amdgcn_alignbit(d[e + 1], d[e], 16); o.y = __builtin_amdgcn_alignbit(d[e + 2], d[e + 1], 16);
                       o.z = __builtin_amdgcn_alignbit(d[e + 3], d[e + 2], 16); o.w = __builtin_amdgcn_alignbit(d[e + 4], d[e + 3], 16); }
                *(LAS v4u*)(lds + HY_GOFF + rr * HY_CS + 16 * tid) = o; } }
        __syncthreads();
        f32x4 acc[16]; bf16x8 P[16];
#pragma unroll
        for (int it = 0; it < 16; ++it) acc[it] = (f32x4){0.f, 0.f, 0.f, 0.f};
#pragma unroll
        for (int it = 2; it < 16; ++it) P[it] = *(const LAS bf16x8*)(lds + abase - 32 * it);
        for (int i8 = 0; i8 < 8; ++i8) {
#pragma unroll
            for (int u = 0; u < 8; ++u) {
                const int isb = i8 * 8 + u;
                const bf16x8 bf = *(const LAS bf16x8*)(lds + bbase + 64 * isb);
                P[(16 - 2 * u) & 15] = *(const LAS bf16x8*)(lds + abase + 64 * isb);
                P[(17 - 2 * u) & 15] = *(const LAS bf16x8*)(lds + abase + 64 * isb - 32);
#pragma unroll
                for (int k = 0; k < 16; ++k) { const int it = (k + 2) & 15;
                    acc[it] = __builtin_amdgcn_mfma_f32_16x16x32_bf16(P[(it - 2 * u) & 15], bf, acc[it], 0, 0, 0); }
            }
        }
#pragma unroll
        for (int it = 0; it < 16; ++it) { v2u o; o.x = pk2(acc[it].x, acc[it].y); o.y = pk2(acc[it].z, acc[it].w);
            *(GAS v2u*)(YCT + ((size_t)c * 16 + tl) * SEQ + 256 * wave + 16 * it + 4 * q) = o; }
        __syncthreads();
    }
}

__device__ __forceinline__ void p7_assemble(Frame& F) {
    const int gw = F.bid * 8 + F.wave, NGW = F.G * 8, lane = F.lane;
    bf16* A2 = wsp<bf16>(F, WS_A2);
    const bf16* YCT = wsp<bf16>(F, WS_YCT); const bf16* X0T = wsp<bf16>(F, WS_X0T); const bf16* UT = wsp<bf16>(F, WS_UT);
    const float* YS = wsp<float>(F, WS_YS); const float* BS = wsp<float>(F, WS_BS); const bf16* SI = wsp<bf16>(F, WS_SI); const bf16* EA = wsp<bf16>(F, WS_EA);
    LAS unsigned char* tile = F.lds + F.wave * 9216;
    constexpr int NU_H = 16 * 32 * 16, NU = NU_H + (NLAT / 16) * 4;
    for (int u = gw; u < NU; u += NGW) {
        if (u < NU_H) {
            const int b = u / 512, rem = u % 512, tb = rem / 16, g = rem % 16, ci = lane >> 3, tq = lane & 7;
            float val[8][8]; float ss[8];
#pragma unroll
            for (int k = 0; k < 8; ++k) ss[k] = 0.f;
#pragma unroll
            for (int i = 0; i < 8; ++i) { const int ch = g * 64 + 8 * ci + i; const size_t o = ((size_t)ch * 16 + b) * SEQ + 64 * tb + 8 * tq;
                const v4u yc = *(const GAS v4u*)(YCT + o), x0 = *(const GAS v4u*)(X0T + o), uu = *(const GAS v4u*)(UT + o); const float bias = F.in[I_HBIAS][ch];
                const unsigned ycw[4] = {yc.x, yc.y, yc.z, yc.w}, x0w[4] = {x0.x, x0.y, x0.z, x0.w}, uw[4] = {uu.x, uu.y, uu.z, uu.w};
#pragma unroll
                for (int k = 0; k < 4; ++k) { const float v0 = bflo(x0w[k]) * (bflo(ycw[k]) + bias * bflo(uw[k])), v1 = bfhi(x0w[k]) * (bfhi(ycw[k]) + bias * bfhi(uw[k]));
                    val[i][2 * k] = v0; val[i][2 * k + 1] = v1; ss[2 * k] += v0 * v0; ss[2 * k + 1] += v1 * v1; } }
#pragma unroll
            for (int k = 0; k < 8; ++k) { float s = ss[k]; s += __shfl_xor(s, 8); s += __shfl_xor(s, 16); s += __shfl_xor(s, 32); ss[k] = 1.0f / sqrtf(s * (1.0f / 64.0f) + 1e-6f); }
            float ng[8];
#pragma unroll
            for (int i = 0; i < 8; ++i) ng[i] = F.in[I_HNG][g * 64 + 8 * ci + i];
#pragma unroll
            for (int k = 0; k < 8; ++k) { v4u o; o.x = pk2(val[0][k] * ss[k] * ng[0], val[1][k] * ss[k] * ng[1]); o.y = pk2(val[2][k] * ss[k] * ng[2], val[3][k] * ss[k] * ng[3]);
                o.z = pk2(val[4][k] * ss[k] * ng[4], val[5][k] * ss[k] * ng[5]); o.w = pk2(val[6][k] * ss[k] * ng[6], val[7][k] * ss[k] * ng[7]);
                *(LAS v4u*)(tile + (8 * tq + k) * 144 + 16 * ci) = o; }
            LDS_WAIT(); asm volatile("" ::: "memory");
#pragma unroll
            for (int i = 0; i < 8; ++i) { const int t = (lane >> 3) + 8 * i, pc = lane & 7; const v4u o = *(const LAS v4u*)(tile + t * 144 + 16 * pc);
                *(GAS v4u*)(A2 + (size_t)(b * SEQ + 64 * tb + t) * D + g * 64 + 8 * pc) = o; }
            LDS_WAIT(); asm volatile("" ::: "memory");
        } else {
            const int v = u - NU_H, tk = v / 4, q = v % 4, c0 = 256 * q + 4 * lane;
            const f32x4 lg = *(const GAS f32x4*)(F.in[I_LNG] + c0), lb = *(const GAS f32x4*)(F.in[I_LNB] + c0);
            for (int i = 0; i < 16; ++i) { const int row = tk * 16 + i;
                const f32x4 y = *(const GAS f32x4*)(YS + (size_t)row * 1024 + c0) + *(const GAS f32x4*)(YS + ((size_t)NLAT + row) * 1024 + c0);
                const float mu = row16_sum((y.x + y.y) + (y.z + y.w)) * (1.0f / 64.0f);
                const f32x4 d = y - mu;
                const float var = row16_sum((d.x * d.x + d.y * d.y) + (d.z * d.z + d.w * d.w)) * (1.0f / 64.0f);
                const float rs = 1.0f / sqrtf(var + 64e-5f);
                const f32x4 vv = unpk4(*(const GAS v2u*)(SI + (size_t)row * SIW + 1024 + c0)), gt = unpk4(*(const GAS v2u*)(EA + (size_t)row * NLORA + 4096 + c0));
                const float bsc = BS[(size_t)row * 16 + 4 * q + (lane >> 4)];
                const f32x4 o = (d * rs * lg + lb + bsc * vv) * gt;
                *(GAS v2u*)(A2 + (size_t)row * D + 1024 + c0) = pk4(o); }
        }
    }
}

__device__ __forceinline__ void p9_router(Frame& F) {
    const int lane = F.lane, rw = lane & 15, q = lane >> 4, wave = F.wave;
    const float* X1 = F.out; const float* MT = wsp<float>(F, WS_MODT); bf16* H2 = wsp<bf16>(F, WS_H2); const bf16* Wr = wsp<bf16>(F, WS_WR);
    int* TOKE = wsp<int>(F, WS_TOKE); float* TOKG = wsp<float>(F, WS_TOKG); int* WCNT = wsp<int>(F, WS_WCNT); int* BCNT = wsp<int>(F, WS_BCNT);
    LAS float* lg = (LAS float*)(F.lds + wave * 2048);
    LAS int* wc = (LAS int*)(F.lds + 16384 + wave * 128);
    {
        const int gw = F.bid * 8 + wave, tok0 = gw * 16, token = tok0 + rw, b = token / SEQ;
        const float* xr = X1 + (size_t)token * D + 8 * q;
        float ss = 0.f;
        for (int ks = 0; ks < 64; ++ks) { const f32x4 a = *(const GAS f32x4*)(xr + 32 * ks), c = *(const GAS f32x4*)(xr + 32 * ks + 4);
            ss += (a.x * a.x + a.y * a.y) + (a.z * a.z + a.w * a.w) + (c.x * c.x + c.y * c.y) + (c.z * c.z + c.w * c.w); }
        ss += __shfl_xor(ss, 16); ss += __shfl_xor(ss, 32);
        const float rstd = 1.0f / sqrtf(ss * (1.0f / D) + 1e-6f);
        const float* t0 = MT + (size_t)b * 4096 + 8 * q; const float* t1 = t0 + 2048;
        f32x4 acc[2] = {(f32x4){0.f, 0.f, 0.f, 0.f}, (f32x4){0.f, 0.f, 0.f, 0.f}};
        for (int ks = 0; ks < 64; ++ks) {
            const f32x4 xa = *(const GAS f32x4*)(xr + 32 * ks), xb = *(const GAS f32x4*)(xr + 32 * ks + 4);
            const f32x4 ma = *(const GAS f32x4*)(t0 + 32 * ks), mb = *(const GAS f32x4*)(t0 + 32 * ks + 4), sa = *(const GAS f32x4*)(t1 + 32 * ks), sb = *(const GAS f32x4*)(t1 + 32 * ks + 4);
            const f32x4 ha = xa * rstd * ma + sa, hb = xb * rstd * mb + sb;
            const float hv[8] = {ha.x, ha.y, ha.z, ha.w, hb.x, hb.y, hb.z, hb.w};
            unsigned hi[8], lo[8];
#pragma unroll
            for (int j = 0; j < 8; ++j) { hi[j] = f2bf(hv[j]); lo[j] = f2bf(hv[j] - bf2f(hi[j])); }
            v4u ph, pl; ph.x = hi[0] | (hi[1] << 16); ph.y = hi[2] | (hi[3] << 16); ph.z = hi[4] | (hi[5] << 16); ph.w = hi[6] | (hi[7] << 16);
            pl.x = lo[0] | (lo[1] << 16); pl.y = lo[2] | (lo[3] << 16); pl.z = lo[4] | (lo[5] << 16); pl.w = lo[6] | (lo[7] << 16);
            *(GAS v4u*)(H2 + (size_t)token * D + 32 * ks + 8 * q) = ph;
            const bf16x8 Ah = __builtin_bit_cast(bf16x8, ph), Al = __builtin_bit_cast(bf16x8, pl);
#pragma unroll
            for (int nb = 0; nb < 2; ++nb) { const bf16* wp = Wr + (size_t)(16 * nb + rw) * D + 32 * ks + 8 * q;
                const bf16x8 Bh = *(const GAS bf16x8*)wp, Bl = *(const GAS bf16x8*)(wp + 32 * D);
                acc[nb] = __builtin_amdgcn_mfma_f32_16x16x32_bf16(Ah, Bh, acc[nb], 0, 0, 0);
                acc[nb] = __builtin_amdgcn_mfma_f32_16x16x32_bf16(Ah, Bl, acc[nb], 0, 0, 0);
                acc[nb] = __builtin_amdgcn_mfma_f32_16x16x32_bf16(Al, Bh, acc[nb], 0, 0, 0); }
        }
#pragma unroll
        for (int nb = 0; nb < 2; ++nb) { const float rb = F.in[I_ROUTB][16 * nb + rw];
#pragma unroll
            for (int j = 0; j < 4; ++j) lg[(4 * q + j) * 32 + 16 * nb + rw] = acc[nb][j] + rb; }
        if (lane < 32) wc[lane] = 0;
        LDS_WAIT(); asm volatile("" ::: "memory");
        if (lane < 16) {
            float lv[32];
#pragma unroll
            for (int e4 = 0; e4 < 8; ++e4) { const f32x4 t = *(const LAS f32x4*)(lg + lane * 32 + 4 * e4); lv[4 * e4] = t.x; lv[4 * e4 + 1] = t.y; lv[4 * e4 + 2] = t.z; lv[4 * e4 + 3] = t.w; }
            int sel[4]; float sv[4];
#pragma unroll
            for (int k = 0; k < 4; ++k) { float best = -3.0e38f; int bi = 0;
#pragma unroll
                for (int e = 0; e < 32; ++e) { bool taken = false;
#pragma unroll
                    for (int kk = 0; kk < k; ++kk) taken = taken || (sel[kk] == e);
                    if (!taken && lv[e] > best) { best = lv[e]; bi = e; } }
                sel[k] = bi; sv[k] = best; }
            const float e1 = __expf(sv[1] - sv[0]), e2 = __expf(sv[2] - sv[0]), e3 = __expf(sv[3] - sv[0]), inv = 1.0f / (1.0f + e1 + e2 + e3);
            const int tk = tok0 + lane;
            *(GAS v4u*)(TOKE + (size_t)tk * 4) = (v4u){(unsigned)sel[0], (unsigned)sel[1], (unsigned)sel[2], (unsigned)sel[3]};
            *(GAS f32x4*)(TOKG + (size_t)tk * 4) = (f32x4){inv, e1 * inv, e2 * inv, e3 * inv};
#pragma unroll
            for (int k = 0; k < 4; ++k) __hip_atomic_fetch_add(&wc[sel[k]], 1, __ATOMIC_RELAXED, __HIP_MEMORY_SCOPE_WORKGROUP);
        }
        LDS_WAIT(); asm volatile("" ::: "memory");
        if (lane < 32) WCNT[(size_t)gw * 32 + lane] = wc[lane];
        __syncthreads();
        if (wave == 0 && lane < 32) { int s = 0;
#pragma unroll
            for (int w = 0; w < 8; ++w) s += ((LAS int*)(F.lds + 16384 + w * 128))[lane];
            BCNT[F.bid * 32 + lane] = s; }
        __syncthreads();
    }
    {
        LAS float* scr = (LAS float*)(F.lds + 32768 + wave * 8448);
        const int gw = F.bid * 8 + wave, NGW = F.G * 8;
        bf16* BtGU = wsp<bf16>(F, WS_BTGU); bf16* BtD = wsp<bf16>(F, WS_BTD);
        for (int it = gw; it < NE * 6144; it += NGW) {
            const int e = it / 6144, r = it % 6144;
            if (r < 4096) { const int s = r / 2048, rr = r % 2048, kb = rr / 64, nb = rr % 64;
                tr_item((s ? F.in[I_EWU] : F.in[I_EWG]) + (size_t)e * D * D, D, 64 * kb, 32 * nb, BtGU + (size_t)e * 4096 * D, nullptr, D, 256 * (nb / 4) + 128 * s + 32 * (nb % 4), 64 * kb, scr, lane); }
            else { const int rr = r - 4096, kb = rr / 64, nb = rr % 64;
                tr_item(F.in[I_EWD] + (size_t)e * D * D, D, 64 * kb, 32 * nb, BtD + (size_t)e * D * D, nullptr, D, 32 * nb, 64 * kb, scr, lane); }
        }
    }
}

__device__ __forceinline__ void p10_sort(Frame& F) {
    const int lane = F.lane, wave = F.wave, gw = F.bid * 8 + wave;
    const int* TOKE = wsp<int>(F, WS_TOKE); const float* TOKG = wsp<float>(F, WS_TOKG); const int* WCNT = wsp<int>(F, WS_WCNT); const int* BCNT = wsp<int>(F, WS_BCNT);
    int* ETAB = wsp<int>(F, WS_ETAB); int* ROWTOK = wsp<int>(F, WS_ROWTOK); int* ROWDST = wsp<int>(F, WS_ROWDST); float* ROWGATE = wsp<float>(F, WS_ROWGATE);
    const int e = lane & 31, half = lane >> 5;
    int tot = 0, pre = 0;
    for (int bb = half; bb < 256; bb += 2) { const int c = BCNT[bb * 32 + e]; tot += c; pre += (bb < F.bid) ? c : 0; }
    tot += __shfl_xor(tot, 32); pre += __shfl_xor(pre, 32);
    for (int w = 0; w < wave; ++w) pre += WCNT[(size_t)(F.bid * 8 + w) * 32 + e];
    const int padded = ((tot + 255) / 256) * 256;
    int incl = padded;
#pragma unroll
    for (int o = 1; o < 32; o <<= 1) { const int t = __shfl_up(incl, o, 32); if (e >= o) incl += t; }
    const int pstart = incl - padded;
    if (gw == 0) {
        if (lane < 32) { ETAB[e] = pstart; ETAB[64 + e] = tot; if (e == 31) { ETAB[32] = incl; ETAB[128] = incl / 256; } }
        for (int t = lane; t < MAXTILES; t += 64) { int te = 0;
            for (int x = 0; x < 32; ++x) { const int ps = __shfl(pstart, x), pd = __shfl(padded, x); if (t * 256 >= ps && t * 256 < ps + pd) te = x; }
            ETAB[256 + t] = te; }
    }
    const int token = 16 * gw + (lane >> 2), slot = lane & 3;
    const int me = TOKE[(size_t)token * 4 + slot]; const float mg = TOKG[(size_t)token * 4 + slot];
    int rank = 0;
    for (int x = 0; x < 32; ++x) { const unsigned long long m = __ballot(me == x); if (me == x) rank = __popcll(m & ((1ull << lane) - 1ull)); }
    const int row = __shfl(pstart, me) + __shfl(pre, me) + rank;
    ROWTOK[row] = token; ROWDST[row] = token * 4 + slot; ROWGATE[row] = mg;
}

__device__ __forceinline__ void p13_final(Frame& F) {
    const int gw = F.bid * 8 + F.wave, NGW = F.G * 8, lane = F.lane;
    const float* macc = wsp<float>(F, WS_MODACC); const float* adab = F.in[I_ADAB]; const bf16* SLOT = wsp<bf16>(F, WS_SLOT);
    for (int row = gw; row < NLAT; row += NGW) {
        int l4 = 4 * lane; asm volatile("" : "+v"(l4));
        const int b = row / SEQ; float* xr = F.out + (size_t)row * D;
        f32x4 v[8]; float ss = 0.f;
#pragma unroll
        for (int j = 0; j < 8; ++j) { const int c = l4 + 256 * j;
            f32x4 m = (f32x4){0.f, 0.f, 0.f, 0.f};
#pragma unroll
            for (int s = 0; s < 4; ++s) m += unpk4(*(const GAS v2u*)(SLOT + ((size_t)row * 4 + s) * D + c));
            const f32x4 g5 = *(const GAS f32x4*)(macc + (size_t)b * 12288 + 5 * 2048 + c) + *(const GAS f32x4*)(adab + 5 * 2048 + c);
            v[j] = *(const GAS f32x4*)(xr + c) + g5 * m;
            ss += (v[j].x * v[j].x + v[j].y * v[j].y) + (v[j].z * v[j].z + v[j].w * v[j].w); }
        const float rstd = 1.0f / sqrtf(wave_sum(ss) * (1.0f / D) + 1e-6f);
#pragma unroll
        for (int j = 0; j < 8; ++j) *(GAS f32x4*)(xr + l4 + 256 * j) = v[j] * rstd * *(const GAS f32x4*)(F.in[I_FING] + l4 + 256 * j);
    }
}

constexpr int NPH = 13;
__global__ void __launch_bounds__(512, 2) mk_fwd(Args args) {
    extern __shared__ __attribute__((aligned(16))) unsigned char lds_raw[];
    Frame F;
    F.lds = (LAS unsigned char*)lds_raw; F.in = args.in; F.out = args.out; F.ws = args.ws;
    F.tid = threadIdx.x; F.lane = F.tid & 63; F.wave = __builtin_amdgcn_readfirstlane(F.tid >> 6); F.G = gridDim.x; F.bid = blockIdx.x;
    volatile LAS unsigned* MISC = (volatile LAS unsigned*)(F.lds + MISC_OFF);
    if (F.tid < 32) MISC[F.tid] = 0u;
    __syncthreads();
    const int lo = args.ph_lo, hi = args.ph_hi;
    unsigned* ctl = (unsigned*)(F.ws + WS_CTL);
    XcdBarrier bar; bar.bar = ctl + CW_BAR; bar.x = 0; bar.st = nullptr;
    if (hi - lo > 1) bar = xcd_barrier_post(ctl + CW_BAR, MISC + 8);
#ifndef PH_MASK
#define PH_MASK 0x1FFF
#endif
#define IN(k) (((PH_MASK >> (k)) & 1) && lo <= (k) && (k) < hi)
#define SEAM(k) do { if (IN(k) && IN((k) + 1)) xcd_barrier(bar); } while (0)

    if (IN(0)) { p0_adaln(F); p0_small_weights(F); p0_filter(F); }
    SEAM(0);
    if (IN(1)) { p1_norm1(F); }
    SEAM(1);
    if (IN(2)) {
        pg8::Gemm g{wsp<bf16>(F, WS_A1), wsp<bf16>(F, WS_BTIN), D, 0};
        pg8::InProjOrder S{F.G, F.bid};
        pg8::EpiInProj E{wsp<bf16>(F, WS_Z), wsp<bf16>(F, WS_AP)};
        pg8::gemm_phase<false>(F.lds, g, S, E);
    }
    SEAM(2);
    if (IN(3)) {
        pg8::Gemm g{wsp<bf16>(F, WS_AP), wsp<bf16>(F, WS_BTL), KLORA, 0};
        pg8::StaticOrder S; S.init(MROWS, NLORA, F.G, F.bid);
        pg8::EpiLora E{wsp<bf16>(F, WS_EA), F.in[I_RW0], F.in[I_RA0]};
        pg8::gemm_phase<false>(F.lds, g, S, E);
    }
    SEAM(3);
    if (IN(4)) { p4_prep(F); }
    SEAM(4);
    if (IN(5)) { p5_scan(F); p6_hyena(F); }
    SEAM(5);
    if (IN(6)) { p7_assemble(F); }
    SEAM(6);
    if (IN(7)) {
        pg8::Gemm g{wsp<bf16>(F, WS_A2), wsp<bf16>(F, WS_BTOUT), D, 0};
        pg8::StaticOrder S; S.init(NLAT, D, F.G, F.bid);
        pg8::EpiOutProj E{F.in[I_X], F.out, wsp<float>(F, WS_MODACC), F.in[I_ADAB]};
        pg8::gemm_phase<false>(F.lds, g, S, E);
    }
    SEAM(7);
    if (IN(8)) { p9_router(F); }
    SEAM(8);
    if (IN(9)) { p10_sort(F); }
    SEAM(9);
    if (IN(10)) {
        const int* ET = wsp<int>(F, WS_ETAB);
        pg8::Gemm g{wsp<bf16>(F, WS_H2), wsp<bf16>(F, WS_BTGU), D, (size_t)4096 * D * 2};
        pg8::MoeOrder S{F.G, F.bid, 16, ET[128], ET + 256, wsp<int>(F, WS_ROWTOK), ET, ET + 64};
        pg8::EpiSwiglu E{wsp<bf16>(F, WS_ACT), F.in[I_EBG], F.in[I_EBU]};
        pg8::gemm_phase<true>(F.lds, g, S, E);
    }
    SEAM(10);
    if (IN(11)) {
        const int* ET = wsp<int>(F, WS_ETAB);
        pg8::Gemm g{wsp<bf16>(F, WS_ACT), wsp<bf16>(F, WS_BTD), D, (size_t)D * D * 2};
        pg8::MoeOrder S{F.G, F.bid, 8, ET[128], ET + 256, wsp<int>(F, WS_ROWTOK), ET, ET + 64};
        pg8::EpiDown E{wsp<bf16>(F, WS_SLOT), F.in[I_EBD], wsp<int>(F, WS_ROWDST), wsp<float>(F, WS_ROWGATE), ET, ET + 64};
        pg8::gemm_phase<false>(F.lds, g, S, E);
    }
    SEAM(11);
    if (IN(12)) { p13_final(F); }
#undef IN
#undef SEAM
}

extern "C" void kernel_launch(void* const* d_in, const int* in_sizes, int n_in, void* d_out, int out_size, void* d_ws, size_t ws_size, hipStream_t stream) {
    static int grid = 0;
    if (grid == 0) {
        if (n_in != 44 || out_size != NLAT * D || ws_size < WS_END) { fprintf(stderr, "kernel_launch: unexpected problem (n_in %d, out %d, ws %zu)\n", n_in, out_size, ws_size); grid = -1; return; }
        if (hipFuncSetAttribute((const void*)mk_fwd, hipFuncAttributeMaxDynamicSharedMemorySize, LDS_BYTES) != hipSuccess) { fprintf(stderr, "kernel_launch: hipFuncSetAttribute failed\n"); grid = -1; return; }
        int per_cu = 0;
        if (hipOccupancyMaxActiveBlocksPerMultiprocessor(&per_cu, (const void*)mk_fwd, 512, LDS_BYTES) != hipSuccess || per_cu < 1) fprintf(stderr, "kernel_launch: occupancy query says %d blocks per CU\n", per_cu);
        (void)hipGetLastError();
        grid = 256;
    }
    if (grid < 0) return;
    (void)hipMemsetAsync((char*)d_ws + WS_CTL, 0, CTL_ZERO_BYTES, stream);
    Args a{};
    for (int i = 0; i < 44; ++i) a.in[i] = (const float*)d_in[i];
    a.out = (float*)d_out; a.ws = (unsigned char*)d_ws;
#if MK_PER_PHASE
    for (int ph = 0; ph < NPH; ++ph) { a.ph_lo = ph; a.ph_hi = ph + 1; hipLaunchKernelGGL(mk_fwd, dim3(grid), dim3(512), LDS_BYTES, stream, a); }
#else
    a.ph_lo = 0; a.ph_hi = NPH;
    hipLaunchKernelGGL(mk_fwd, dim3(grid), dim3(512), LDS_BYTES, stream, a);
#endif
    const hipError_t le = hipPeekAtLastError();
    if (le != hipSuccess) fprintf(stderr, "kernel_launch: launch failed: %s\n", hipGetErrorName(le));
}
```

```cpp
#include <hip/hip_runtime.h>
#include <cstdio>
#include <cstdint>

#ifndef MK_PER_PHASE
#define MK_PER_PHASE 0
#endif

#define GAS __attribute__((address_space(1)))
#define LAS __attribute__((address_space(3)))
typedef unsigned short bf16;
typedef unsigned v4u __attribute__((ext_vector_type(4)));
typedef unsigned v2u __attribute__((ext_vector_type(2)));
typedef float f32x4 __attribute__((ext_vector_type(4)));
typedef float f32x2 __attribute__((ext_vector_type(2)));
typedef short bf16x8 __attribute__((ext_vector_type(8)));

constexpr int NB = 16, SEQ = 2048, CTXL = 256, D = 2048;
constexpr int NLAT = NB * SEQ;
constexpr int NCTX = NB * CTXL;
constexpr int MROWS = NLAT + NCTX;
constexpr int PW = 6144;
constexpr int NIN = 6656;
constexpr int NLORA = 5120, KLORA = 512;
constexpr int NE = 32, TOPK = 4;
constexpr int NASG = NLAT * TOPK;
constexpr int MAXTILES = NASG / 256 + NE;
constexpr int SIW = 7168;

constexpr size_t MiB = 1u << 20;
constexpr size_t WS_CTL = 0;
constexpr size_t WS_MODACC = 1 * MiB;
constexpr size_t CTL_ZERO_BYTES = 2 * MiB;
constexpr size_t WS_MODT = 2 * MiB;
constexpr size_t WS_BS = 3 * MiB;
constexpr size_t WS_TOKE = 5 * MiB;
constexpr size_t WS_TOKG = 6 * MiB;
constexpr size_t WS_WCNT = 7 * MiB;
constexpr size_t WS_BCNT = 7 * MiB + 512 * 1024;
constexpr size_t WS_ETAB = 7 * MiB + 768 * 1024;
constexpr size_t WS_ROWTOK = 8 * MiB;
constexpr size_t WS_ROWDST = 9 * MiB;
constexpr size_t WS_ROWGATE = 10 * MiB;
constexpr size_t WS_G = 16 * MiB;
constexpr size_t WS_BTIN = 24 * MiB;
constexpr size_t WS_BTL = 50 * MiB;
constexpr size_t WS_BTOUT = 55 * MiB;
constexpr size_t WS_WR = 63 * MiB;
constexpr size_t WS_A1 = 64 * MiB;
constexpr size_t WS_Z = 208 * MiB;
constexpr size_t WS_AP = 640 * MiB;
constexpr size_t WS_EA = 676 * MiB;
constexpr size_t WS_SI = 1036 * MiB;
constexpr size_t WS_UT = 1540 * MiB;
constexpr size_t WS_X0T = 1604 * MiB;
constexpr size_t WS_YCT = 1668 * MiB;
constexpr size_t WS_YS = 64 * MiB;
constexpr size_t WS_A2 = 320 * MiB;
constexpr size_t WS_H2 = 64 * MiB;
constexpr size_t WS_BTGU = 192 * MiB;
constexpr size_t WS_BTD = 704 * MiB;
constexpr size_t WS_ACT = 960 * MiB;
constexpr size_t WS_SLOT = 1504 * MiB;
constexpr size_t WS_END = 2016 * MiB;

constexpr int CW_TMO = 0;
constexpr int CW_BAR = 4096;

constexpr int LDS_BYTES = 147456;
constexpr int MISC_OFF = 143360;

__device__ __forceinline__ unsigned f2bf(float f) { unsigned u = __builtin_bit_cast(unsigned, f); return (u + 0x7fffu + ((u >> 16) & 1u)) >> 16; }
__device__ __forceinline__ unsigned pk2(float lo, float hi) { return f2bf(lo) | (f2bf(hi) << 16); }
__device__ __forceinline__ float bf2f(unsigned b) { return __builtin_bit_cast(float, b << 16); }
__device__ __forceinline__ float bflo(unsigned w) { return __builtin_bit_cast(float, w << 16); }
__device__ __forceinline__ float bfhi(unsigned w) { return __builtin_bit_cast(float, w & 0xffff0000u); }
__device__ __forceinline__ float fsigmoid(float x) { return 1.0f / (1.0f + __expf(-x)); }
__device__ __forceinline__ float ftanh(float x) { const float e = __expf(2.0f * x); return 1.0f - 2.0f / (e + 1.0f); }
#define LDS_WAIT() asm volatile("s_waitcnt lgkmcnt(0)" ::: "memory")
#define VM_WAIT() asm volatile("s_waitcnt vmcnt(0)" ::: "memory")

#define XB_TMO      128
#define XB_XCNT(j)  (256  + 64 * (j))
#define XB_XSUB(j)  (1280 + 64 * (j))
#define XB_XGEN(j)  (2304 + 64 * (j))
#define XB_TOP      3328
#define XB_TOPGEN   3392
#define XCD_BAR_WORDS 3456
#define XB_SPIN_CAP (1u << 20)

__device__ __forceinline__ unsigned xb_ld(unsigned* p)              { return __hip_atomic_load(p, __ATOMIC_RELAXED, __HIP_MEMORY_SCOPE_AGENT); }
__device__ __forceinline__ unsigned xb_add(unsigned* p, unsigned v) { return __hip_atomic_fetch_add(p, v, __ATOMIC_RELAXED, __HIP_MEMORY_SCOPE_AGENT); }
__device__ __forceinline__ unsigned xb_xcc_id() { return (unsigned)__builtin_amdgcn_s_getreg((3 << 11) | 20) & 0xFu; }
#define XB_SPIN(cond, bar) do { unsigned _sp = 0; while (cond) { __builtin_amdgcn_s_sleep(1); \
    if ((++_sp & 255u) == 0u) { if (xb_ld(&(bar)[XB_TMO])) break; if (_sp > XB_SPIN_CAP) { atomicAdd(&(bar)[XB_TMO], 1u); break; } } } } while (0)

struct XcdBarrier { unsigned* bar; unsigned x; volatile LAS unsigned* st; };

__device__ __forceinline__ XcdBarrier xcd_barrier_post(unsigned* bar, volatile LAS unsigned* st) {
    XcdBarrier b; b.bar = bar; b.x = xb_xcc_id(); b.st = st;
    if (threadIdx.x == 0) (void)xb_add(&bar[XB_XCNT(b.x)], 1u);
    return b;
}
__device__ __forceinline__ void xcd_barrier_complete(unsigned* bar, unsigned x, unsigned& nloc, unsigned& nx) {
    const unsigned G = gridDim.x * gridDim.y * gridDim.z;
    unsigned sum, cnt, mine, sp = 0u;
    for (;;) {
        sum = 0u; cnt = 0u; mine = 0u;
#pragma unroll
        for (unsigned j = 0; j < 16; ++j) { const unsigned c = xb_ld(&bar[XB_XCNT(j)]); sum += c; cnt += (c > 0u) ? 1u : 0u; mine = (j == x) ? c : mine; }
        if (sum == G) break;
        __builtin_amdgcn_s_sleep(1);
        if ((++sp & 255u) == 0u) { if (xb_ld(&bar[XB_TMO])) break; if (sp > XB_SPIN_CAP) { atomicAdd(&bar[XB_TMO], 1u); break; } }
    }
    nloc = mine > 0u ? mine : 1u; nx = cnt > 0u ? cnt : 1u;
}
__device__ __forceinline__ void xcd_barrier(const XcdBarrier& b) {
    asm volatile("s_waitcnt vmcnt(0)" ::: "memory");
    __syncthreads();
    if (threadIdx.x == 0) {
        unsigned* bar = b.bar;
        __builtin_amdgcn_s_waitcnt(0);
        unsigned nloc = b.st[0], nx = b.st[1];
        if (nloc == 0u) { xcd_barrier_complete(bar, b.x, nloc, nx); b.st[0] = nloc; b.st[1] = nx; }
        const unsigned old = xb_add(&bar[XB_XSUB(b.x)], 1u);
        const unsigned gen = old / nloc;
        if (old + 1u == (gen + 1u) * nloc) {
            __builtin_amdgcn_fence(__ATOMIC_RELEASE, "agent");
            asm volatile("s_waitcnt vmcnt(0)" ::: "memory");
            const unsigned og = xb_add(&bar[XB_TOP], 1u);
            const unsigned tg = og / nx;
            if (og + 1u == (tg + 1u) * nx) xb_add(&bar[XB_TOPGEN], 1u);
            else XB_SPIN(xb_ld(&bar[XB_TOPGEN]) == tg, bar);
            __builtin_amdgcn_fence(__ATOMIC_ACQUIRE, "agent");
            xb_add(&bar[XB_XGEN(b.x)], 1u);
            asm volatile("s_waitcnt vmcnt(0)" ::: "memory");
        } else {
            XB_SPIN(xb_ld(&bar[XB_XGEN(b.x)]) == gen, bar);
            __builtin_amdgcn_fence(__ATOMIC_ACQUIRE, "agent");
            asm volatile("s_waitcnt vmcnt(0)" ::: "memory");
        }
    }
    __syncthreads();
}

namespace pg8 {
constexpr int BM = 256, BK = 64, HALF = 128, HTB = HALF * BK * 2, STAGE_BYTES = 8 * HTB, NXCD = 8, WGM = 8;
__device__ __forceinline__ int lds_byte(int r, int c) { const int st = (r >> 4) * 2 + (c >> 5), rr = r & 15, cc = c & 31, ob = rr * 64 + cc * 2; return st * 1024 + (ob ^ (((ob >> 9) & 1) << 5)); }
__device__ __forceinline__ void stage_rc(int b, int& R, int& C) { const int st = b / 1024, sb = b % 1024, swz = sb ^ (((sb >> 9) & 1) << 5); R = (st >> 1) * 16 + swz / 64; C = (st & 1) * 32 + (swz % 64) / 2; }
__device__ __forceinline__ int perm32(int rho) { const int n = rho >> 4, i = rho & 15; return 8 * (i >> 2) + 4 * n + (i & 3); }

struct Unit { int pm, pn, e; };
struct Gemm { const bf16* A; const bf16* Bt; int K; size_t bstrideE; };

__device__ __forceinline__ unsigned cvt_pk_bf16(float lo, float hi) { unsigned r; asm volatile("v_cvt_pk_bf16_f32 %0, %1, %2" : "=v"(r) : "v"(lo), "v"(hi)); return r; }

template <bool GATHER, class Epi, class Sched>
__device__ __forceinline__ void gemm_phase(LAS unsigned char* lds, const Gemm g, const Sched& S, const Epi& E) {
    const int tid = threadIdx.x, wid = __builtin_amdgcn_readfirstlane(tid >> 6), lane = tid & 63, wr = wid >> 2, wc = wid & 3, fr = lane & 15, fq = lane >> 4;
    const int K = g.K, nt = K / BK;
    unsigned voffB[2]; int RA[2], CA[2];
#pragma unroll
    for (int i = 0; i < 2; ++i) { int R, C; stage_rc(tid * 16 + i * 8192, R, C); const int Rb = Epi::PERM ? ((R & ~31) + perm32(R & 31)) : R;
        RA[i] = R; CA[i] = C; voffB[i] = (unsigned)(Rb * K + C) * 2u; }
    const size_t kstep = (size_t)(BK * 2);
    const size_t hstep = (size_t)HALF * K * 2;
    const size_t tstep = 2 * hstep;
    const unsigned ldsw = (unsigned)wid * 1024u;
    const int aoff = lds_byte(wr * 64 + fr, fq * 8), boff = lds_byte(wc * 32 + fr, fq * 8);
#define PG8_SA(b, h) (((b) * 2 + (h)) * HTB)
#define PG8_SB(b, h) ((4 + (b) * 2 + (h)) * HTB)
#define PG8_STAGE(bufoff, gbase, voff) do { _Pragma("unroll") for (int _i = 0; _i < 2; ++_i) \
        __builtin_amdgcn_global_load_lds((const unsigned*)((const char*)(gbase) + (voff)[_i]), (LAS unsigned*)(lds + (bufoff) + ldsw + _i * 8192), 16, 0, 0); } while (0)
#define PG8_LDA(dst, b, h) do { _Pragma("unroll") for (int m = 0; m < 4; ++m) _Pragma("unroll") for (int k = 0; k < 2; ++k) dst[m][k] = *(const LAS bf16x8*)(lds + PG8_SA(b, h) + aoff + m * 2048 + k * 1024); } while (0)
#define PG8_LDB(dst, b, h) do { _Pragma("unroll") for (int n = 0; n < 2; ++n) _Pragma("unroll") for (int k = 0; k < 2; ++k) dst[n][k] = *(const LAS bf16x8*)(lds + PG8_SB(b, h) + boff + n * 2048 + k * 1024); } while (0)
#define PG8_MMA(ai, bj, At, Bt) do { __builtin_amdgcn_s_setprio(1); _Pragma("unroll") for (int m = 0; m < 4; ++m) _Pragma("unroll") for (int n = 0; n < 2; ++n) _Pragma("unroll") for (int k = 0; k < 2; ++k) \
        acc[ai][bj][m][n] = __builtin_amdgcn_mfma_f32_16x16x32_bf16(Bt[n][k], At[m][k], acc[ai][bj][m][n], 0, 0, 0); __builtin_amdgcn_s_setprio(0); } while (0)
#define PG8_WAIT_V(n) asm volatile("s_waitcnt vmcnt(" #n ")" ::: "memory")
#define PG8_WAIT_L(n) asm volatile("s_waitcnt lgkmcnt(" #n ")" ::: "memory")
#define PG8_BAR __builtin_amdgcn_s_barrier()
#define PG8_SCHED __builtin_amdgcn_sched_barrier(0)
    Unit cur, nxt; int ui = 0;
    if (!S.next(0, cur)) return;
    f32x4 acc[2][2][4][2];
#pragma unroll
    for (int a = 0; a < 2; ++a)
#pragma unroll
        for (int b = 0; b < 2; ++b)
#pragma unroll
            for (int m = 0; m < 4; ++m)
#pragma unroll
                for (int n = 0; n < 2; ++n) acc[a][b][m][n] = (f32x4){0.f, 0.f, 0.f, 0.f};
    bf16x8 At[4][2], B0[2][2], B1[2][2];
    unsigned vA0[2], vA1[2], vN0[2], vN1[2];
    const char* cA; const char* cB;
    if constexpr (GATHER) {
        cA = (const char*)g.A;
#pragma unroll
        for (int i = 0; i < 2; ++i) { vA0[i] = (unsigned)(S.arow(cur, RA[i]) * K + CA[i]) * 2u; vA1[i] = (unsigned)(S.arow(cur, HALF + RA[i]) * K + CA[i]) * 2u; }
    } else {
        cA = (const char*)g.A + (size_t)cur.pm * tstep;
#pragma unroll
        for (int i = 0; i < 2; ++i) { vA0[i] = (unsigned)(RA[i] * K + CA[i]) * 2u; vA1[i] = vA0[i] + (unsigned)hstep; }
    }
#pragma unroll
    for (int i = 0; i < 2; ++i) { vN0[i] = vA0[i]; vN1[i] = vA1[i]; }
    cB = (const char*)g.Bt + (size_t)cur.e * g.bstrideE + (size_t)cur.pn * tstep;
    PG8_STAGE(PG8_SB(0, 0), cB, voffB); PG8_STAGE(PG8_SA(0, 0), cA, vA0); PG8_STAGE(PG8_SB(0, 1), cB + hstep, voffB); PG8_STAGE(PG8_SA(0, 1), cA, vA1);
    if (wr == 1) PG8_BAR;
    PG8_WAIT_V(4); PG8_BAR;
    PG8_STAGE(PG8_SB(1, 0), cB + kstep, voffB); PG8_STAGE(PG8_SA(1, 0), cA + kstep, vA0); PG8_STAGE(PG8_SB(1, 1), cB + hstep + kstep, voffB);
    PG8_WAIT_V(6); PG8_BAR;
    for (;;) {
        const bool has_next = S.next(ui + 1, nxt);
        const char* nA; const char* nB;
        if (has_next) {
            nB = (const char*)g.Bt + (size_t)nxt.e * g.bstrideE + (size_t)nxt.pn * tstep;
            if constexpr (GATHER) { nA = cA;
#pragma unroll
                for (int i = 0; i < 2; ++i) { vN0[i] = (unsigned)(S.arow(nxt, RA[i]) * K + CA[i]) * 2u; vN1[i] = (unsigned)(S.arow(nxt, HALF + RA[i]) * K + CA[i]) * 2u; }
            } else nA = (const char*)g.A + (size_t)nxt.pm * tstep;
        } else { nA = cA; nB = cB;
#pragma unroll
            for (int i = 0; i < 2; ++i) { vN0[i] = vA0[i]; vN1[i] = vA1[i]; } }
        for (int t = 0; t < nt; t += 2) {
            const bool last = (t == nt - 2);
            const char* a1 = cA + (size_t)(t + 1) * kstep;
            const char* a2 = last ? nA : cA + (size_t)(t + 2) * kstep; const char* b2 = last ? nB : cB + (size_t)(t + 2) * kstep;
            const char* a3 = a2 + kstep; const char* b3 = b2 + kstep;
            unsigned w0[2], w1[2];
#pragma unroll
            for (int i = 0; i < 2; ++i) { if constexpr (GATHER) { w0[i] = last ? vN0[i] : vA0[i]; w1[i] = last ? vN1[i] : vA1[i]; } else { w0[i] = vA0[i]; w1[i] = vA1[i]; } }
            PG8_LDB(B0, 0, 0); PG8_SCHED; PG8_LDA(At, 0, 0); PG8_STAGE(PG8_SA(1, 1), a1, vA1);
            PG8_WAIT_L(8); PG8_BAR; PG8_WAIT_L(0); PG8_MMA(0, 0, At, B0); PG8_BAR; PG8_SCHED;
            PG8_LDB(B1, 0, 1); PG8_STAGE(PG8_SB(0, 0), b2, voffB);
            PG8_BAR; PG8_WAIT_L(0); PG8_MMA(0, 1, At, B1); PG8_BAR;
            PG8_LDA(At, 0, 1); PG8_STAGE(PG8_SA(0, 0), a2, w0);
            PG8_BAR; PG8_WAIT_L(0); PG8_MMA(1, 0, At, B0); PG8_BAR; PG8_SCHED;
            PG8_STAGE(PG8_SB(0, 1), b2 + hstep, voffB);
            PG8_WAIT_V(6); PG8_BAR; PG8_MMA(1, 1, At, B1); PG8_BAR;
            PG8_LDB(B0, 1, 0); PG8_SCHED; PG8_LDA(At, 1, 0); PG8_STAGE(PG8_SA(0, 1), a2, w1);
            PG8_WAIT_L(8); PG8_BAR; PG8_WAIT_L(0); PG8_MMA(0, 0, At, B0); PG8_BAR; PG8_SCHED;
            PG8_LDB(B1, 1, 1); PG8_STAGE(PG8_SB(1, 0), b3, voffB);
            PG8_BAR; PG8_WAIT_L(0); PG8_MMA(0, 1, At, B1); PG8_BAR;
            PG8_LDA(At, 1, 1); PG8_STAGE(PG8_SA(1, 0), a3, w0);
            PG8_BAR; PG8_WAIT_L(0); PG8_MMA(1, 0, At, B0); PG8_BAR; PG8_SCHED;
            PG8_STAGE(PG8_SB(1, 1), b3 + hstep, voffB);
            PG8_WAIT_V(6); PG8_BAR; PG8_MMA(1, 1, At, B1); PG8_BAR;
        }
        E(acc, cur, wr, wc, fr, fq);
        if (!has_next) break;
#pragma unroll
        for (int a = 0; a < 2; ++a)
#pragma unroll
            for (int b = 0; b < 2; ++b)
#pragma unroll
                for (int m = 0; m < 4; ++m)
#pragma unroll
                    for (int n = 0; n < 2; ++n) acc[a][b][m][n] = (f32x4){0.f, 0.f, 0.f, 0.f};
        cur = nxt; cA = nA; cB = nB; ++ui;
#pragma unroll
        for (int i = 0; i < 2; ++i) { vA0[i] = vN0[i]; vA1[i] = vN1[i]; }
    }
    PG8_WAIT_V(0);
    if (wr == 0) PG8_BAR;
    PG8_BAR;
#undef PG8_SA
#undef PG8_SB
#undef PG8_STAGE
#undef PG8_LDA
#undef PG8_LDB
#undef PG8_MMA
#undef PG8_WAIT_V
#undef PG8_WAIT_L
#undef PG8_BAR
#undef PG8_SCHED
}
}

struct Args { const float* in[44]; float* out; unsigned char* ws; int ph_lo, ph_hi; };
enum InIdx { I_X = 0, I_C, I_CTX, I_CCTX, I_ADAW, I_ADAB, I_N1G, I_N2G, I_INW, I_CONVW, I_CONVB, I_HW1, I_HB1, I_HW2, I_HB2, I_HW3, I_HB3, I_HFREQ, I_HW4, I_HBIAS, I_HNG,
             I_RW0, I_RW1, I_RW2, I_RA0, I_RA1, I_RA2, I_RKK, I_RKA, I_RRK, I_RG1, I_RG2, I_LNG, I_LNB, I_OUTW, I_ROUTW, I_ROUTB, I_EWG, I_EBG, I_EWU, I_EBU, I_EWD, I_EBD, I_FING };

struct Frame {
    LAS unsigned char* lds;
    const float* const* in;
    float* out; unsigned char* ws;
    int tid, lane, wave, G, bid;
};
template <class T> __device__ __forceinline__ T* wsp(const Frame& F, size_t off) { return (T*)(F.ws + off); }

template <int CTRL> __device__ __forceinline__ float dpp_mov(float x) { return __builtin_bit_cast(float, __builtin_amdgcn_update_dpp(0, __builtin_bit_cast(int, x), CTRL, 0xF, 0xF, true)); }
__device__ __forceinline__ float row16_sum(float v) {
    v += dpp_mov<0x128>(v);
    v += dpp_mov<0x124>(v);
    v += dpp_mov<0x122>(v);
    v += dpp_mov<0x121>(v);
    return v;
}

__device__ __forceinline__ float rdlane(float v, int l) { return __builtin_bit_cast(float, __builtin_amdgcn_readlane(__builtin_bit_cast(int, v), l)); }
__device__ __forceinline__ float wave_sum(float v) { v = row16_sum(v); return (rdlane(v, 0) + rdlane(v, 16)) + (rdlane(v, 32) + rdlane(v, 48)); }

__device__ __forceinline__ void tr_item(const float* src, size_t ld_src, int k0, int n0, bf16* dst, bf16* dlo, size_t ld_dst, int drow0, int dk0, LAS float* scr, int lane) {
    const int c = lane & 7;
    if (src == nullptr) {
#pragma unroll
        for (int j = 0; j < 4; ++j) { const int n = (lane >> 3) + 8 * j; *(GAS v4u*)(dst + (size_t)(drow0 + n) * ld_dst + dk0 + 8 * c) = (v4u){0u, 0u, 0u, 0u}; }
        return;
    }
#pragma unroll 8
    for (int i = 0; i < 32; ++i) { const int kk = 2 * i + (lane >> 5); scr[kk * 33 + (lane & 31)] = src[(size_t)(k0 + kk) * ld_src + n0 + (lane & 31)]; }
    LDS_WAIT(); asm volatile("" ::: "memory");
#pragma unroll
    for (int j = 0; j < 4; ++j) { const int n = (lane >> 3) + 8 * j; const LAS float* s = scr + (8 * c) * 33 + n;
        float v[8];
#pragma unroll
        for (int q = 0; q < 8; ++q) v[q] = s[q * 33];
        v4u o; o.x = pk2(v[0], v[1]); o.y = pk2(v[2], v[3]); o.z = pk2(v[4], v[5]); o.w = pk2(v[6], v[7]);
        *(GAS v4u*)(dst + (size_t)(drow0 + n) * ld_dst + dk0 + 8 * c) = o;
        if (dlo) { float r[8];
#pragma unroll
            for (int q = 0; q < 8; ++q) r[q] = v[q] - bf2f(f2bf(v[q]));
            v4u p; p.x = pk2(r[0], r[1]); p.y = pk2(r[2], r[3]); p.z = pk2(r[4], r[5]); p.w = pk2(r[6], r[7]);
            *(GAS v4u*)(dlo + (size_t)(drow0 + n) * ld_dst + dk0 + 8 * c) = p; } }
    LDS_WAIT(); asm volatile("" ::: "memory");
}

__device__ __forceinline__ void p0_small_weights(Frame& F) {
    LAS float* scr = (LAS float*)(F.lds + F.wave * 8448);
    const int gw = F.bid * 8 + F.wave, NGW = F.G * 8;
    constexpr int I_T1 = 32 * 192, I_T2 = 128, I_T3 = 128, I_T4 = 128, I_T5 = 128, I_T6 = 32 * 64, I_T7 = 160 * 8, I_T8 = 32;
    constexpr int NITEMS = I_T1 + I_T2 + I_T3 + I_T4 + I_T5 + I_T6 + I_T7 + I_T8;
    bf16* BtIn = wsp<bf16>(F, WS_BTIN); bf16* BtL = wsp<bf16>(F, WS_BTL); bf16* BtOut = wsp<bf16>(F, WS_BTOUT); bf16* Wr = wsp<bf16>(F, WS_WR);
    for (int it = gw; it < NITEMS; it += NGW) {
        int r = it;
        if (r < I_T1) { const int kb = r / 192, nb = r % 192; tr_item(F.in[I_INW], PW, 64 * kb, 32 * nb, BtIn, nullptr, D, 32 * nb, 64 * kb, scr, F.lane); continue; } r -= I_T1;
        if (r < I_T2) { const int dir = r / 64, q = r % 64, kb = q / 2, nb = q % 2; tr_item(F.in[I_RW1] + (size_t)dir * D * 64, 64, 64 * kb, 32 * nb, BtIn, nullptr, D, 6144 + 64 * dir + 32 * nb, 64 * kb, scr, F.lane); continue; } r -= I_T2;
        if (r < I_T3) { const int dir = r / 64, q = r % 64, kb = q / 2, nb = q % 2; tr_item(F.in[I_RA1] + (size_t)dir * D * 64, 64, 64 * kb, 32 * nb, BtIn, nullptr, D, 6272 + 64 * dir + 32 * nb, 64 * kb, scr, F.lane); continue; } r -= I_T3;
        if (r < I_T4) { const int kb = r / 4, nb = r % 4; tr_item(F.in[I_RG1], 128, 64 * kb, 32 * nb, BtIn, nullptr, D, 6400 + 32 * nb, 64 * kb, scr, F.lane); continue; } r -= I_T4;
        if (r < I_T5) { const int kb = r / 4, nb = r % 4; tr_item(nullptr, 0, 0, 0, BtIn, nullptr, D, 6528 + 32 * nb, 64 * kb, scr, F.lane); continue; } r -= I_T5;
        if (r < I_T6) { const int kb = r / 64, nb = r % 64; tr_item(F.in[I_OUTW], D, 64 * kb, 32 * nb, BtOut, nullptr, D, 32 * nb, 64 * kb, scr, F.lane); continue; } r -= I_T6;
        if (r < I_T7) { const int nb = r / 8, kb = r % 8, j = nb / 32, n0 = (nb % 32) * 32; const float* src = nullptr; int k0 = 0;
            if (j == 0 && kb == 0) src = F.in[I_RW2];
            else if (j == 1 && kb == 1) src = F.in[I_RW2] + 64 * 1024;
            else if (j == 2 && kb == 2) src = F.in[I_RA2];
            else if (j == 3 && kb == 3) src = F.in[I_RA2] + 64 * 1024;
            else if (j == 4 && (kb == 4 || kb == 5)) { src = F.in[I_RG2]; k0 = 64 * (kb - 4); }
            tr_item(src, 1024, k0, n0, BtL, nullptr, KLORA, 32 * nb, 64 * kb, scr, F.lane); continue; } r -= I_T7;
        { const int kb = r; tr_item(F.in[I_ROUTW], 32, 64 * kb, 0, Wr, Wr + 32 * D, D, 0, 64 * kb, scr, F.lane); }
    }
}

__device__ __forceinline__ void p0_adaln(Frame& F) {
    if (F.bid >= 192) return;
    const int kc = F.bid / 6, cg = F.bid % 6, k0 = 64 * kc;
    LAS float* sc = (LAS float*)(F.lds + 73728);
    for (int i = F.tid; i < 17 * 64; i += 512) { const int b = i / 64, k = i % 64; const float c = (b < 16) ? F.in[I_C][b * D + k0 + k] : F.in[I_CCTX][k0 + k]; sc[i] = c * fsigmoid(c); }
    __syncthreads();
    const int col = cg * 2048 + F.wave * 256 + F.lane * 4;
    f32x4 acc[17];
#pragma unroll
    for (int b = 0; b < 17; ++b) acc[b] = (f32x4){0.f, 0.f, 0.f, 0.f};
    const float* W = F.in[I_ADAW] + (size_t)k0 * 12288 + col;
    for (int k = 0; k < 64; k += 4) {
        f32x4 w[4];
#pragma unroll
        for (int j = 0; j < 4; ++j) w[j] = *(const GAS f32x4*)(W + (size_t)(k + j) * 12288);
#pragma unroll
        for (int b = 0; b < 17; ++b) { const f32x4 s = *(const LAS f32x4*)(sc + b * 64 + k);
            acc[b] += s.x * w[0]; acc[b] += s.y * w[1]; acc[b] += s.z * w[2]; acc[b] += s.w * w[3]; }
    }
    float* macc = wsp<float>(F, WS_MODACC);
#pragma unroll
    for (int b = 0; b < 17; ++b) { float* p = macc + (size_t)b * 12288 + col; atomicAdd(p + 0, acc[b].x); atomicAdd(p + 1, acc[b].y); atomicAdd(p + 2, acc[b].z); atomicAdd(p + 3, acc[b].w); }
    __syncthreads();
}

__device__ __forceinline__ void p0_filter(Frame& F) {
    LAS float* hs = (LAS float*)(F.lds + 81920 + F.wave * 256);
    const int gw = F.bid * 8 + F.wave, NGW = F.G * 8, j = F.lane;
    const float freq = F.in[I_HFREQ][j];
    bf16* Gt = wsp<bf16>(F, WS_G);
    for (int t = gw; t < SEQ; t += NGW) {
        const float tl = (float)t * (1.0f / 2047.0f);
        float pre = F.in[I_HB1][j] + tl * F.in[I_HW1][j];
#pragma unroll 4
        for (int i = 0; i < 16; ++i) {
            const float band = 1e-4f + (float)i * ((15.0f - 1e-4f) / 15.0f);
            float rev = band * (float)t * (1.0f / 2048.0f); rev = rev - floorf(rev);
            const float cs = __builtin_amdgcn_cosf(rev), sn = __builtin_amdgcn_sinf(rev);
            pre += cs * F.in[I_HW1][(1 + i) * 64 + j] - sn * F.in[I_HW1][(17 + i) * 64 + j];
        }
        float h = __sinf(freq * pre);
        hs[j] = h; LDS_WAIT(); asm volatile("" ::: "memory");
        pre = F.in[I_HB2][j];
#pragma unroll 8
        for (int i = 0; i < 64; ++i) pre += hs[i] * F.in[I_HW2][i * 64 + j];
        h = __sinf(freq * pre);
        LDS_WAIT(); asm volatile("" ::: "memory");
        hs[j] = h; LDS_WAIT(); asm volatile("" ::: "memory");
        pre = F.in[I_HB3][j];
#pragma unroll 8
        for (int i = 0; i < 64; ++i) pre += hs[i] * F.in[I_HW3][i * 64 + j];
        h = __sinf(freq * pre);
        LDS_WAIT(); asm volatile("" ::: "memory");
        hs[j] = h; LDS_WAIT(); asm volatile("" ::: "memory");
        f32x4 o[8];
#pragma unroll
        for (int m = 0; m < 8; ++m) o[m] = (f32x4){0.f, 0.f, 0.f, 0.f};
#pragma unroll 2
        for (int i = 0; i < 64; ++i) { const float hv = hs[i]; const float* w4 = F.in[I_HW4] + (size_t)i * 2048 + 4 * j;
#pragma unroll
            for (int m = 0; m < 8; ++m) o[m] += hv * *(const GAS f32x4*)(w4 + 256 * m); }
        LDS_WAIT(); asm volatile("" ::: "memory");
        const float dlo = -3.0701134573253945f, dhi = -15.350567286626973f;
#pragma unroll
        for (int m = 0; m < 8; ++m)
#pragma unroll
            for (int q = 0; q < 4; ++q) { const int n = 256 * m + 4 * j + q, c = n & 1023;
                const float delta = fabsf(dlo + (dhi - dlo) * ((float)c * (1.0f / 1023.0f)));
                const float val = o[m][q] * __expf(-tl * delta);
                if (n < 1024) Gt[(size_t)c * 4096 + (2048 - t)] = (bf16)f2bf(val);
                else if (t > 0) Gt[(size_t)c * 4096 + (2048 + t)] = (bf16)f2bf(val);
                else Gt[(size_t)c * 4096] = 0; }
    }
}

__device__ __forceinline__ void p1_norm1(Frame& F) {
    const int gw = F.bid * 8 + F.wave, NGW = F.G * 8, lane = F.lane;
    const float* macc = wsp<float>(F, WS_MODACC); const float* adab = F.in[I_ADAB];
    bf16* A1 = wsp<bf16>(F, WS_A1);
    f32x4 g[8];
#pragma unroll
    for (int j = 0; j < 8; ++j) g[j] = *(const GAS f32x4*)(F.in[I_N1G] + 4 * lane + 256 * j);
    for (int row = gw; row < MROWS; row += NGW) {
        const int b = row < NLAT ? row / SEQ : 16;
        const float* xr = row < NLAT ? F.in[I_X] + (size_t)row * D : F.in[I_CTX] + (size_t)(row - NLAT) * D;
        f32x4 v[8]; float ss = 0.f;
#pragma unroll
        for (int j = 0; j < 8; ++j) { v[j] = *(const GAS f32x4*)(xr + 4 * lane + 256 * j); ss += (v[j].x * v[j].x + v[j].y * v[j].y) + (v[j].z * v[j].z + v[j].w * v[j].w); }
        const float rstd = 1.0f / sqrtf(wave_sum(ss) * (1.0f / D) + 1e-6f);
        const float* mrow = macc + (size_t)b * 12288;
#pragma unroll
        for (int j = 0; j < 8; ++j) { const int c = 4 * lane + 256 * j;
            const f32x4 sh = *(const GAS f32x4*)(mrow + c) + *(const GAS f32x4*)(adab + c);
            const f32x4 sc = *(const GAS f32x4*)(mrow + 2048 + c) + *(const GAS f32x4*)(adab + 2048 + c);
            const f32x4 y = v[j] * rstd * g[j] * (1.0f + sc) + sh;
            v2u o; o.x = pk2(y.x, y.y); o.y = pk2(y.z, y.w);
            *(GAS v2u*)(A1 + (size_t)row * D + c) = o; }
    }
    if (F.bid < 16) { const int b = F.bid; float* T = wsp<float>(F, WS_MODT) + (size_t)b * 4096; const float* mrow = macc + (size_t)b * 12288;
        for (int k = F.tid; k < D; k += 512) { const float sh = mrow[3 * 2048 + k] + adab[3 * 2048 + k], sc = mrow[4 * 2048 + k] + adab[4 * 2048 + k];
            T[k] = F.in[I_N2G][k] * (1.0f + sc); T[2048 + k] = sh; } }
}

namespace pg8 {
__device__ __forceinline__ void static_unit(int L, int nM, int nN, Unit& u) {
    const int nwg = nM * nN; int wgid = L;
    { const int q = nwg / NXCD, r = nwg % NXCD, xcd = wgid % NXCD, off = wgid / NXCD; wgid = (xcd < r ? xcd * (q + 1) : r * (q + 1) + (xcd - r) * q) + off; }
    const int nig = WGM * nN, gid = wgid / nig, fm = gid * WGM, gsz = (nM - fm) < WGM ? (nM - fm) : WGM;
    u.pm = fm + ((wgid % nig) % gsz); u.pn = (wgid % nig) / gsz; u.e = 0;
}
struct StaticOrder {
    int nM, nN, nwg, G, c;
    __device__ void init(int M, int N, int G_, int c_) { nM = M / BM; nN = N / BM; nwg = nM * nN; G = G_; c = c_; }
    __device__ __forceinline__ bool next(int i, Unit& u) const { const long L = (long)i * G + c; if (L >= nwg) return false; static_unit((int)L, nM, nN, u); return true; }
    __device__ __forceinline__ int arow(const Unit&, int) const { return 0; }
};
struct InProjOrder {
    int G, c;
    __device__ __forceinline__ bool next(int i, Unit& u) const {
        long L = (long)i * G + c;
        if (L < 128 * 26) { static_unit((int)L, 128, 26, u); return true; }
        L -= 128 * 26; if (L >= 16 * 13) return false;
        u.pm = 128 + (int)(L % 16); u.pn = 12 + (int)(L / 16); u.e = 0; return true;
    }
    __device__ __forceinline__ int arow(const Unit&, int) const { return 0; }
};
struct MoeOrder {
    int G, c, nN, ntiles; const int* tile_e; const int* rowtok; const int* pad_start; const int* total;
    __device__ __forceinline__ bool next(int i, Unit& u) const {
        const long L0 = (long)i * G;
        const long L = L0 + (long)(c % 8) * (G / 8) + (c / 8);
        if (L >= (long)ntiles * nN) return false;
        u.pm = (int)(L / nN); u.pn = (int)(L % nN); u.e = tile_e[u.pm]; return true;
    }
    __device__ __forceinline__ int arow(const Unit& u, int r) const { const int row = u.pm * 256 + r; const bool valid = (row - pad_start[u.e]) < total[u.e]; return valid ? rowtok[row] : 0; }
};

struct EpiInProj {
    static constexpr bool PERM = true;
    bf16* Z; bf16* AP;
    __device__ __forceinline__ void operator()(const f32x4 (&acc)[2][2][4][2], const Unit& u, int wr, int wc, int fr, int fq) const {
        const int row0 = u.pm * BM + wr * 64 + fr;
        const bool lora = u.pn >= 24;
        bf16* base = lora ? AP : Z; const int ldc = lora ? KLORA : PW;
        const int col0 = (lora ? (u.pn - 24) * BM : u.pn * BM) + wc * 32 + 8 * fq;
#pragma unroll
        for (int ai = 0; ai < 2; ++ai)
#pragma unroll
            for (int m = 0; m < 4; ++m) { bf16* rowp = base + (size_t)(row0 + ai * HALF + m * 16) * ldc + col0;
#pragma unroll
                for (int bj = 0; bj < 2; ++bj) { f32x4 v0 = acc[ai][bj][m][0], v1 = acc[ai][bj][m][1];
                    if (lora) { const int act = (u.pn == 24) ? (bj == 0 ? 1 : 0) : (bj == 0 ? 2 : 0);
                        if (act == 1) {
#pragma unroll
                            for (int j = 0; j < 4; ++j) { v0[j] = ftanh(v0[j]); v1[j] = ftanh(v1[j]); } }
                        if (act == 2) {
#pragma unroll
                            for (int j = 0; j < 4; ++j) { v0[j] = fsigmoid(v0[j]); v1[j] = fsigmoid(v1[j]); } } }
                    v4u w; w.x = cvt_pk_bf16(v0[0], v0[1]); w.y = cvt_pk_bf16(v0[2], v0[3]); w.z = cvt_pk_bf16(v1[0], v1[1]); w.w = cvt_pk_bf16(v1[2], v1[3]);
                    *(v4u*)(rowp + bj * HALF) = w; } }
    }
};
struct EpiLora {
    static constexpr bool PERM = true;
    bf16* EA; const float* w0; const float* a0;
    __device__ __forceinline__ void operator()(const f32x4 (&acc)[2][2][4][2], const Unit& u, int wr, int wc, int fr, int fq) const {
        const int row0 = u.pm * BM + wr * 64 + fr, col0 = u.pn * BM + wc * 32 + 8 * fq;
        const int blk = u.pn >> 2;
        const float* bias = blk < 2 ? w0 + col0 : (blk < 4 ? a0 + (col0 - 2048) : nullptr);
        const float scale = blk < 2 ? 0.60653065971263342f : 1.0f;
        f32x4 bv[2][2];
#pragma unroll
        for (int bj = 0; bj < 2; ++bj)
#pragma unroll
            for (int n = 0; n < 2; ++n) bv[bj][n] = bias ? *(const f32x4*)(bias + bj * HALF + 4 * n) : (f32x4){0.f, 0.f, 0.f, 0.f};
#pragma unroll
        for (int ai = 0; ai < 2; ++ai)
#pragma unroll
            for (int m = 0; m < 4; ++m) { bf16* rowp = EA + (size_t)(row0 + ai * HALF + m * 16) * NLORA + col0;
#pragma unroll
                for (int bj = 0; bj < 2; ++bj) { f32x4 v0 = acc[ai][bj][m][0] + bv[bj][0], v1 = acc[ai][bj][m][1] + bv[bj][1];
                    if (blk < 4) {
#pragma unroll
                        for (int j = 0; j < 4; ++j) { v0[j] = scale * fsigmoid(v0[j]); v1[j] = scale * fsigmoid(v1[j]); } }
                    v4u w; w.x = cvt_pk_bf16(v0[0], v0[1]); w.y = cvt_pk_bf16(v0[2], v0[3]); w.z = cvt_pk_bf16(v1[0], v1[1]); w.w = cvt_pk_bf16(v1[2], v1[3]);
                    *(v4u*)(rowp + bj * HALF) = w; } }
    }
};
struct EpiOutProj {
    static constexpr bool PERM = false;
    const float* X; float* X1; const float* macc; const float* adab;
    __device__ __forceinline__ void operator()(const f32x4 (&acc)[2][2][4][2], const Unit& u, int wr, int wc, int fr, int fq) const {
        const int row0 = u.pm * BM + wr * 64 + fr, col0 = u.pn * BM + wc * 32 + 4 * fq;
        const int b = (u.pm * BM) / SEQ;
        f32x4 gv[2][2];
#pragma unroll
        for (int bj = 0; bj < 2; ++bj)
#pragma unroll
            for (int n = 0; n < 2; ++n) { const int c = col0 + bj * HALF + n * 16; gv[bj][n] = *(const f32x4*)(macc + (size_t)b * 12288 + 2 * 2048 + c) + *(const f32x4*)(adab + 2 * 2048 + c); }
#pragma unroll
        for (int ai = 0; ai < 2; ++ai)
#pragma unroll
            for (int m = 0; m < 4; ++m) { const size_t off = (size_t)(row0 + ai * HALF + m * 16) * D + col0;
#pragma unroll
                for (int bj = 0; bj < 2; ++bj)
#pragma unroll
                    for (int n = 0; n < 2; ++n) { const f32x4 xv = *(const f32x4*)(X + off + bj * HALF + n * 16); *(f32x4*)(X1 + off + bj * HALF + n * 16) = xv + gv[bj][n] * acc[ai][bj][m][n]; } }
    }
};
struct EpiSwiglu {
    static constexpr bool PERM = true;
    bf16* ACT; const float* bg; const float* bu;
    __device__ __forceinline__ void operator()(const f32x4 (&acc)[2][2][4][2], const Unit& u, int wr, int wc, int fr, int fq) const {
        const int row0 = u.pm * BM + wr * 64 + fr, col0 = u.pn * HALF + wc * 32 + 8 * fq;
        const float* pg = bg + (size_t)u.e * 2048 + col0; const float* pu = bu + (size_t)u.e * 2048 + col0;
        f32x4 bgv[2], buv[2];
#pragma unroll
        for (int n = 0; n < 2; ++n) { bgv[n] = *(const f32x4*)(pg + 4 * n); buv[n] = *(const f32x4*)(pu + 4 * n); }
#pragma unroll
        for (int ai = 0; ai < 2; ++ai)
#pragma unroll
            for (int m = 0; m < 4; ++m) { bf16* rowp = ACT + (size_t)(row0 + ai * HALF + m * 16) * 2048 + col0; float o[8];
#pragma unroll
                for (int n = 0; n < 2; ++n) { const f32x4 gq = acc[ai][0][m][n] + bgv[n], uq = acc[ai][1][m][n] + buv[n];
#pragma unroll
                    for (int j = 0; j < 4; ++j) { const float gg = fminf(gq[j], 7.0f), uu = fminf(fmaxf(uq[j], -7.0f), 7.0f); o[4 * n + j] = (uu + 1.0f) * (gg * fsigmoid(1.702f * gg)); } }
                v4u w; w.x = cvt_pk_bf16(o[0], o[1]); w.y = cvt_pk_bf16(o[2], o[3]); w.z = cvt_pk_bf16(o[4], o[5]); w.w = cvt_pk_bf16(o[6], o[7]);
                *(v4u*)rowp = w; }
    }
};
struct EpiDown {
    static constexpr bool PERM = true;
    bf16* SLOT; const float* bd; const int* rowdst; const float* rowgate; const int* pad_start; const int* total;
    __device__ __forceinline__ void operator()(const f32x4 (&acc)[2][2][4][2], const Unit& u, int wr, int wc, int fr, int fq) const {
        const int row0 = u.pm * BM + wr * 64 + fr, col0 = u.pn * BM + wc * 32 + 8 * fq;
        const float* pb = bd + (size_t)u.e * 2048 + col0;
        const int lim = pad_start[u.e] + total[u.e];
        f32x4 bv[2][2];
#pragma unroll
        for (int bj = 0; bj < 2; ++bj)
#pragma unroll
            for (int n = 0; n < 2; ++n) bv[bj][n] = *(const f32x4*)(pb + bj * HALF + 4 * n);
#pragma unroll
        for (int ai = 0; ai < 2; ++ai)
#pragma unroll
            for (int m = 0; m < 4; ++m) { const int row = row0 + ai * HALF + m * 16;
                if (row < lim) { const int dst = rowdst[row]; const float gt = rowgate[row]; bf16* rowp = SLOT + (size_t)dst * 2048 + col0;
#pragma unroll
                    for (int bj = 0; bj < 2; ++bj) { const f32x4 v0 = (acc[ai][bj][m][0] + bv[bj][0]) * gt, v1 = (acc[ai][bj][m][1] + bv[bj][1]) * gt;
                        v4u w; w.x = cvt_pk_bf16(v0[0], v0[1]); w.y = cvt_pk_bf16(v0[2], v0[3]); w.z = cvt_pk_bf16(v1[0], v1[1]); w.w = cvt_pk_bf16(v1[2], v1[3]);
                        *(v4u*)(rowp + bj * HALF) = w; } } }
    }
};
}

__device__ __forceinline__ f32x4 unpk4(v2u w) { return (f32x4){bflo(w.x), bfhi(w.x), bflo(w.y), bfhi(w.y)}; }
__device__ __forceinline__ v2u pk4(f32x4 v) { v2u o; o.x = pk2(v.x, v.y); o.y = pk2(v.z, v.w); return o; }
__device__ __forceinline__ f32x4 ldz4(const bf16* p, bool ok) { return ok ? unpk4(*(const GAS v2u*)p) : (f32x4){0.f, 0.f, 0.f, 0.f}; }

__device__ __forceinline__ void p4_prep(Frame& F) {
    const int gw = F.bid * 8 + F.wave, NGW = F.G * 8, lane = F.lane;
    const bf16* Z = wsp<bf16>(F, WS_Z); const bf16* EA = wsp<bf16>(F, WS_EA); bf16* SI = wsp<bf16>(F, WS_SI);
    bf16* UT = wsp<bf16>(F, WS_UT); bf16* X0T = wsp<bf16>(F, WS_X0T); float* BS = wsp<float>(F, WS_BS);
    const float* cw = F.in[I_CONVW]; const float* cb = F.in[I_CONVB];
    constexpr int NU_LAT = 16 * 64 * 8, NU = NU_LAT + 16 * 8 * 4;
    for (int u = gw; u < NU; u += NGW) {
        int b, chunk, slice; bool lat;
        if (u < NU_LAT) { lat = true; b = u / 512; const int rem = u % 512; chunk = rem / 8; slice = rem % 8; }
        else { lat = false; const int v = u - NU_LAT; b = v / 32; chunk = (v % 32) / 4; slice = 4 + (v % 4); }
        const int Ls = lat ? SEQ : CTXL, rowbase = lat ? b * SEQ : NLAT + b * CTXL, t0 = chunk * 32;
        if (slice < 4) {
            const int c0 = 256 * slice + 4 * lane;
            f32x4 w[3][3], bi[3];
#pragma unroll
            for (int a = 0; a < 3; ++a) { bi[a] = *(const GAS f32x4*)(cb + a * 1024 + c0);
#pragma unroll
                for (int tp = 0; tp < 3; ++tp) w[a][tp] = *(const GAS f32x4*)(cw + (size_t)tp * PW + a * 1024 + c0); }
            f32x4 pv[3], cu[3], nx[3];
#pragma unroll
            for (int a = 0; a < 3; ++a) { pv[a] = ldz4(Z + (size_t)(rowbase + t0 - 1) * PW + a * 1024 + c0, t0 > 0); cu[a] = ldz4(Z + (size_t)(rowbase + t0) * PW + a * 1024 + c0, true); }
            for (int g8 = 0; g8 < 4; ++g8) {
                float x0v[4][8], uv[4][8];
#pragma unroll
                for (int i = 0; i < 8; ++i) { const int t = t0 + 8 * g8 + i;
                    f32x4 zc[3];
#pragma unroll
                    for (int a = 0; a < 3; ++a) { nx[a] = ldz4(Z + (size_t)(rowbase + t + 1) * PW + a * 1024 + c0, t + 1 < Ls);
                        zc[a] = pv[a] * w[a][0] + cu[a] * w[a][1] + nx[a] * w[a][2] + bi[a]; pv[a] = cu[a]; cu[a] = nx[a]; }
                    const f32x4 uu = zc[2] * zc[1];
#pragma unroll
                    for (int j = 0; j < 4; ++j) { x0v[j][i] = zc[0][j]; uv[j][i] = uu[j]; } }
#pragma unroll
                for (int j = 0; j < 4; ++j) { const size_t o = ((size_t)(c0 + j) * 16 + b) * SEQ + t0 + 8 * g8;
                    v4u a, c; a.x = pk2(x0v[j][0], x0v[j][1]); a.y = pk2(x0v[j][2], x0v[j][3]); a.z = pk2(x0v[j][4], x0v[j][5]); a.w = pk2(x0v[j][6], x0v[j][7]);
                    c.x = pk2(uv[j][0], uv[j][1]); c.y = pk2(uv[j][2], uv[j][3]); c.z = pk2(uv[j][4], uv[j][5]); c.w = pk2(uv[j][6], uv[j][7]);
                    *(GAS v4u*)(X0T + o) = a; *(GAS v4u*)(UT + o) = c; }
            }
        } else {
            const int q = slice - 4, c0 = 256 * q + 4 * lane;
            f32x4 w[3][3], bi[3];
#pragma unroll
            for (int a = 0; a < 3; ++a) { bi[a] = *(const GAS f32x4*)(cb + 3072 + a * 1024 + c0);
#pragma unroll
                for (int tp = 0; tp < 3; ++tp) w[a][tp] = *(const GAS f32x4*)(cw + (size_t)tp * PW + 3072 + a * 1024 + c0); }
            const f32x4 kkw = *(const GAS f32x4*)(F.in[I_RKK] + c0), kaw = *(const GAS f32x4*)(F.in[I_RKA] + c0), rkw = *(const GAS f32x4*)(F.in[I_RRK] + c0);
            f32x4 pv[3], cu[3], nx[3];
#pragma unroll
            for (int a = 0; a < 3; ++a) { pv[a] = ldz4(Z + (size_t)(rowbase + t0 - 1) * PW + 3072 + a * 1024 + c0, t0 > 0); cu[a] = ldz4(Z + (size_t)(rowbase + t0) * PW + 3072 + a * 1024 + c0, true); }
            for (int i = 0; i < 32; ++i) { const int t = t0 + i, row = rowbase + t;
                f32x4 zc[3];
#pragma unroll
                for (int a = 0; a < 3; ++a) { nx[a] = ldz4(Z + (size_t)(row + 1) * PW + 3072 + a * 1024 + c0, t + 1 < Ls);
                    zc[a] = pv[a] * w[a][0] + cu[a] * w[a][1] + nx[a] * w[a][2] + bi[a]; pv[a] = cu[a]; cu[a] = nx[a]; }
                const f32x4 a0 = unpk4(*(const GAS v2u*)(EA + (size_t)row * NLORA + 2048 + c0)), a1 = unpk4(*(const GAS v2u*)(EA + (size_t)row * NLORA + 3072 + c0));
                const f32x4 zr = zc[0], zk = zc[1], zv = zc[2];
                const f32x4 kk = zk * kkw;
                const float n2 = row16_sum((kk.x * kk.x + kk.y * kk.y) + (kk.z * kk.z + kk.w * kk.w));
                const float inv = 1.0f / fmaxf(sqrtf(n2), 1e-12f);
                const f32x4 kkn = kk * inv;
                const f32x4 kd0 = zk * (1.0f + (a0 - 1.0f) * kaw), kd1 = zk * (1.0f + (a1 - 1.0f) * kaw);
                const f32x4 b0 = kkn * a0, b1 = kkn * a1;
                const f32x4 bt = zr * (kd0 + kd1) * rkw;
                const float bsum = row16_sum((bt.x + bt.y) + (bt.z + bt.w));
                bf16* so = SI + (size_t)row * SIW + c0;
                *(GAS v2u*)(so) = pk4(zr); *(GAS v2u*)(so + 1024) = pk4(zv); *(GAS v2u*)(so + 2048) = pk4(kkn);
                *(GAS v2u*)(so + 3072) = pk4(b0); *(GAS v2u*)(so + 4096) = pk4(kd0); *(GAS v2u*)(so + 5120) = pk4(b1); *(GAS v2u*)(so + 6144) = pk4(kd1);
                if (lat && (lane & 15) == 0) BS[(size_t)row * 16 + 4 * q + (lane >> 4)] = bsum;
            }
        }
    }
}

typedef short bf16x4 __attribute__((ext_vector_type(4)));
__device__ __forceinline__ int scan_row(int s, int dir, int b) {
    return s < CTXL ? NLAT + b * CTXL + (dir ? CTXL - 1 - s : s) : b * SEQ + (dir ? SEQ - 1 - (s - CTXL) : (s - CTXL));
}
__device__ __forceinline__ bf16x4 pack4(f32x4 v) { v2u o; o.x = pk2(v.x, v.y); o.y = pk2(v.z, v.w); return __builtin_bit_cast(bf16x4, o); }
__device__ __forceinline__ bf16x8 cat8(bf16x4 a, bf16x4 b) { return __builtin_shufflevector(a, b, 0, 1, 2, 3, 4, 5, 6, 7); }
#define MF16(a, b, c) __builtin_amdgcn_mfma_f32_16x16x16bf16_1k((a), (b), (c), 0, 0, 0)
#define MF32(a, b, c) __builtin_amdgcn_mfma_f32_16x16x32_bf16((a), (b), (c), 0, 0, 0)
template <int CTRL> __device__ __forceinline__ float dpp_shr0(float x) { return __builtin_bit_cast(float, __builtin_amdgcn_update_dpp(0, __builtin_bit_cast(int, x), CTRL, 0xF, 0xF, true)); }
__device__ __forceinline__ float row16_incl_scan(float x) { x += dpp_shr0<0x111>(x); x += dpp_shr0<0x112>(x); x += dpp_shr0<0x114>(x); x += dpp_shr0<0x118>(x); return x; }
constexpr int SC_AT = 0, SC_RT = 2304, SC_BT = 4608, SC_KT = 6912, SC_BHT = 9216, SC_KHT = 11264, SC_VT = 13312, SC_GC = 15360, SC_BUF = 15616, SC_CHAIN = 2 * SC_BUF;
__device__ __forceinline__ void p5_scan(Frame& F) {
    const int cwv = F.wave >> 2, w4 = F.wave & 3, lane = F.lane, tc = F.tid & 255, q = lane >> 4, lr = lane & 15;
    const bf16* SI = wsp<bf16>(F, WS_SI); const bf16* EA = wsp<bf16>(F, WS_EA); float* YS = wsp<float>(F, WS_YS);
    for (int cp = F.bid; cp < 256; cp += F.G) {
        const int chain = cp * 2 + cwv, dir = chain >> 8, b = (chain >> 4) & 15, h = chain & 15;
        LAS unsigned char* cb = F.lds + cwv * SC_CHAIN;
        const int sl = lr, jc = 4 * w4 + q, coff = h * 64 + 4 * jc;
        const int ppos = 32 * (jc >> 3) + 8 * (jc & 3) + 4 * ((jc >> 2) & 1);
        v2u ld[6];
#define SCAN_ISSUE(ck_) do { const int row_ = scan_row((ck_) * 16 + sl, dir, b); const bf16* sr_ = SI + (size_t)row_ * SIW + coff; \
            ld[0] = *(const GAS v2u*)(sr_ + 2048); ld[1] = *(const GAS v2u*)(EA + (size_t)row_ * NLORA + dir * 1024 + coff); ld[2] = *(const GAS v2u*)(sr_ + 3072 + dir * 2048); \
            ld[3] = *(const GAS v2u*)(sr_ + 4096 + dir * 2048); ld[4] = *(const GAS v2u*)(sr_); ld[5] = *(const GAS v2u*)(sr_ + 1024); } while (0)
#define SCAN_COMMIT(p_) do { LAS unsigned char* d_ = cb + (p_) * SC_BUF; \
            const f32x4 kk_ = unpk4(ld[0]), e_ = unpk4(ld[1]), b_ = unpk4(ld[2]), kd_ = unpk4(ld[3]), r_ = unpk4(ld[4]), v_ = unpk4(ld[5]); \
            f32x4 Ei_, Et_; \
            _Pragma("unroll") for (int i_ = 0; i_ < 4; ++i_) { Ei_[i_] = row16_incl_scan(e_[i_]); Et_[i_] = row16_sum(e_[i_]); } \
            f32x4 gin_, gex_, ginv_, grem_; \
            _Pragma("unroll") for (int i_ = 0; i_ < 4; ++i_) { gin_[i_] = __expf(-Ei_[i_]); gex_[i_] = __expf(e_[i_] - Ei_[i_]); ginv_[i_] = __expf(Ei_[i_]); grem_[i_] = __expf(Ei_[i_] - Et_[i_]); } \
            *(LAS v2u*)(d_ + SC_AT + sl * 144 + 2 * ppos) = pk4(-kk_ * gex_); \
            *(LAS v2u*)(d_ + SC_RT + sl * 144 + 2 * ppos) = pk4(r_ * gin_); \
            *(LAS v2u*)(d_ + SC_BT + sl * 144 + 2 * ppos) = pk4(b_ * ginv_); \
            *(LAS v2u*)(d_ + SC_KT + sl * 144 + 2 * ppos) = pk4(kd_ * ginv_); \
            const f32x4 bh_ = b_ * grem_, kh_ = kd_ * grem_; \
            _Pragma("unroll") for (int i_ = 0; i_ < 4; ++i_) { \
                *(LAS bf16*)(d_ + SC_BHT + (4 * jc + i_) * 32 + 2 * sl) = (bf16)f2bf(bh_[i_]); \
                *(LAS bf16*)(d_ + SC_KHT + (4 * jc + i_) * 32 + 2 * sl) = (bf16)f2bf(kh_[i_]); \
                *(LAS bf16*)(d_ + SC_VT + (4 * jc + i_) * 32 + 2 * sl) = (bf16)f2bf(v_[i_]); } \
            if (sl == 0) *(LAS f32x4*)(d_ + SC_GC + 16 * jc) = (f32x4){__expf(-Et_.x), __expf(-Et_.y), __expf(-Et_.z), __expf(-Et_.w)}; } while (0)
        f32x4 ST[4];
#pragma unroll
        for (int i = 0; i < 4; ++i) ST[i] = (f32x4){0.f, 0.f, 0.f, 0.f};
        SCAN_ISSUE(0); SCAN_COMMIT(0); __syncthreads();
        constexpr int NCK = (CTXL + SEQ) / 16;
        const f32x4 zero4 = (f32x4){0.f, 0.f, 0.f, 0.f};
        for (int ck = 0; ck < NCK; ++ck) {
            const int p = ck & 1;
            if (ck + 1 < NCK) SCAN_ISSUE(ck + 1);
            const LAS unsigned char* d = cb + p * SC_BUF;
            bf16x8 Af[2], Rf[2], Bf[2], Kf[2];
#pragma unroll
            for (int m = 0; m < 2; ++m) { const int o = lr * 144 + m * 64 + q * 16;
                Af[m] = *(const LAS bf16x8*)(d + SC_AT + o); Rf[m] = *(const LAS bf16x8*)(d + SC_RT + o); Bf[m] = *(const LAS bf16x8*)(d + SC_BT + o); Kf[m] = *(const LAS bf16x8*)(d + SC_KT + o); }
            const bf16x4 Vf = *(const LAS bf16x4*)(d + SC_VT + (16 * w4 + lr) * 32 + 8 * q);
            f32x4 GabT = MF32(Bf[0], Af[0], zero4); GabT = MF32(Bf[1], Af[1], GabT);
            f32x4 Gab = MF32(Af[0], Bf[0], zero4); Gab = MF32(Af[1], Bf[1], Gab);
            f32x4 GakT = MF32(Kf[0], Af[0], zero4); GakT = MF32(Kf[1], Af[1], GakT);
            f32x4 GrbT = MF32(Bf[0], Rf[0], zero4); GrbT = MF32(Bf[1], Rf[1], GrbT);
            f32x4 GrkT = MF32(Kf[0], Rf[0], zero4); GrkT = MF32(Kf[1], Rf[1], GrkT);
#pragma unroll
            for (int j = 0; j < 4; ++j) { const int i = 4 * q + j;
                GabT[j] = (i < lr) ? GabT[j] : 0.f; GakT[j] = (i < lr) ? GakT[j] : 0.f; GrbT[j] = (i <= lr) ? GrbT[j] : 0.f; GrkT[j] = (i <= lr) ? GrkT[j] : 0.f;
                Gab[j] = (lr < i) ? Gab[j] : 0.f; }
            const bf16x4 LakA = pack4(GakT), LrbA = pack4(GrbT), LrkA = pack4(GrkT);
            f32x4 X = GabT, Y = Gab, Tt = GabT;
#pragma unroll
            for (int j = 0; j < 4; ++j) Tt[j] += (4 * q + j == lr) ? 1.0f : 0.f;
#pragma unroll
            for (int lv = 0; lv < 3; ++lv) { const bf16x4 x = pack4(X), y = pack4(Y);
                const f32x4 Y2 = MF16(x, y, zero4), X2 = MF16(y, x, zero4);
                Tt = MF16(pack4(Y2), pack4(Tt), Tt);
                X = X2; Y = Y2; }
            const bf16x4 TinvA = pack4(Tt);
            bf16x4 Sb[4];
#pragma unroll
            for (int kb = 0; kb < 4; ++kb) Sb[kb] = pack4(ST[kb]);
            const bf16x8 SB0 = cat8(Sb[0], Sb[1]), SB1 = cat8(Sb[2], Sb[3]);
            f32x4 W = MF16(LakA, Vf, zero4); W = MF32(Af[0], SB0, W); W = MF32(Af[1], SB1, W);
            const f32x4 U = MF16(TinvA, pack4(W), zero4);
            const bf16x4 Ub = pack4(U);
            f32x4 Yt = MF16(LrkA, Vf, zero4); Yt = MF32(Rf[0], SB0, Yt); Yt = MF32(Rf[1], SB1, Yt); Yt = MF16(LrbA, Ub, Yt);
#pragma unroll
            for (int kb = 0; kb < 4; ++kb) { const f32x4 g = *(const LAS f32x4*)(d + SC_GC + (16 * kb + 4 * q) * 4);
                const bf16x4 bh = *(const LAS bf16x4*)(d + SC_BHT + (16 * kb + lr) * 32 + 8 * q), kh = *(const LAS bf16x4*)(d + SC_KHT + (16 * kb + lr) * 32 + 8 * q);
                f32x4 s = ST[kb] * g; s = MF16(bh, Ub, s); s = MF16(kh, Vf, s); ST[kb] = s; }
            if (ck >= CTXL / 16) {
#pragma unroll
                for (int j = 0; j < 4; ++j) { const int row = scan_row(ck * 16 + 4 * q + j, dir, b); YS[((size_t)dir * NLAT + row) * 1024 + h * 64 + 16 * w4 + lr] = Yt[j]; } }
            if (ck + 1 < NCK) SCAN_COMMIT(p ^ 1);
            __syncthreads();
        }
    }
}

constexpr int HY_UROW = 4128, HY_GOFF = 16 * HY_UROW, HY_CS = 8208;
__device__ __forceinline__ void p6_hyena(Frame& F) {
    const int lane = F.lane, tl = lane & 15, q = lane >> 4, wave = F.wave, tid = F.tid;
    const bf16* UT = wsp<bf16>(F, WS_UT); const bf16* Gt = wsp<bf16>(F, WS_G); bf16* YCT = wsp<bf16>(F, WS_YCT);
    LAS unsigned char* lds = F.lds;
    const int r = (8 - (tl & 7)) & 7;
    const int abase = HY_GOFF + r * HY_CS + 2 * (2048 + 8 * q - (tl + r)) - 32 * (16 * wave);
    const int bbase = tl * HY_UROW + 16 * q;
    for (int c = F.bid; c < 1024; c += F.G) {
#pragma unroll
        for (int i = 0; i < 8; ++i) { const int id = tid + 512 * i, bb = id >> 8, ch = id & 255;
            const v4u v = *(const GAS v4u*)(UT + ((size_t)c * 16 + bb) * SEQ + 8 * ch); *(LAS v4u*)(lds + bb * HY_UROW + 16 * ch) = v; }
        { const v4u v = *(const GAS v4u*)(Gt + (size_t)c * 4096 + 8 * tid); *(LAS v4u*)(lds + HY_GOFF + 16 * tid) = v; }
        __syncthreads();
        { unsigned d[8]; const v4u lo = *(const LAS v4u*)(lds + HY_GOFF + 16 * tid); const v4u hi = tid < 511 ? *(const LAS v4u*)(lds + HY_GOFF + 16 * tid + 16) : (v4u){0u, 0u, 0u, 0u};
            d[0] = lo.x; d[1] = lo.y; d[2] = lo.z; d[3] = lo.w; d[4] = hi.x; d[5] = hi.y; d[6] = hi.z; d[7] = hi.w;
#pragma unroll
            for (int rr = 1; rr < 8; ++rr) { v4u o;
                if ((rr & 1) == 0) { o.x = d[rr / 2]; o.y = d[rr / 2 + 1]; o.z = d[rr / 2 + 2]; o.w = d[rr / 2 + 3]; }
                else { const int e = (rr - 1) / 2; o.x = __builtin_amdgcn_alignbit(d[e + 1], d[e], 16); o.y = __builtin_amdgcn_alignbit(d[e + 2], d[e + 1], 16);
                       o.z = __builtin_amdgcn_alignbit(d[e + 3], d[e + 2], 16); o.w = __builtin_amdgcn_alignbit(d[e + 4], d[e + 3], 16); }
                *(LAS v4u*)(lds + HY_GOFF + rr * HY_CS + 16 * tid) = o; } }
        __syncthreads();
        f32x4 acc[16]; bf16x8 P[16];
#pragma unroll
        for (int it = 0; it < 16; ++it) acc[it] = (f32x4){0.f, 0.f, 0.f, 0.f};
#pragma unroll
        for (int it = 2; it < 16; ++it) P[it] = *(const LAS bf16x8*)(lds + abase - 32 * it);
        for (int i8 = 0; i8 < 8; ++i8) {
#pragma unroll
            for (int u = 0; u < 8; ++u) {
                const int isb = i8 * 8 + u;
                const bf16x8 bf = *(const LAS bf16x8*)(lds + bbase + 64 * isb);
                P[(16 - 2 * u) & 15] = *(const LAS bf16x8*)(lds + abase + 64 * isb);
                P[(17 - 2 * u) & 15] = *(const LAS bf16x8*)(lds + abase + 64 * isb - 32);
#pragma unroll
                for (int k = 0; k < 16; ++k) { const int it = (k + 2) & 15;
                    acc[it] = __builtin_amdgcn_mfma_f32_16x16x32_bf16(P[(it - 2 * u) & 15], bf, acc[it], 0, 0, 0); }
            }
        }
#pragma unroll
        for (int it = 0; it < 16; ++it) { v2u o; o.x = pk2(acc[it].x, acc[it].y); o.y = pk2(acc[it].z, acc[it].w);
            *(GAS v2u*)(YCT + ((size_t)c * 16 + tl) * SEQ + 256 * wave + 16 * it + 4 * q) = o; }
        __syncthreads();
    }
}

__device__ __forceinline__ void p7_assemble(Frame& F) {
    const int gw = F.bid * 8 + F.wave, NGW = F.G * 8, lane = F.lane;
    bf16* A2 = wsp<bf16>(F, WS_A2);
    const bf16* YCT = wsp<bf16>(F, WS_YCT); const bf16* X0T = wsp<bf16>(F, WS_X0T); const bf16* UT = wsp<bf16>(F, WS_UT);
    const float* YS = wsp<float>(F, WS_YS); const float* BS = wsp<float>(F, WS_BS); const bf16* SI = wsp<bf16>(F, WS_SI); const bf16* EA = wsp<bf16>(F, WS_EA);
    LAS unsigned char* tile = F.lds + F.wave * 9216;
    constexpr int NU_H = 16 * 32 * 16, NU = NU_H + (NLAT / 16) * 4;
    for (int u = gw; u < NU; u += NGW) {
        if (u < NU_H) {
            const int b = u / 512, rem = u % 512, tb = rem / 16, g = rem % 16, ci = lane >> 3, tq = lane & 7;
            float val[8][8]; float ss[8];
#pragma unroll
            for (int k = 0; k < 8; ++k) ss[k] = 0.f;
#pragma unroll
            for (int i = 0; i < 8; ++i) { const int ch = g * 64 + 8 * ci + i; const size_t o = ((size_t)ch * 16 + b) * SEQ + 64 * tb + 8 * tq;
                const v4u yc = *(const GAS v4u*)(YCT + o), x0 = *(const GAS v4u*)(X0T + o), uu = *(const GAS v4u*)(UT + o); const float bias = F.in[I_HBIAS][ch];
                const unsigned ycw[4] = {yc.x, yc.y, yc.z, yc.w}, x0w[4] = {x0.x, x0.y, x0.z, x0.w}, uw[4] = {uu.x, uu.y, uu.z, uu.w};
#pragma unroll
                for (int k = 0; k < 4; ++k) { const float v0 = bflo(x0w[k]) * (bflo(ycw[k]) + bias * bflo(uw[k])), v1 = bfhi(x0w[k]) * (bfhi(ycw[k]) + bias * bfhi(uw[k]));
                    val[i][2 * k] = v0; val[i][2 * k + 1] = v1; ss[2 * k] += v0 * v0; ss[2 * k + 1] += v1 * v1; } }
#pragma unroll
            for (int k = 0; k < 8; ++k) { float s = ss[k]; s += __shfl_xor(s, 8); s += __shfl_xor(s, 16); s += __shfl_xor(s, 32); ss[k] = 1.0f / sqrtf(s * (1.0f / 64.0f) + 1e-6f); }
            float ng[8];
#pragma unroll
            for (int i = 0; i < 8; ++i) ng[i] = F.in[I_HNG][g * 64 + 8 * ci + i];
#pragma unroll
            for (int k = 0; k < 8; ++k) { v4u o; o.x = pk2(val[0][k] * ss[k] * ng[0], val[1][k] * ss[k] * ng[1]); o.y = pk2(val[2][k] * ss[k] * ng[2], val[3][k] * ss[k] * ng[3]);
                o.z = pk2(val[4][k] * ss[k] * ng[4], val[5][k] * ss[k] * ng[5]); o.w = pk2(val[6][k] * ss[k] * ng[6], val[7][k] * ss[k] * ng[7]);
                *(LAS v4u*)(tile + (8 * tq + k) * 144 + 16 * ci) = o; }
            LDS_WAIT(); asm volatile("" ::: "memory");
#pragma unroll
            for (int i = 0; i < 8; ++i) { const int t = (lane >> 3) + 8 * i, pc = lane & 7; const v4u o = *(const LAS v4u*)(tile + t * 144 + 16 * pc);
                *(GAS v4u*)(A2 + (size_t)(b * SEQ + 64 * tb + t) * D + g * 64 + 8 * pc) = o; }
            LDS_WAIT(); asm volatile("" ::: "memory");
        } else {
            const int v = u - NU_H, tk = v / 4, q = v % 4, c0 = 256 * q + 4 * lane;
            const f32x4 lg = *(const GAS f32x4*)(F.in[I_LNG] + c0), lb = *(const GAS f32x4*)(F.in[I_LNB] + c0);
            for (int i = 0; i < 16; ++i) { const int row = tk * 16 + i;
                const f32x4 y = *(const GAS f32x4*)(YS + (size_t)row * 1024 + c0) + *(const GAS f32x4*)(YS + ((size_t)NLAT + row) * 1024 + c0);
                const float mu = row16_sum((y.x + y.y) + (y.z + y.w)) * (1.0f / 64.0f);
                const f32x4 d = y - mu;
                const float var = row16_sum((d.x * d.x + d.y * d.y) + (d.z * d.z + d.w * d.w)) * (1.0f / 64.0f);
                const float rs = 1.0f / sqrtf(var + 64e-5f);
                const f32x4 vv = unpk4(*(const GAS v2u*)(SI + (size_t)row * SIW + 1024 + c0)), gt = unpk4(*(const GAS v2u*)(EA + (size_t)row * NLORA + 4096 + c0));
                const float bsc = BS[(size_t)row * 16 + 4 * q + (lane >> 4)];
                const f32x4 o = (d * rs * lg + lb + bsc * vv) * gt;
                *(GAS v2u*)(A2 + (size_t)row * D + 1024 + c0) = pk4(o); }
        }
    }
}

__device__ __forceinline__ void p9_router(Frame& F) {
    const int lane = F.lane, rw = lane & 15, q = lane >> 4, wave = F.wave;
    const float* X1 = F.out; const float* MT = wsp<float>(F, WS_MODT); bf16* H2 = wsp<bf16>(F, WS_H2); const bf16* Wr = wsp<bf16>(F, WS_WR);
    int* TOKE = wsp<int>(F, WS_TOKE); float* TOKG = wsp<float>(F, WS_TOKG); int* WCNT = wsp<int>(F, WS_WCNT); int* BCNT = wsp<int>(F, WS_BCNT);
    LAS float* lg = (LAS float*)(F.lds + wave * 2048);
    LAS int* wc = (LAS int*)(F.lds + 16384 + wave * 128);
    {
        const int gw = F.bid * 8 + wave, tok0 = gw * 16, token = tok0 + rw, b = token / SEQ;
        const float* xr = X1 + (size_t)token * D + 8 * q;
        float ss = 0.f;
        for (int ks = 0; ks < 64; ++ks) { const f32x4 a = *(const GAS f32x4*)(xr + 32 * ks), c = *(const GAS f32x4*)(xr + 32 * ks + 4);
            ss += (a.x * a.x + a.y * a.y) + (a.z * a.z + a.w * a.w) + (c.x * c.x + c.y * c.y) + (c.z * c.z + c.w * c.w); }
        ss += __shfl_xor(ss, 16); ss += __shfl_xor(ss, 32);
        const float rstd = 1.0f / sqrtf(ss * (1.0f / D) + 1e-6f);
        const float* t0 = MT + (size_t)b * 4096 + 8 * q; const float* t1 = t0 + 2048;
        f32x4 acc[2] = {(f32x4){0.f, 0.f, 0.f, 0.f}, (f32x4){0.f, 0.f, 0.f, 0.f}};
        for (int ks = 0; ks < 64; ++ks) {
            const f32x4 xa = *(const GAS f32x4*)(xr + 32 * ks), xb = *(const GAS f32x4*)(xr + 32 * ks + 4);
            const f32x4 ma = *(const GAS f32x4*)(t0 + 32 * ks), mb = *(const GAS f32x4*)(t0 + 32 * ks + 4), sa = *(const GAS f32x4*)(t1 + 32 * ks), sb = *(const GAS f32x4*)(t1 + 32 * ks + 4);
            const f32x4 ha = xa * rstd * ma + sa, hb = xb * rstd * mb + sb;
            const float hv[8] = {ha.x, ha.y, ha.z, ha.w, hb.x, hb.y, hb.z, hb.w};
            unsigned hi[8], lo[8];
#pragma unroll
            for (int j = 0; j < 8; ++j) { hi[j] = f2bf(hv[j]); lo[j] = f2bf(hv[j] - bf2f(hi[j])); }
            v4u ph, pl; ph.x = hi[0] | (hi[1] << 16); ph.y = hi[2] | (hi[3] << 16); ph.z = hi[4] | (hi[5] << 16); ph.w = hi[6] | (hi[7] << 16);
            pl.x = lo[0] | (lo[1] << 16); pl.y = lo[2] | (lo[3] << 16); pl.z = lo[4] | (lo[5] << 16); pl.w = lo[6] | (lo[7] << 16);
            *(GAS v4u*)(H2 + (size_t)token * D + 32 * ks + 8 * q) = ph;
            const bf16x8 Ah = __builtin_bit_cast(bf16x8, ph), Al = __builtin_bit_cast(bf16x8, pl);
#pragma unroll
            for (int nb = 0; nb < 2; ++nb) { const bf16* wp = Wr + (size_t)(16 * nb + rw) * D + 32 * ks + 8 * q;
                const bf16x8 Bh = *(const GAS bf16x8*)wp, Bl = *(const GAS bf16x8*)(wp + 32 * D);
                acc[nb] = __builtin_amdgcn_mfma_f32_16x16x32_bf16(Ah, Bh, acc[nb], 0, 0, 0);
                acc[nb] = __builtin_amdgcn_mfma_f32_16x16x32_bf16(Ah, Bl, acc[nb], 0, 0, 0);
                acc[nb] = __builtin_amdgcn_mfma_f32_16x16x32_bf16(Al, Bh, acc[nb], 0, 0, 0); }
        }
#pragma unroll
        for (int nb = 0; nb < 2; ++nb) { const float rb = F.in[I_ROUTB][16 * nb + rw];
#pragma unroll
            for (int j = 0; j < 4; ++j) lg[(4 * q + j) * 32 + 16 * nb + rw] = acc[nb][j] + rb; }
        if (lane < 32) wc[lane] = 0;
        LDS_WAIT(); asm volatile("" ::: "memory");
        if (lane < 16) {
            float lv[32];
#pragma unroll
            for (int e4 = 0; e4 < 8; ++e4) { const f32x4 t = *(const LAS f32x4*)(lg + lane * 32 + 4 * e4); lv[4 * e4] = t.x; lv[4 * e4 + 1] = t.y; lv[4 * e4 + 2] = t.z; lv[4 * e4 + 3] = t.w; }
            int sel[4]; float sv[4];
#pragma unroll
            for (int k = 0; k < 4; ++k) { float best = -3.0e38f; int bi = 0;
#pragma unroll
                for (int e = 0; e < 32; ++e) { bool taken = false;
#pragma unroll
                    for (int kk = 0; kk < k; ++kk) taken = taken || (sel[kk] == e);
                    if (!taken && lv[e] > best) { best = lv[e]; bi = e; } }
                sel[k] = bi; sv[k] = best; }
            const float e1 = __expf(sv[1] - sv[0]), e2 = __expf(sv[2] - sv[0]), e3 = __expf(sv[3] - sv[0]), inv = 1.0f / (1.0f + e1 + e2 + e3);
            const int tk = tok0 + lane;
            *(GAS v4u*)(TOKE + (size_t)tk * 4) = (v4u){(unsigned)sel[0], (unsigned)sel[1], (unsigned)sel[2], (unsigned)sel[3]};
            *(GAS f32x4*)(TOKG + (size_t)tk * 4) = (f32x4){inv, e1 * inv, e2 * inv, e3 * inv};
#pragma unroll
            for (int k = 0; k < 4; ++k) __hip_atomic_fetch_add(&wc[sel[k]], 1, __ATOMIC_RELAXED, __HIP_MEMORY_SCOPE_WORKGROUP);
        }
        LDS_WAIT(); asm volatile("" ::: "memory");
        if (lane < 32) WCNT[(size_t)gw * 32 + lane] = wc[lane];
        __syncthreads();
        if (wave == 0 && lane < 32) { int s = 0;
#pragma unroll
            for (int w = 0; w < 8; ++w) s += ((LAS int*)(F.lds + 16384 + w * 128))[lane];
            BCNT[F.bid * 32 + lane] = s; }
        __syncthreads();
    }
    {
        LAS float* scr = (LAS float*)(F.lds + 32768 + wave * 8448);
        const int gw = F.bid * 8 + wave, NGW = F.G * 8;
        bf16* BtGU = wsp<bf16>(F, WS_BTGU); bf16* BtD = wsp<bf16>(F, WS_BTD);
        for (int it = gw; it < NE * 6144; it += NGW) {
            const int e = it / 6144, r = it % 6144;
            if (r < 4096) { const int s = r / 2048, rr = r % 2048, kb = rr / 64, nb = rr % 64;
                tr_item((s ? F.in[I_EWU] : F.in[I_EWG]) + (size_t)e * D * D, D, 64 * kb, 32 * nb, BtGU + (size_t)e * 4096 * D, nullptr, D, 256 * (nb / 4) + 128 * s + 32 * (nb % 4), 64 * kb, scr, lane); }
            else { const int rr = r - 4096, kb = rr / 64, nb = rr % 64;
                tr_item(F.in[I_EWD] + (size_t)e * D * D, D, 64 * kb, 32 * nb, BtD + (size_t)e * D * D, nullptr, D, 32 * nb, 64 * kb, scr, lane); }
        }
    }
}

__device__ __forceinline__ void p10_sort(Frame& F) {
    const int lane = F.lane, wave = F.wave, gw = F.bid * 8 + wave;
    const int* TOKE = wsp<int>(F, WS_TOKE); const float* TOKG = wsp<float>(F, WS_TOKG); const int* WCNT = wsp<int>(F, WS_WCNT); const int* BCNT = wsp<int>(F, WS_BCNT);
    int* ETAB = wsp<int>(F, WS_ETAB); int* ROWTOK = wsp<int>(F, WS_ROWTOK); int* ROWDST = wsp<int>(F, WS_ROWDST); float* ROWGATE = wsp<float>(F, WS_ROWGATE);
    const int e = lane & 31, half = lane >> 5;
    int tot = 0, pre = 0;
    for (int bb = half; bb < 256; bb += 2) { const int c = BCNT[bb * 32 + e]; tot += c; pre += (bb < F.bid) ? c : 0; }
    tot += __shfl_xor(tot, 32); pre += __shfl_xor(pre, 32);
    for (int w = 0; w < wave; ++w) pre += WCNT[(size_t)(F.bid * 8 + w) * 32 + e];
    const int padded = ((tot + 255) / 256) * 256;
    int incl = padded;
#pragma unroll
    for (int o = 1; o < 32; o <<= 1) { const int t = __shfl_up(incl, o, 32); if (e >= o) incl += t; }
    const int pstart = incl - padded;
    if (gw == 0) {
        if (lane < 32) { ETAB[e] = pstart; ETAB[64 + e] = tot; if (e == 31) { ETAB[32] = incl; ETAB[128] = incl / 256; } }
        for (int t = lane; t < MAXTILES; t += 64) { int te = 0;
            for (int x = 0; x < 32; ++x) { const int ps = __shfl(pstart, x), pd = __shfl(padded, x); if (t * 256 >= ps && t * 256 < ps + pd) te = x; }
            ETAB[256 + t] = te; }
    }
    const int token = 16 * gw + (lane >> 2), slot = lane & 3;
    const int me = TOKE[(size_t)token * 4 + slot]; const float mg = TOKG[(size_t)token * 4 + slot];
    int rank = 0;
    for (int x = 0; x < 32; ++x) { const unsigned long long m = __ballot(me == x); if (me == x) rank = __popcll(m & ((1ull << lane) - 1ull)); }
    const int row = __shfl(pstart, me) + __shfl(pre, me) + rank;
    ROWTOK[row] = token; ROWDST[row] = token * 4 + slot; ROWGATE[row] = mg;
}

__device__ __forceinline__ void p13_final(Frame& F) {
    const int gw = F.bid * 8 + F.wave, NGW = F.G * 8, lane = F.lane;
    const float* macc = wsp<float>(F, WS_MODACC); const float* adab = F.in[I_ADAB]; const bf16* SLOT = wsp<bf16>(F, WS_SLOT);
    for (int row = gw; row < NLAT; row += NGW) {
        int l4 = 4 * lane; asm volatile("" : "+v"(l4));
        const int b = row / SEQ; float* xr = F.out + (size_t)row * D;
        f32x4 v[8]; float ss = 0.f;
#pragma unroll
        for (int j = 0; j < 8; ++j) { const int c = l4 + 256 * j;
            f32x4 m = (f32x4){0.f, 0.f, 0.f, 0.f};
#pragma unroll
            for (int s = 0; s < 4; ++s) m += unpk4(*(const GAS v2u*)(SLOT + ((size_t)row * 4 + s) * D + c));
            const f32x4 g5 = *(const GAS f32x4*)(macc + (size_t)b * 12288 + 5 * 2048 + c) + *(const GAS f32x4*)(adab + 5 * 2048 + c);
            v[j] = *(const GAS f32x4*)(xr + c) + g5 * m;
            ss += (v[j].x * v[j].x + v[j].y * v[j].y) + (v[j].z * v[j].z + v[j].w * v[j].w); }
        const float rstd = 1.0f / sqrtf(wave_sum(ss) * (1.0f / D) + 1e-6f);
#pragma unroll
        for (int j = 0; j < 8; ++j) *(GAS f32x4*)(xr + l4 + 256 * j) = v[j] * rstd * *(const GAS f32x4*)(F.in[I_FING] + l4 + 256 * j);
    }
}

constexpr int NPH = 13;
__global__ void __launch_bounds__(512, 2) mk_fwd(Args args) {
    extern __shared__ __attribute__((aligned(16))) unsigned char lds_raw[];
    Frame F;
    F.lds = (LAS unsigned char*)lds_raw; F.in = args.in; F.out = args.out; F.ws = args.ws;
    F.tid = threadIdx.x; F.lane = F.tid & 63; F.wave = __builtin_amdgcn_readfirstlane(F.tid >> 6); F.G = gridDim.x; F.bid = blockIdx.x;
    volatile LAS unsigned* MISC = (volatile LAS unsigned*)(F.lds + MISC_OFF);
    if (F.tid < 32) MISC[F.tid] = 0u;
    __syncthreads();
    const int lo = args.ph_lo, hi = args.ph_hi;
    unsigned* ctl = (unsigned*)(F.ws + WS_CTL);
    XcdBarrier bar; bar.bar = ctl + CW_BAR; bar.x = 0; bar.st = nullptr;
    if (hi - lo > 1) bar = xcd_barrier_post(ctl + CW_BAR, MISC + 8);
#ifndef PH_MASK
#define PH_MASK 0x1FFF
#endif
#define IN(k) (((PH_MASK >> (k)) & 1) && lo <= (k) && (k) < hi)
#ifndef REP_PH
#define REP_PH -1
#endif
#define SEAM(k) do { if (IN(k) && IN((k) + 1)) xcd_barrier(bar); } while (0)

    if (IN(0)) { p0_adaln(F); p0_small_weights(F); p0_filter(F); }
    SEAM(0);
#define PHBODY_1  p1_norm1(F);
    if (IN(1)) { PHBODY_1 }
    if (REP_PH == 1 && IN(1)) { PHBODY_1 }
    SEAM(1);
#define PHBODY_2     \
        pg8::Gemm g{wsp<bf16>(F, WS_A1), wsp<bf16>(F, WS_BTIN), D, 0}; \
        pg8::InProjOrder S{F.G, F.bid}; \
        pg8::EpiInProj E{wsp<bf16>(F, WS_Z), wsp<bf16>(F, WS_AP)}; \
        pg8::gemm_phase<false>(F.lds, g, S, E); \

    if (IN(2)) { PHBODY_2 }
    if (REP_PH == 2 && IN(2)) { PHBODY_2 }
    SEAM(2);
#define PHBODY_3     \
        pg8::Gemm g{wsp<bf16>(F, WS_AP), wsp<bf16>(F, WS_BTL), KLORA, 0}; \
        pg8::StaticOrder S; S.init(MROWS, NLORA, F.G, F.bid); \
        pg8::EpiLora E{wsp<bf16>(F, WS_EA), F.in[I_RW0], F.in[I_RA0]}; \
        pg8::gemm_phase<false>(F.lds, g, S, E); \

    if (IN(3)) { PHBODY_3 }
    if (REP_PH == 3 && IN(3)) { PHBODY_3 }
    SEAM(3);
#define PHBODY_4  p4_prep(F);
    if (IN(4)) { PHBODY_4 }
    if (REP_PH == 4 && IN(4)) { PHBODY_4 }
    SEAM(4);
#define PHBODY_5  p5_scan(F); p6_hyena(F);
    if (IN(5)) { PHBODY_5 }
    if (REP_PH == 5 && IN(5)) { PHBODY_5 }
    if (REP_PH == 50 && IN(5)) { p5_scan(F); }
    if (REP_PH == 51 && IN(5)) { p6_hyena(F); }
    SEAM(5);
#define PHBODY_6  p7_assemble(F);
    if (IN(6)) { PHBODY_6 }
    if (REP_PH == 6 && IN(6)) { PHBODY_6 }
    SEAM(6);
#define PHBODY_7     \
        pg8::Gemm g{wsp<bf16>(F, WS_A2), wsp<bf16>(F, WS_BTOUT), D, 0}; \
        pg8::StaticOrder S; S.init(NLAT, D, F.G, F.bid); \
        pg8::EpiOutProj E{F.in[I_X], F.out, wsp<float>(F, WS_MODACC), F.in[I_ADAB]}; \
        pg8::gemm_phase<false>(F.lds, g, S, E); \

    if (IN(7)) { PHBODY_7 }
    if (REP_PH == 7 && IN(7)) { PHBODY_7 }
    SEAM(7);
#define PHBODY_8  p9_router(F);
    if (IN(8)) { PHBODY_8 }
    if (REP_PH == 8 && IN(8)) { PHBODY_8 }
    SEAM(8);
#define PHBODY_9  p10_sort(F);
    if (IN(9)) { PHBODY_9 }
    if (REP_PH == 9 && IN(9)) { PHBODY_9 }
    SEAM(9);
#define PHBODY_10    \
        const int* ET = wsp<int>(F, WS_ETAB); \
        pg8::Gemm g{wsp<bf16>(F, WS_H2), wsp<bf16>(F, WS_BTGU), D, (size_t)4096 * D * 2}; \
        pg8::MoeOrder S{F.G, F.bid, 16, ET[128], ET + 256, wsp<int>(F, WS_ROWTOK), ET, ET + 64}; \
        pg8::EpiSwiglu E{wsp<bf16>(F, WS_ACT), F.in[I_EBG], F.in[I_EBU]}; \
        pg8::gemm_phase<true>(F.lds, g, S, E); \

    if (IN(10)) { PHBODY_10 }
    if (REP_PH == 10 && IN(10)) { PHBODY_10 }
    SEAM(10);
#define PHBODY_11    \
        const int* ET = wsp<int>(F, WS_ETAB); \
        pg8::Gemm g{wsp<bf16>(F, WS_ACT), wsp<bf16>(F, WS_BTD), D, (size_t)D * D * 2}; \
        pg8::MoeOrder S{F.G, F.bid, 8, ET[128], ET + 256, wsp<int>(F, WS_ROWTOK), ET, ET + 64}; \
        pg8::EpiDown E{wsp<bf16>(F, WS_SLOT), F.in[I_EBD], wsp<int>(F, WS_ROWDST), wsp<float>(F, WS_ROWGATE), ET, ET + 64}; \
        pg8::gemm_phase<false>(F.lds, g, S, E); \

    if (IN(11)) { PHBODY_11 }
    if (REP_PH == 11 && IN(11)) { PHBODY_11 }
    SEAM(11);
    if (IN(12)) { p13_final(F); }
#undef IN
#undef SEAM
}

extern "C" void kernel_launch(void* const* d_in, const int* in_sizes, int n_in, void* d_out, int out_size, void* d_ws, size_t ws_size, hipStream_t stream) {
    static int grid = 0;
    if (grid == 0) {
        if (n_in != 44 || out_size != NLAT * D || ws_size < WS_END) { fprintf(stderr, "kernel_launch: unexpected problem (n_in %d, out %d, ws %zu)\n", n_in, out_size, ws_size); grid = -1; return; }
        if (hipFuncSetAttribute((const void*)mk_fwd, hipFuncAttributeMaxDynamicSharedMemorySize, LDS_BYTES) != hipSuccess) { fprintf(stderr, "kernel_launch: hipFuncSetAttribute failed\n"); grid = -1; return; }
        int per_cu = 0;
        if (hipOccupancyMaxActiveBlocksPerMultiprocessor(&per_cu, (const void*)mk_fwd, 512, LDS_BYTES) != hipSuccess || per_cu < 1) fprintf(stderr, "kernel_launch: occupancy query says %d blocks per CU\n", per_cu);
        (void)hipGetLastError();
        grid = 256;
    }
    if (grid < 0) return;
    (void)hipMemsetAsync((char*)d_ws + WS_CTL, 0, CTL_ZERO_BYTES, stream);
    Args a{};
    for (int i = 0; i < 44; ++i) a.in[i] = (const float*)d_in[i];
    a.out = (float*)d_out; a.ws = (unsigned char*)d_ws;
#if MK_PER_PHASE
    for (int ph = 0; ph < NPH; ++ph) { a.ph_lo = ph; a.ph_hi = ph + 1; hipLaunchKernelGGL(mk_fwd, dim3(grid), dim3(512), LDS_BYTES, stream, a); }
#else
    a.ph_lo = 0; a.ph_hi = NPH;
    hipLaunchKernelGGL(mk_fwd, dim3(grid), dim3(512), LDS_BYTES, stream, a);
#endif
    const hipError_t le = hipPeekAtLastError();
    if (le != hipSuccess) fprintf(stderr, "kernel_launch: launch failed: %s\n", hipGetErrorName(le));
}
```

```cpp
#include <hip/hip_runtime.h>
#include <cstdio>
#include <cstdint>

#ifndef MK_PER_PHASE
#define MK_PER_PHASE 0
#endif

#define GAS __attribute__((address_space(1)))
#define LAS __attribute__((address_space(3)))
typedef unsigned short bf16;
typedef unsigned v4u __attribute__((ext_vector_type(4)));
typedef unsigned v2u __attribute__((ext_vector_type(2)));
typedef float f32x4 __attribute__((ext_vector_type(4)));
typedef float f32x2 __attribute__((ext_vector_type(2)));
typedef short bf16x8 __attribute__((ext_vector_type(8)));

constexpr int NB = 16, SEQ = 2048, CTXL = 256, D = 2048;
constexpr int NLAT = NB * SEQ;
constexpr int NCTX = NB * CTXL;
constexpr int MROWS = NLAT + NCTX;
constexpr int PW = 6144;
constexpr int NIN = 6656;
constexpr int NLORA = 5120, KLORA = 512;
constexpr int NE = 32, TOPK = 4;
constexpr int NASG = NLAT * TOPK;
constexpr int MAXTILES = NASG / 256 + NE;
constexpr int SIW = 7168;

constexpr size_t MiB = 1u << 20;
constexpr size_t WS_CTL = 0;
constexpr size_t WS_MODACC = 1 * MiB;
constexpr size_t CTL_ZERO_BYTES = 1 * MiB;
constexpr size_t WS_MODT = 15 * MiB;
constexpr size_t WS_BS = 3 * MiB;
constexpr size_t WS_TOKE = 5 * MiB;
constexpr size_t WS_TOKG = 6 * MiB;
constexpr size_t WS_WCNT = 7 * MiB;
constexpr size_t WS_BCNT = 7 * MiB + 512 * 1024;
constexpr size_t WS_ETAB = 7 * MiB + 768 * 1024;
constexpr size_t WS_ROWTOK = 8 * MiB;
constexpr size_t WS_ROWDST = 9 * MiB;
constexpr size_t WS_ROWGATE = 10 * MiB;
constexpr size_t WS_SSQ = 1040 * MiB;
constexpr size_t WS_H3T = 12 * MiB;
constexpr size_t WS_G = 16 * MiB;
constexpr size_t WS_BTIN = 24 * MiB;
constexpr size_t WS_BTL = 50 * MiB;
constexpr size_t WS_BTOUT = 55 * MiB;
constexpr size_t WS_WR = 63 * MiB;
constexpr size_t WS_A1 = 64 * MiB;
constexpr size_t WS_Z = 208 * MiB;
constexpr size_t WS_AP = 640 * MiB;
constexpr size_t WS_X1B = 676 * MiB;
constexpr size_t WS_EA = 676 * MiB;
constexpr size_t WS_KKINV = 1036 * MiB;
constexpr size_t WS_UT = 1540 * MiB;
constexpr size_t WS_X0T = 1604 * MiB;
constexpr size_t WS_YCT = 1668 * MiB;
constexpr size_t WS_YS = 1040 * MiB;
constexpr size_t WS_A2 = 208 * MiB;
constexpr size_t WS_ZC = 1296 * MiB;
constexpr size_t WS_H2 = 336 * MiB;
constexpr size_t WS_BTGU = 1732 * MiB;
constexpr size_t WS_BTD = 64 * MiB;
constexpr size_t WS_ACT = 400 * MiB;
constexpr size_t WS_SLOT = 1040 * MiB;
constexpr size_t WS_END = 1988 * MiB;

constexpr int CW_TMO = 0;
constexpr int CW_BAR = 4096;

constexpr int LDS_BYTES = 147456;
constexpr int MISC_OFF = 143360;

__device__ __forceinline__ unsigned f2bf(float f) { unsigned u = __builtin_bit_cast(unsigned, f); return (u + 0x7fffu + ((u >> 16) & 1u)) >> 16; }
typedef __bf16 bf16v2_t __attribute__((ext_vector_type(2)));
__device__ __forceinline__ unsigned pk2(float lo, float hi) { const f32x2 v = {lo, hi}; return __builtin_bit_cast(unsigned, __builtin_convertvector(v, bf16v2_t)); }
__device__ __forceinline__ float bf2f(unsigned b) { return __builtin_bit_cast(float, b << 16); }
__device__ __forceinline__ float bflo(unsigned w) { return __builtin_bit_cast(float, w << 16); }
__device__ __forceinline__ float bfhi(unsigned w) { return __builtin_bit_cast(float, w & 0xffff0000u); }
__device__ __forceinline__ float fsigmoid(float x) { return __builtin_amdgcn_rcpf(1.0f + __builtin_amdgcn_exp2f(-1.4426950408889634f * x)); }
__device__ __forceinline__ float ftanh(float x) { const float e = __builtin_amdgcn_exp2f(2.8853900817779268f * x); return 1.0f - 2.0f * __builtin_amdgcn_rcpf(e + 1.0f); }
#define LDS_WAIT() asm volatile("s_waitcnt lgkmcnt(0)" ::: "memory")
#define VM_WAIT() asm volatile("s_waitcnt vmcnt(0)" ::: "memory")

#define XB_TMO      128
#define XB_XCNT(j)  (256  + 64 * (j))
#define XB_XSUB(j)  (1280 + 64 * (j))
#define XB_XGEN(j)  (2304 + 64 * (j))
#define XB_TOP      3328
#define XB_TOPGEN   3392
#define XCD_BAR_WORDS 3456
#define XB_SPIN_CAP (1u << 20)

__device__ __forceinline__ unsigned xb_ld(unsigned* p)              { return __hip_atomic_load(p, __ATOMIC_RELAXED, __HIP_MEMORY_SCOPE_AGENT); }
__device__ __forceinline__ unsigned xb_add(unsigned* p, unsigned v) { return __hip_atomic_fetch_add(p, v, __ATOMIC_RELAXED, __HIP_MEMORY_SCOPE_AGENT); }
__device__ __forceinline__ unsigned xb_xcc_id() { return (unsigned)__builtin_amdgcn_s_getreg((3 << 11) | 20) & 0xFu; }
#define XB_SPIN(cond, bar) do { unsigned _sp = 0; while (cond) { __builtin_amdgcn_s_sleep(1); \
    if ((++_sp & 255u) == 0u) { if (xb_ld(&(bar)[XB_TMO])) break; if (_sp > XB_SPIN_CAP) { atomicAdd(&(bar)[XB_TMO], 1u); break; } } } } while (0)

struct XcdBarrier { unsigned* bar; unsigned x; volatile LAS unsigned* st; };

__device__ __forceinline__ XcdBarrier xcd_barrier_post(unsigned* bar, volatile LAS unsigned* st) {
    XcdBarrier b; b.bar = bar; b.x = xb_xcc_id(); b.st = st;
    if (threadIdx.x == 0) (void)xb_add(&bar[XB_XCNT(b.x)], 1u);
    return b;
}
__device__ __forceinline__ void xcd_barrier_complete(unsigned* bar, unsigned x, unsigned& nloc, unsigned& nx) {
    const unsigned G = gridDim.x * gridDim.y * gridDim.z;
    unsigned sum, cnt, mine, sp = 0u;
    for (;;) {
        sum = 0u; cnt = 0u; mine = 0u;
#pragma unroll
        for (unsigned j = 0; j < 16; ++j) { const unsigned c = xb_ld(&bar[XB_XCNT(j)]); sum += c; cnt += (c > 0u) ? 1u : 0u; mine = (j == x) ? c : mine; }
        if (sum == G) break;
        __builtin_amdgcn_s_sleep(1);
        if ((++sp & 255u) == 0u) { if (xb_ld(&bar[XB_TMO])) break; if (sp > XB_SPIN_CAP) { atomicAdd(&bar[XB_TMO], 1u); break; } }
    }
    nloc = mine > 0u ? mine : 1u; nx = cnt > 0u ? cnt : 1u;
}
__device__ __forceinline__ void xcd_barrier(const XcdBarrier& b) {
    asm volatile("s_waitcnt vmcnt(0)" ::: "memory");
    __syncthreads();
    if (threadIdx.x == 0) {
        unsigned* bar = b.bar;
        __builtin_amdgcn_s_waitcnt(0);
        unsigned nloc = b.st[0], nx = b.st[1];
        if (nloc == 0u) { xcd_barrier_complete(bar, b.x, nloc, nx); b.st[0] = nloc; b.st[1] = nx; }
        const unsigned old = xb_add(&bar[XB_XSUB(b.x)], 1u);
        const unsigned gen = old / nloc;
        if (old + 1u == (gen + 1u) * nloc) {
            __builtin_amdgcn_fence(__ATOMIC_RELEASE, "agent");
            asm volatile("s_waitcnt vmcnt(0)" ::: "memory");
            const unsigned og = xb_add(&bar[XB_TOP], 1u);
            const unsigned tg = og / nx;
            if (og + 1u == (tg + 1u) * nx) xb_add(&bar[XB_TOPGEN], 1u);
            else XB_SPIN(xb_ld(&bar[XB_TOPGEN]) == tg, bar);
            __builtin_amdgcn_fence(__ATOMIC_ACQUIRE, "agent");
            xb_add(&bar[XB_XGEN(b.x)], 1u);
            asm volatile("s_waitcnt vmcnt(0)" ::: "memory");
        } else {
            XB_SPIN(xb_ld(&bar[XB_XGEN(b.x)]) == gen, bar);
            __builtin_amdgcn_fence(__ATOMIC_ACQUIRE, "agent");
            asm volatile("s_waitcnt vmcnt(0)" ::: "memory");
        }
    }
    __syncthreads();
}

namespace pg8 {
constexpr int BM = 256, BK = 64, HALF = 128, HTB = HALF * BK * 2, STAGE_BYTES = 8 * HTB, NXCD = 8, WGM = 8;
__device__ __forceinline__ int lds_byte(int r, int c) { const int st = (r >> 4) * 2 + (c >> 5), rr = r & 15, cc = c & 31, ob = rr * 64 + cc * 2; return st * 1024 + (ob ^ (((ob >> 9) & 1) << 5)); }
__device__ __forceinline__ void stage_rc(int b, int& R, int& C) { const int st = b / 1024, sb = b % 1024, swz = sb ^ (((sb >> 9) & 1) << 5); R = (st >> 1) * 16 + swz / 64; C = (st & 1) * 32 + (swz % 64) / 2; }
__device__ __forceinline__ int perm32(int rho) { const int n = rho >> 4, i = rho & 15; return 8 * (i >> 2) + 4 * n + (i & 3); }

typedef int i32x4 __attribute__((ext_vector_type(4)));
typedef int i32x8 __attribute__((ext_vector_type(8)));
__device__ __forceinline__ i32x8 cat_i8(bf16x8 a, bf16x8 b) { return __builtin_shufflevector(__builtin_bit_cast(i32x4, a), __builtin_bit_cast(i32x4, b), 0, 1, 2, 3, 4, 5, 6, 7); }
struct Unit { int pm, pn, e; };
struct Gemm { const bf16* A; const bf16* Bt; int K; size_t bstrideE; int lda, ldb; };

__device__ __forceinline__ unsigned cvt_pk_bf16(float lo, float hi) { return pk2(lo, hi); }

template <bool GATHER, bool FP8, class Epi, class Sched>
__device__ __forceinline__ void gemm_phase(LAS unsigned char* lds, const Gemm g, const Sched& S, const Epi& E) {
    const int tid = threadIdx.x, wid = __builtin_amdgcn_readfirstlane(tid >> 6), lane = tid & 63, wr = wid >> 2, wc = wid & 3, fr = lane & 15, fq = lane >> 4;
    const int K = g.K, nt = K / BK, lda = g.lda, ldb = g.ldb;
    unsigned voffB[2]; int RA[2], CA[2];
#pragma unroll
    for (int i = 0; i < 2; ++i) { int R, C; stage_rc(tid * 16 + i * 8192, R, C); const int Rb = Epi::PERM ? ((R & ~31) + perm32(R & 31)) : R;
        RA[i] = R; CA[i] = C; voffB[i] = (unsigned)(Rb * ldb + C) * 2u; }
    const size_t kstep = (size_t)(BK * 2);
    const size_t hstep = (size_t)HALF * ldb * 2, tstep = 2 * hstep;
    const size_t hstepA = (size_t)HALF * lda * 2, tstepA = 2 * hstepA;
    const unsigned ldsw = (unsigned)wid * 1024u;
    const int aoff = lds_byte(wr * 64 + fr, fq * 8), boff = lds_byte(wc * 32 + fr, fq * 8);
#define PG8_SA(b, h) (((b) * 2 + (h)) * HTB)
#define PG8_SB(b, h) ((4 + (b) * 2 + (h)) * HTB)
#define PG8_STAGE(bufoff, gbase, voff) do { _Pragma("unroll") for (int _i = 0; _i < 2; ++_i) \
        __builtin_amdgcn_global_load_lds((const unsigned*)((const char*)(gbase) + (voff)[_i]), (LAS unsigned*)(lds + (bufoff) + ldsw + _i * 8192), 16, 0, 0); } while (0)
#define PG8_LDA(dst, b, h) do { _Pragma("unroll") for (int m = 0; m < 4; ++m) { if constexpr (FP8) dst##8[m] = cat_i8(*(const LAS bf16x8*)(lds + PG8_SA(b, h) + aoff + m * 2048), *(const LAS bf16x8*)(lds + PG8_SA(b, h) + aoff + m * 2048 + 1024)); \
        else { _Pragma("unroll") for (int k = 0; k < 2; ++k) dst[m][k] = *(const LAS bf16x8*)(lds + PG8_SA(b, h) + aoff + m * 2048 + k * 1024); } } } while (0)
#define PG8_LDB(dst, b, h) do { _Pragma("unroll") for (int n = 0; n < 2; ++n) { if constexpr (FP8) dst##8[n] = cat_i8(*(const LAS bf16x8*)(lds + PG8_SB(b, h) + boff + n * 2048), *(const LAS bf16x8*)(lds + PG8_SB(b, h) + boff + n * 2048 + 1024)); \
        else { _Pragma("unroll") for (int k = 0; k < 2; ++k) dst[n][k] = *(const LAS bf16x8*)(lds + PG8_SB(b, h) + boff + n * 2048 + k * 1024); } } } while (0)
#define PG8_F8STR(d, a, b) "v_mfma_scale_f32_16x16x128_f8f6f4 %" #d ", %" #a ", %" #b ", %" #d ", %14, %14 op_sel_hi:[0,0,0]\n\t"
#define PG8_MMA(ai, bj, At, Bt) do { __builtin_amdgcn_s_setprio(1); \
        if constexpr (FP8) { asm volatile("s_nop 1\n\t" PG8_F8STR(0, 12, 8) PG8_F8STR(1, 13, 8) PG8_F8STR(2, 12, 9) PG8_F8STR(3, 13, 9) PG8_F8STR(4, 12, 10) PG8_F8STR(5, 13, 10) PG8_F8STR(6, 12, 11) PG8_F8STR(7, 13, 11) \
            : "+v"(acc[ai][bj][0][0]), "+v"(acc[ai][bj][0][1]), "+v"(acc[ai][bj][1][0]), "+v"(acc[ai][bj][1][1]), "+v"(acc[ai][bj][2][0]), "+v"(acc[ai][bj][2][1]), "+v"(acc[ai][bj][3][0]), "+v"(acc[ai][bj][3][1]) \
            : "v"(At##8[0]), "v"(At##8[1]), "v"(At##8[2]), "v"(At##8[3]), "v"(Bt##8[0]), "v"(Bt##8[1]), "v"(f8scale)); } \
        else { _Pragma("unroll") for (int m = 0; m < 4; ++m) _Pragma("unroll") for (int n = 0; n < 2; ++n) _Pragma("unroll") for (int k = 0; k < 2; ++k) \
            acc[ai][bj][m][n] = __builtin_amdgcn_mfma_f32_16x16x32_bf16(Bt[n][k], At[m][k], acc[ai][bj][m][n], 0, 0, 0); } __builtin_amdgcn_s_setprio(0); } while (0)
#define PG8_WAIT_V(n) asm volatile("s_waitcnt vmcnt(" #n ")" ::: "memory")
#define PG8_WAIT_L(n) asm volatile("s_waitcnt lgkmcnt(" #n ")" ::: "memory")
#define PG8_BAR __builtin_amdgcn_s_barrier()
#define PG8_SCHED __builtin_amdgcn_sched_barrier(0)
    Unit cur, nxt; int ui = 0;
    if (!S.next(0, cur)) return;
    f32x4 acc[2][2][4][2];
#pragma unroll
    for (int a = 0; a < 2; ++a)
#pragma unroll
        for (int b = 0; b < 2; ++b)
#pragma unroll
            for (int m = 0; m < 4; ++m)
#pragma unroll
                for (int n = 0; n < 2; ++n) acc[a][b][m][n] = (f32x4){0.f, 0.f, 0.f, 0.f};
    bf16x8 At[4][2], B0[2][2], B1[2][2]; i32x8 At8[4], B08[2], B18[2]; int f8scale = 0x7f7f7f7f; asm volatile("" : "+v"(f8scale));
    unsigned vA0[2], vA1[2], vN0[2], vN1[2];
    const char* cA; const char* cB;
    if constexpr (GATHER) {
        cA = (const char*)g.A;
#pragma unroll
        for (int i = 0; i < 2; ++i) { vA0[i] = (unsigned)(S.arow(cur, RA[i]) * lda + CA[i]) * 2u; vA1[i] = (unsigned)(S.arow(cur, HALF + RA[i]) * lda + CA[i]) * 2u; }
    } else {
        cA = (const char*)g.A + (size_t)cur.pm * tstepA;
#pragma unroll
        for (int i = 0; i < 2; ++i) { vA0[i] = (unsigned)(RA[i] * lda + CA[i]) * 2u; vA1[i] = vA0[i] + (unsigned)hstepA; }
    }
#pragma unroll
    for (int i = 0; i < 2; ++i) { vN0[i] = vA0[i]; vN1[i] = vA1[i]; }
    cB = (const char*)g.Bt + (size_t)cur.e * g.bstrideE + (size_t)cur.pn * tstep;
    PG8_STAGE(PG8_SB(0, 0), cB, voffB); PG8_STAGE(PG8_SA(0, 0), cA, vA0); PG8_STAGE(PG8_SB(0, 1), cB + hstep, voffB); PG8_STAGE(PG8_SA(0, 1), cA, vA1);
    if (wr == 1) PG8_BAR;
    PG8_WAIT_V(4); PG8_BAR;
    PG8_STAGE(PG8_SB(1, 0), cB + kstep, voffB); PG8_STAGE(PG8_SA(1, 0), cA + kstep, vA0); PG8_STAGE(PG8_SB(1, 1), cB + hstep + kstep, voffB);
    PG8_WAIT_V(6); PG8_BAR;
    for (;;) {
        const bool has_next = S.next(ui + 1, nxt);
        const char* nA; const char* nB;
        if (has_next) {
            nB = (const char*)g.Bt + (size_t)nxt.e * g.bstrideE + (size_t)nxt.pn * tstep;
            if constexpr (GATHER) { nA = cA;
#pragma unroll
                for (int i = 0; i < 2; ++i) { vN0[i] = (unsigned)(S.arow(nxt, RA[i]) * lda + CA[i]) * 2u; vN1[i] = (unsigned)(S.arow(nxt, HALF + RA[i]) * lda + CA[i]) * 2u; }
            } else nA = (const char*)g.A + (size_t)nxt.pm * tstepA;
        } else { nA = cA; nB = cB;
#pragma unroll
            for (int i = 0; i < 2; ++i) { vN0[i] = vA0[i]; vN1[i] = vA1[i]; } }
#pragma unroll 1
        for (int t = 0; t < nt; t += 2) {
            const bool last = (t == nt - 2);
            const char* a1 = cA + (size_t)(t + 1) * kstep;
            const char* a2 = last ? nA : cA + (size_t)(t + 2) * kstep; const char* b2 = last ? nB : cB + (size_t)(t + 2) * kstep;
            const char* a3 = a2 + kstep; const char* b3 = b2 + kstep;
            unsigned w0[2], w1[2];
#pragma unroll
            for (int i = 0; i < 2; ++i) { if constexpr (GATHER) { w0[i] = last ? vN0[i] : vA0[i]; w1[i] = last ? vN1[i] : vA1[i]; } else { w0[i] = vA0[i]; w1[i] = vA1[i]; } }
            PG8_LDB(B0, 0, 0); PG8_SCHED; PG8_LDA(At, 0, 0); PG8_STAGE(PG8_SA(1, 1), a1, vA1);
            PG8_WAIT_L(8); PG8_BAR; PG8_WAIT_L(0); PG8_MMA(0, 0, At, B0); PG8_BAR; PG8_SCHED;
            PG8_LDB(B1, 0, 1); PG8_STAGE(PG8_SB(0, 0), b2, voffB);
            PG8_BAR; PG8_WAIT_L(0); PG8_MMA(0, 1, At, B1); PG8_BAR;
            PG8_LDA(At, 0, 1); PG8_STAGE(PG8_SA(0, 0), a2, w0);
            PG8_BAR; PG8_WAIT_L(0); PG8_MMA(1, 0, At, B0); PG8_BAR; PG8_SCHED;
            PG8_STAGE(PG8_SB(0, 1), b2 + hstep, voffB);
            PG8_WAIT_V(6); PG8_BAR; PG8_MMA(1, 1, At, B1); PG8_BAR;
            PG8_LDB(B0, 1, 0); PG8_SCHED; PG8_LDA(At, 1, 0); PG8_STAGE(PG8_SA(0, 1), a2, w1);
            PG8_WAIT_L(8); PG8_BAR; PG8_WAIT_L(0); PG8_MMA(0, 0, At, B0); PG8_BAR; PG8_SCHED;
            PG8_LDB(B1, 1, 1); PG8_STAGE(PG8_SB(1, 0), b3, voffB);
            PG8_BAR; PG8_WAIT_L(0); PG8_MMA(0, 1, At, B1); PG8_BAR;
            PG8_LDA(At, 1, 1); PG8_STAGE(PG8_SA(1, 0), a3, w0);
            PG8_BAR; PG8_WAIT_L(0); PG8_MMA(1, 0, At, B0); PG8_BAR; PG8_SCHED;
            PG8_STAGE(PG8_SB(1, 1), b3 + hstep, voffB);
            PG8_WAIT_V(6); PG8_BAR; PG8_MMA(1, 1, At, B1); PG8_BAR;
        }
        if constexpr (FP8) asm volatile("s_nop 15\n\ts_nop 15" ::: "memory");
        E(acc, cur, wr, wc, fr, fq);
        if (!has_next) break;
#pragma unroll
        for (int a = 0; a < 2; ++a)
#pragma unroll
            for (int b = 0; b < 2; ++b)
#pragma unroll
                for (int m = 0; m < 4; ++m)
#pragma unroll
                    for (int n = 0; n < 2; ++n) acc[a][b][m][n] = (f32x4){0.f, 0.f, 0.f, 0.f};
        cur = nxt; cA = nA; cB = nB; ++ui;
#pragma unroll
        for (int i = 0; i < 2; ++i) { vA0[i] = vN0[i]; vA1[i] = vN1[i]; }
    }
    PG8_WAIT_V(0);
    if (wr == 0) PG8_BAR;
    PG8_BAR;
#undef PG8_SA
#undef PG8_SB
#undef PG8_STAGE
#undef PG8_LDA
#undef PG8_LDB
#undef PG8_MMA
#undef PG8_WAIT_V
#undef PG8_WAIT_L
#undef PG8_BAR
#undef PG8_SCHED
}
}

struct Args { const float* in[44]; float* out; unsigned char* ws; int ph_lo, ph_hi; };
enum InIdx { I_X = 0, I_C, I_CTX, I_CCTX, I_ADAW, I_ADAB, I_N1G, I_N2G, I_INW, I_CONVW, I_CONVB, I_HW1, I_HB1, I_HW2, I_HB2, I_HW3, I_HB3, I_HFREQ, I_HW4, I_HBIAS, I_HNG,
             I_RW0, I_RW1, I_RW2, I_RA0, I_RA1, I_RA2, I_RKK, I_RKA, I_RRK, I_RG1, I_RG2, I_LNG, I_LNB, I_OUTW, I_ROUTW, I_ROUTB, I_EWG, I_EBG, I_EWU, I_EBU, I_EWD, I_EBD, I_FING };

struct Frame {
    LAS unsigned char* lds;
    const float* const* in;
    float* out; unsigned char* ws;
    int tid, lane, wave, G, bid;
};
template <class T> __device__ __forceinline__ T* wsp(const Frame& F, size_t off) { return (T*)(F.ws + off); }

template <int CTRL> __device__ __forceinline__ float dpp_mov(float x) { return __builtin_bit_cast(float, __builtin_amdgcn_update_dpp(0, __builtin_bit_cast(int, x), CTRL, 0xF, 0xF, true)); }
__device__ __forceinline__ float row16_sum(float v) {
    v += dpp_mov<0x128>(v);
    v += dpp_mov<0x124>(v);
    v += dpp_mov<0x122>(v);
    v += dpp_mov<0x121>(v);
    return v;
}

__device__ __forceinline__ float rdlane(float v, int l) { return __builtin_bit_cast(float, __builtin_amdgcn_readlane(__builtin_bit_cast(int, v), l)); }
__device__ __forceinline__ float wave_sum(float v) { v = row16_sum(v); return (rdlane(v, 0) + rdlane(v, 16)) + (rdlane(v, 32) + rdlane(v, 48)); }

__device__ __forceinline__ void tr_item(const float* src, size_t ld_src, int k0, int n0, bf16* dst, bf16* dlo, size_t ld_dst, int drow0, int dk0, LAS float* scr, int lane) {
    const int c = lane & 7;
    if (src == nullptr) {
#pragma unroll
        for (int j = 0; j < 4; ++j) { const int n = (lane >> 3) + 8 * j; *(GAS v4u*)(dst + (size_t)(drow0 + n) * ld_dst + dk0 + 8 * c) = (v4u){0u, 0u, 0u, 0u}; }
        return;
    }
#pragma unroll 8
    for (int i = 0; i < 32; ++i) { const int kk = 2 * i + (lane >> 5); scr[kk * 33 + (lane & 31)] = src[(size_t)(k0 + kk) * ld_src + n0 + (lane & 31)]; }
    LDS_WAIT(); asm volatile("" ::: "memory");
#pragma unroll
    for (int j = 0; j < 4; ++j) { const int n = (lane >> 3) + 8 * j; const LAS float* s = scr + (8 * c) * 33 + n;
        float v[8];
#pragma unroll
        for (int q = 0; q < 8; ++q) v[q] = s[q * 33];
        v4u o; o.x = pk2(v[0], v[1]); o.y = pk2(v[2], v[3]); o.z = pk2(v[4], v[5]); o.w = pk2(v[6], v[7]);
        *(GAS v4u*)(dst + (size_t)(drow0 + n) * ld_dst + dk0 + 8 * c) = o;
        if (dlo) { float r[8];
#pragma unroll
            for (int q = 0; q < 8; ++q) r[q] = v[q] - bf2f(f2bf(v[q]));
            v4u p; p.x = pk2(r[0], r[1]); p.y = pk2(r[2], r[3]); p.z = pk2(r[4], r[5]); p.w = pk2(r[6], r[7]);
            *(GAS v4u*)(dlo + (size_t)(drow0 + n) * ld_dst + dk0 + 8 * c) = p; } }
    LDS_WAIT(); asm volatile("" ::: "memory");
}

struct ConvItem { const float* src; unsigned char* dst; };
__device__ __forceinline__ ConvItem conv_item(const Frame& F, int it) {
    const int e = it / 6144, r = it % 6144; ConvItem c;
    if (r < 4096) { const int s = r / 2048, rr = r % 2048, kb = rr / 64, nb = rr % 64;
        c.src = (s ? F.in[I_EWU] : F.in[I_EWG]) + (size_t)e * D * D + (size_t)(64 * kb) * D + 32 * nb;
        c.dst = F.ws + WS_BTGU + ((size_t)e * 4096 + 256 * (nb / 4) + 128 * s + 32 * (nb % 4)) * D + 64 * kb; }
    else { const int rr = r - 4096, kb = rr / 64, nb = rr % 64;
        c.src = F.in[I_EWD] + (size_t)e * D * D + (size_t)(64 * kb) * D + 32 * nb;
        c.dst = F.ws + WS_BTD + ((size_t)e * D + 32 * nb) * D + 64 * kb; }
    return c;
}
__device__ __forceinline__ void conv_issue(const ConvItem& c, f32x4 (&cv)[8], int lane) {
#pragma unroll
    for (int i = 0; i < 8; ++i) cv[i] = *(const GAS f32x4*)(c.src + (size_t)(8 * i + (lane >> 3)) * D + 4 * (lane & 7));
}
__device__ __forceinline__ void conv_finish(const ConvItem& c, const f32x4 (&cv)[8], LAS float* scr, int lane) {
#pragma unroll
    for (int i = 0; i < 8; ++i) { LAS float* d = scr + (8 * i + (lane >> 3)) * 33 + 4 * (lane & 7); d[0] = cv[i].x; d[1] = cv[i].y; d[2] = cv[i].z; d[3] = cv[i].w; }
    LDS_WAIT(); asm volatile("" ::: "memory");
    const int cc = lane & 7;
#pragma unroll
    for (int j = 0; j < 4; ++j) { const int n = (lane >> 3) + 8 * j; const LAS float* s = scr + (8 * cc) * 33 + n;
        float v[8];
#pragma unroll
        for (int q = 0; q < 8; ++q) v[q] = s[q * 33] * 64.0f;
        int w0 = __builtin_amdgcn_cvt_pk_fp8_f32(v[0], v[1], 0, false); w0 = __builtin_amdgcn_cvt_pk_fp8_f32(v[2], v[3], w0, true);
        int w1 = __builtin_amdgcn_cvt_pk_fp8_f32(v[4], v[5], 0, false); w1 = __builtin_amdgcn_cvt_pk_fp8_f32(v[6], v[7], w1, true);
        v2u o; o.x = (unsigned)w0; o.y = (unsigned)w1;
        *(GAS v2u*)(c.dst + (size_t)n * D + 8 * cc) = o; }
    LDS_WAIT(); asm volatile("" ::: "memory");
}

typedef short bf16x8_t __attribute__((ext_vector_type(8)));
struct ConvSel { bf16x8_t b0, b1; };
__device__ __forceinline__ ConvSel conv_sel(int lane) {
    const int c = lane & 15, qd = lane >> 4, e = c & 3; const bool on = (c >> 2) == qd; const unsigned val = on ? ((e & 1) ? 0x42800000u : 0x00004280u) : 0u;
    v4u s0, s1; s0.x = (e >> 1) == 0 ? val : 0u; s0.y = (e >> 1) == 1 ? val : 0u; s0.z = 0u; s0.w = 0u; s1.x = 0u; s1.y = 0u; s1.z = s0.x; s1.w = s0.y;
    ConvSel r; r.b0 = __builtin_bit_cast(bf16x8_t, s0); r.b1 = __builtin_bit_cast(bf16x8_t, s1); return r;
}
__device__ __forceinline__ void conv_issue_m(const ConvItem& c, f32x4 (&cv)[8], int lane) {
    const int r = lane & 15, qd = lane >> 4; const float* p = c.src + (size_t)(16 * (r >> 2) + (r & 3)) * D + 4 * qd;
#pragma unroll
    for (int blk = 0; blk < 4; ++blk) { cv[2 * blk] = *(const GAS f32x4*)(p + (size_t)(4 * blk) * D); cv[2 * blk + 1] = *(const GAS f32x4*)(p + (size_t)(4 * blk) * D + 16); }
}
__device__ __forceinline__ void conv_finish_m(const ConvItem& c, const f32x4 (&cv)[8], const ConvSel& sel, int lane) {
    const int cc = lane & 15, mg = lane >> 4; unsigned w0[4], w1[4]; const f32x4 z4 = (f32x4){0.f, 0.f, 0.f, 0.f};
#pragma unroll
    for (int blk = 0; blk < 4; ++blk) { v4u a; a.x = pk2(cv[2 * blk].x, cv[2 * blk].y); a.y = pk2(cv[2 * blk].z, cv[2 * blk].w); a.z = pk2(cv[2 * blk + 1].x, cv[2 * blk + 1].y); a.w = pk2(cv[2 * blk + 1].z, cv[2 * blk + 1].w);
        const bf16x8_t A = __builtin_bit_cast(bf16x8_t, a);
        const f32x4 d0 = __builtin_amdgcn_mfma_f32_16x16x32_bf16(A, sel.b0, z4, 0, 0, 0), d1 = __builtin_amdgcn_mfma_f32_16x16x32_bf16(A, sel.b1, z4, 0, 0, 0);
        int t0 = __builtin_amdgcn_cvt_pk_fp8_f32(d0.x, d0.y, 0, false); t0 = __builtin_amdgcn_cvt_pk_fp8_f32(d0.z, d0.w, t0, true);
        int t1 = __builtin_amdgcn_cvt_pk_fp8_f32(d1.x, d1.y, 0, false); t1 = __builtin_amdgcn_cvt_pk_fp8_f32(d1.z, d1.w, t1, true);
        w0[blk] = (unsigned)t0; w1[blk] = (unsigned)t1; }
    unsigned char* dp = c.dst + (size_t)cc * D + 16 * mg;
    *(GAS v4u*)dp = (v4u){w0[0], w0[1], w0[2], w0[3]}; *(GAS v4u*)(dp + (size_t)16 * D) = (v4u){w1[0], w1[1], w1[2], w1[3]};
}

__device__ __forceinline__ void p0_small_weights(Frame& F) {
    LAS float* scr = (LAS float*)(F.lds + F.wave * 8448);
    if (F.bid < 96) return;
    const int gw = (F.bid - 96) * 8 + F.wave, NGW = (F.G - 96) * 8;
    constexpr int I_T1 = 32 * 192, I_T2 = 128, I_T3 = 128, I_T4 = 128, I_T5 = 128, I_T6 = 32 * 64, I_T7 = 160 * 8, I_T8 = 32;
    constexpr int NITEMS = I_T1 + I_T2 + I_T3 + I_T4 + I_T5 + I_T6 + I_T7 + I_T8;
    bf16* BtIn = wsp<bf16>(F, WS_BTIN); bf16* BtL = wsp<bf16>(F, WS_BTL); bf16* BtOut = wsp<bf16>(F, WS_BTOUT); bf16* Wr = wsp<bf16>(F, WS_WR);
    for (int it = gw; it < NITEMS; it += NGW) {
        int r = it;
        if (r < I_T1) { const int kb = r / 192, nb = r % 192; tr_item(F.in[I_INW], PW, 64 * kb, 32 * nb, BtIn, nullptr, D, 32 * nb, 64 * kb, scr, F.lane); continue; } r -= I_T1;
        if (r < I_T2) { const int dir = r / 64, q = r % 64, kb = q / 2, nb = q % 2; tr_item(F.in[I_RW1] + (size_t)dir * D * 64, 64, 64 * kb, 32 * nb, BtIn, nullptr, D, 6144 + 64 * dir + 32 * nb, 64 * kb, scr, F.lane); continue; } r -= I_T2;
        if (r < I_T3) { const int dir = r / 64, q = r % 64, kb = q / 2, nb = q % 2; tr_item(F.in[I_RA1] + (size_t)dir * D * 64, 64, 64 * kb, 32 * nb, BtIn, nullptr, D, 6272 + 64 * dir + 32 * nb, 64 * kb, scr, F.lane); continue; } r -= I_T3;
        if (r < I_T4) { const int kb = r / 4, nb = r % 4; tr_item(F.in[I_RG1], 128, 64 * kb, 32 * nb, BtIn, nullptr, D, 6400 + 32 * nb, 64 * kb, scr, F.lane); continue; } r -= I_T4;
        if (r < I_T5) { const int kb = r / 4, nb = r % 4; tr_item(nullptr, 0, 0, 0, BtIn, nullptr, D, 6528 + 32 * nb, 64 * kb, scr, F.lane); continue; } r -= I_T5;
        if (r < I_T6) { const int kb = r / 64, nb = r % 64; f32x4 cv[8];
            ConvItem c; c.src = F.in[I_OUTW] + (size_t)(64 * kb) * D + 32 * nb; c.dst = (unsigned char*)BtOut + (size_t)(32 * nb) * D + 64 * kb;
            conv_issue(c, cv, F.lane); conv_finish(c, cv, scr, F.lane); continue; } r -= I_T6;
        if (r < I_T7) { const int nb = r / 8, kb = r % 8, j = nb / 32, n0 = (nb % 32) * 32; const float* src = nullptr; int k0 = 0;
            if (j == 0 && kb == 0) src = F.in[I_RW2];
            else if (j == 1 && kb == 1) src = F.in[I_RW2] + 64 * 1024;
            else if (j == 2 && kb == 2) src = F.in[I_RA2];
            else if (j == 3 && kb == 3) src = F.in[I_RA2] + 64 * 1024;
            else if (j == 4 && (kb == 4 || kb == 5)) { src = F.in[I_RG2]; k0 = 64 * (kb - 4); }
            tr_item(src, 1024, k0, n0, BtL, nullptr, KLORA, 32 * nb, 64 * kb, scr, F.lane); continue; } r -= I_T7;
        { const int kb = r; tr_item(F.in[I_ROUTW], 32, 64 * kb, 0, Wr, Wr + 32 * D, D, 0, 64 * kb, scr, F.lane); }
    }
}

__device__ __forceinline__ void p0_adaln(Frame& F) {
    if (F.bid >= 96) return;
    const int kh = F.bid / 48, cg = F.bid % 48, k0 = 1024 * kh + 128 * F.wave;
    LAS float* sc = (LAS float*)(F.lds + F.wave * 8704);
    for (int i = F.lane; i < 17 * 128; i += 64) { const int b = i / 128, k = i % 128; const float c = (b < 16) ? F.in[I_C][b * D + k0 + k] : F.in[I_CCTX][k0 + k]; sc[i] = c * fsigmoid(c); }
    LDS_WAIT(); asm volatile("" ::: "memory");
    const int col = cg * 256 + F.lane * 4;
    f32x4 acc[17];
#pragma unroll
    for (int b = 0; b < 17; ++b) acc[b] = (f32x4){0.f, 0.f, 0.f, 0.f};
    const float* W = F.in[I_ADAW] + (size_t)k0 * 12288 + col;
#pragma unroll 2
    for (int k = 0; k < 128; k += 4) {
        f32x4 w[4];
#pragma unroll
        for (int j = 0; j < 4; ++j) w[j] = *(const GAS f32x4*)(W + (size_t)(k + j) * 12288);
#pragma unroll
        for (int b = 0; b < 17; ++b) { const f32x4 s = *(const LAS f32x4*)(sc + b * 128 + k);
            acc[b] += s.x * w[0]; acc[b] += s.y * w[1]; acc[b] += s.z * w[2]; acc[b] += s.w * w[3]; }
    }
    __syncthreads();
    LAS f32x4* red = (LAS f32x4*)F.lds;
#pragma unroll
    for (int st = 4; st >= 1; st >>= 1) {
        if (F.wave >= st && F.wave < 2 * st) {
#pragma unroll
            for (int b = 0; b < 17; ++b) red[((F.wave - st) * 17 + b) * 64 + F.lane] = acc[b]; }
        __syncthreads();
        if (F.wave < st) {
#pragma unroll
            for (int b = 0; b < 17; ++b) acc[b] += red[(F.wave * 17 + b) * 64 + F.lane]; }
        __syncthreads();
    }
    if (F.wave == 0) { float* mp = wsp<float>(F, WS_MODACC) + (size_t)kh * 17 * 12288;
#pragma unroll
        for (int b = 0; b < 17; ++b) *(GAS f32x4*)(mp + (size_t)b * 12288 + col) = acc[b]; }
}
__device__ __forceinline__ f32x4 modv(const float* mp, const float* adab, int b, int idx) {
    return (*(const GAS f32x4*)(mp + (size_t)b * 12288 + idx) + *(const GAS f32x4*)(mp + (size_t)(17 + b) * 12288 + idx)) + *(const GAS f32x4*)(adab + idx);
}

__device__ __forceinline__ void p0_filter(Frame& F) {
    LAS float* hs = (LAS float*)(F.lds + 81920 + F.wave * 256);
    const int gw = F.bid * 8 + F.wave, NGW = F.G * 8, j = F.lane;
    const float freq = F.in[I_HFREQ][j];
    bf16* Gt = wsp<bf16>(F, WS_G);
    for (int t = gw; t < SEQ; t += NGW) {
        const float tl = (float)t * (1.0f / 2047.0f);
        float pre = F.in[I_HB1][j] + tl * F.in[I_HW1][j];
#pragma unroll 4
        for (int i = 0; i < 16; ++i) {
            const float band = 1e-4f + (float)i * ((15.0f - 1e-4f) / 15.0f);
            float rev = band * (float)t * (1.0f / 2048.0f); rev = rev - floorf(rev);
            const float cs = __builtin_amdgcn_cosf(rev), sn = __builtin_amdgcn_sinf(rev);
            pre += cs * F.in[I_HW1][(1 + i) * 64 + j] - sn * F.in[I_HW1][(17 + i) * 64 + j];
        }
        float h = __sinf(freq * pre);
        hs[j] = h; LDS_WAIT(); asm volatile("" ::: "memory");
        pre = F.in[I_HB2][j];
#pragma unroll 8
        for (int i = 0; i < 64; ++i) pre += hs[i] * F.in[I_HW2][i * 64 + j];
        h = __sinf(freq * pre);
        LDS_WAIT(); asm volatile("" ::: "memory");
        hs[j] = h; LDS_WAIT(); asm volatile("" ::: "memory");
        pre = F.in[I_HB3][j];
#pragma unroll 8
        for (int i = 0; i < 64; ++i) pre += hs[i] * F.in[I_HW3][i * 64 + j];
        h = __sinf(freq * pre);
        LDS_WAIT(); asm volatile("" ::: "memory");
        hs[j] = h; LDS_WAIT(); asm volatile("" ::: "memory");
        wsp<float>(F, WS_H3T)[(size_t)j * SEQ + t] = h;
        LDS_WAIT(); asm volatile("" ::: "memory");
    }
}
__device__ __forceinline__ void p1_filter_out(Frame& F) {
    LAS float* ws4 = (LAS float*)(F.lds + F.wave * 8192);
    const int gw = F.bid * 8 + F.wave, NGW = F.G * 8, lane = F.lane;
    const float* H3T = wsp<float>(F, WS_H3T); bf16* Gt = wsp<bf16>(F, WS_G);
    for (int u = gw; u < 64 * 32; u += NGW) {
        const int cb = u >> 5, tb = u & 31, c0 = 16 * cb, t = 64 * tb + lane;
#pragma unroll
        for (int k = 0; k < 8; ++k) { const int n = (k < 4) ? c0 + 4 * k : 1024 + c0 + 4 * (k - 4);
            *(LAS f32x4*)(ws4 + lane * 32 + 4 * k) = *(const GAS f32x4*)(F.in[I_HW4] + (size_t)lane * 2048 + n); }
        LDS_WAIT(); asm volatile("" ::: "memory");
        f32x4 o[8];
#pragma unroll
        for (int k = 0; k < 8; ++k) o[k] = (f32x4){0.f, 0.f, 0.f, 0.f};
#pragma unroll 1
        for (int ig = 0; ig < 8; ++ig) { float hh[8];
#pragma unroll
            for (int i = 0; i < 8; ++i) hh[i] = H3T[(size_t)(8 * ig + i) * SEQ + t];
#pragma unroll
            for (int i = 0; i < 8; ++i) {
#pragma unroll
                for (int k = 0; k < 8; ++k) o[k] += hh[i] * *(const LAS f32x4*)(ws4 + (8 * ig + i) * 32 + 4 * k); } }
        const float tl = (float)t * (1.0f / 2047.0f);
        const float dlo = -3.0701134573253945f, dhi = -15.350567286626973f;
#pragma unroll
        for (int k = 0; k < 8; ++k)
#pragma unroll
            for (int q = 0; q < 4; ++q) { const int c = c0 + 4 * (k & 3) + q;
                const float delta = fabsf(dlo + (dhi - dlo) * ((float)c * (1.0f / 1023.0f)));
                const float val = o[k][q] * __expf(-tl * delta);
                if (k < 4) Gt[(size_t)c * 4096 + (2048 - t)] = (bf16)f2bf(val);
                else if (t > 0) Gt[(size_t)c * 4096 + (2048 + t)] = (bf16)f2bf(val);
                else Gt[(size_t)c * 4096] = 0; }
        LDS_WAIT(); asm volatile("" ::: "memory");
    }
}

__device__ __forceinline__ void p1_norm1(Frame& F) {
    const int lane = F.lane;
    const float* macc = wsp<float>(F, WS_MODACC); const float* adab = F.in[I_ADAB];
    bf16* A1 = wsp<bf16>(F, WS_A1);
    constexpr int RPB = MROWS / 256; static_assert(RPB * 256 == MROWS && RPB == 144, "rows per workgroup");
    const int rbase = RPB * F.bid, blo = rbase < NLAT ? rbase / SEQ : 16;
    LAS float* TL = (LAS float*)(F.lds + 65536);
    { const int c = 4 * F.tid; const f32x4 g = *(const GAS f32x4*)(F.in[I_N1G] + c);
#pragma unroll
        for (int tb = 0; tb < 2; ++tb) { const int b = blo + tb < 16 ? blo + tb : 16;
            const f32x4 sh = modv(macc, adab, b, c), sc = modv(macc, adab, b, 2048 + c);
            *(LAS f32x4*)(TL + (tb * 2 + 0) * 2048 + c) = g * (1.0f + sc); *(LAS f32x4*)(TL + (tb * 2 + 1) * 2048 + c) = sh; } }
    __syncthreads();
    f32x4 va[2][8], vb[2][8];
#define N1_XROW(row) ((row) < NLAT ? F.in[I_X] + (size_t)(row) * D : F.in[I_CTX] + (size_t)((row) - NLAT) * D)
#define N1_LOAD(buf, it_) do { _Pragma("unroll") for (int r = 0; r < 2; ++r) { const int row = rbase + 8 * ((it_) + r) + F.wave; const float* xr = N1_XROW(row) + 8 * lane; \
        _Pragma("unroll") for (int j = 0; j < 4; ++j) { buf[r][2 * j] = *(const GAS f32x4*)(xr + 512 * j); buf[r][2 * j + 1] = *(const GAS f32x4*)(xr + 512 * j + 4); } } } while (0)
#define N1_PROC(buf, it_) do { _Pragma("unroll") for (int r = 0; r < 2; ++r) { const int row = rbase + 8 * ((it_) + r) + F.wave; const int b = row < NLAT ? row / SEQ : 16; \
        const LAS float* T0 = TL + (b - blo) * 4096 + 8 * lane; float ss = 0.f; \
        _Pragma("unroll") for (int j = 0; j < 8; ++j) ss += (buf[r][j].x * buf[r][j].x + buf[r][j].y * buf[r][j].y) + (buf[r][j].z * buf[r][j].z + buf[r][j].w * buf[r][j].w); \
        const float rstd = __builtin_amdgcn_rsqf(wave_sum(ss) * (1.0f / D) + 1e-6f); \
        _Pragma("unroll") for (int j = 0; j < 4; ++j) { \
            const f32x4 y0 = buf[r][2 * j] * rstd * *(const LAS f32x4*)(T0 + 512 * j) + *(const LAS f32x4*)(T0 + 2048 + 512 * j); \
            const f32x4 y1 = buf[r][2 * j + 1] * rstd * *(const LAS f32x4*)(T0 + 512 * j + 4) + *(const LAS f32x4*)(T0 + 2048 + 512 * j + 4); \
            v4u o; o.x = pk2(y0.x, y0.y); o.y = pk2(y0.z, y0.w); o.z = pk2(y1.x, y1.y); o.w = pk2(y1.z, y1.w); \
            *(GAS v4u*)(A1 + (size_t)row * D + 8 * lane + 512 * j) = o; } } } while (0)
    N1_LOAD(va, 0);
    for (int it = 0; it < 16; it += 4) { N1_LOAD(vb, it + 2); N1_PROC(va, it); N1_LOAD(va, it + 4); N1_PROC(vb, it + 2); }
    N1_PROC(va, 16);
#undef N1_XROW
#undef N1_LOAD
#undef N1_PROC
    if (F.bid < 16) { const int b = F.bid; float* T = wsp<float>(F, WS_MODT) + (size_t)b * 6144;
        for (int k = 4 * F.tid; k < D; k += 2048) { const f32x4 sh = modv(macc, adab, b, 3 * 2048 + k), sc = modv(macc, adab, b, 4 * 2048 + k);
            *(GAS f32x4*)(T + k) = *(const GAS f32x4*)(F.in[I_N2G] + k) * (1.0f + sc); *(GAS f32x4*)(T + 2048 + k) = sh; *(GAS f32x4*)(T + 4096 + k) = modv(macc, adab, b, 5 * 2048 + k); } }
}

namespace pg8 {
__device__ __forceinline__ void static_unit(int L, int nM, int nN, Unit& u) {
    const int nwg = nM * nN; int wgid = L;
    { const int q = nwg / NXCD, r = nwg % NXCD, xcd = wgid % NXCD, off = wgid / NXCD; wgid = (xcd < r ? xcd * (q + 1) : r * (q + 1) + (xcd - r) * q) + off; }
    const int nig = WGM * nN, gid = wgid / nig, fm = gid * WGM, gsz = (nM - fm) < WGM ? (nM - fm) : WGM;
    u.pm = fm + ((wgid % nig) % gsz); u.pn = (wgid % nig) / gsz; u.e = 0;
}
struct StaticOrder {
    int nM, nN, nwg, G, c;
    __device__ void init(int M, int N, int G_, int c_) { nM = M / BM; nN = N / BM; nwg = nM * nN; G = G_; c = c_; }
    __device__ __forceinline__ bool next(int i, Unit& u) const { const long L = (long)i * G + c; if (L >= nwg) return false; static_unit((int)L, nM, nN, u); return true; }
    __device__ __forceinline__ int arow(const Unit&, int) const { return 0; }
};
struct InProjOrder {
    int G, c;
    __device__ __forceinline__ bool next(int i, Unit& u) const {
        long L = (long)i * G + c;
        if (L < 128 * 26) { static_unit((int)L, 128, 26, u); return true; }
        L -= 128 * 26; if (L >= 16 * 13) return false;
        u.pm = 128 + (int)(L % 16); u.pn = 12 + (int)(L / 16); u.e = 0; return true;
    }
    __device__ __forceinline__ int arow(const Unit&, int) const { return 0; }
};
struct MoeOrder {
    int G, c, nN, ntiles; unsigned char* ws;
    __device__ __forceinline__ bool next(int i, Unit& u) const {
        const int x = c % 8, idx = c / 8, TR = 256 / nN, th = TR / 4, pw = nN / 2;
        u.pm = i * TR + (x >> 1) * th + idx / pw; u.pn = (x & 1) * pw + idx % pw;
        if (u.pm >= ntiles) return false;
        u.e = ((const int*)(ws + WS_ETAB))[256 + u.pm]; return true;
    }
    __device__ __forceinline__ int arow(const Unit& u, int r) const { const int* et = (const int*)(ws + WS_ETAB); const int row = u.pm * 256 + r; const bool valid = (row - et[u.e]) < et[64 + u.e]; return valid ? ((const int*)(ws + WS_ROWTOK))[row] : 0; }
};

struct EpiInProj {
    static constexpr bool PERM = true;
    bf16* Z; bf16* AP;
    __device__ __forceinline__ void operator()(const f32x4 (&acc)[2][2][4][2], const Unit& u, int wr, int wc, int fr, int fq) const {
        const int row0 = u.pm * BM + wr * 64 + fr;
        const bool lora = u.pn >= 24;
        bf16* base = lora ? AP + (u.pn - 24) * BM : Z + (size_t)u.pn * MROWS * 256; const int ldc = lora ? KLORA : 256;
        const int col0 = wc * 32 + 8 * fq;
#pragma unroll
        for (int ai = 0; ai < 2; ++ai)
#pragma unroll
            for (int m = 0; m < 4; ++m) { bf16* rowp = base + (size_t)(row0 + ai * HALF + m * 16) * ldc + col0;
#pragma unroll
                for (int bj = 0; bj < 2; ++bj) { f32x4 v0 = acc[ai][bj][m][0], v1 = acc[ai][bj][m][1];
                    if (lora) { const int act = (u.pn == 24) ? (bj == 0 ? 1 : 0) : (bj == 0 ? 2 : 0);
                        if (act == 1) {
#pragma unroll
                            for (int j = 0; j < 4; ++j) { v0[j] = ftanh(v0[j]); v1[j] = ftanh(v1[j]); } }
                        if (act == 2) {
#pragma unroll
                            for (int j = 0; j < 4; ++j) { v0[j] = fsigmoid(v0[j]); v1[j] = fsigmoid(v1[j]); } } }
                    v4u w; w.x = cvt_pk_bf16(v0[0], v0[1]); w.y = cvt_pk_bf16(v0[2], v0[3]); w.z = cvt_pk_bf16(v1[0], v1[1]); w.w = cvt_pk_bf16(v1[2], v1[3]);
                    *(v4u*)(rowp + bj * HALF) = w; } }
    }
};
struct EpiLora {
    static constexpr bool PERM = true;
    bf16* EA; const float* w0; const float* a0; int pn0;
    __device__ __forceinline__ void operator()(const f32x4 (&acc)[2][2][4][2], const Unit& u, int wr, int wc, int fr, int fq) const {
        const int pn = u.pn + pn0, row0 = u.pm * BM + wr * 64 + fr, col0 = pn * BM + wc * 32 + 8 * fq;
        const int blk = pn >> 2;
        const float* bias = blk < 2 ? w0 + col0 : (blk < 4 ? a0 + (col0 - 2048) : nullptr);
        const float scale = blk < 2 ? 0.60653065971263342f : 1.0f;
        f32x4 bv[2][2];
#pragma unroll
        for (int bj = 0; bj < 2; ++bj)
#pragma unroll
            for (int n = 0; n < 2; ++n) bv[bj][n] = bias ? *(const f32x4*)(bias + bj * HALF + 4 * n) : (f32x4){0.f, 0.f, 0.f, 0.f};
#pragma unroll
        for (int ai = 0; ai < 2; ++ai)
#pragma unroll
            for (int m = 0; m < 4; ++m) { bf16* rowp = EA + (size_t)(row0 + ai * HALF + m * 16) * NLORA + col0;
#pragma unroll
                for (int bj = 0; bj < 2; ++bj) { f32x4 v0 = acc[ai][bj][m][0] + bv[bj][0], v1 = acc[ai][bj][m][1] + bv[bj][1];
                    if (blk < 4) {
#pragma unroll
                        for (int j = 0; j < 4; ++j) { v0[j] = scale * fsigmoid(v0[j]); v1[j] = scale * fsigmoid(v1[j]); } }
                    v4u w; w.x = cvt_pk_bf16(v0[0], v0[1]); w.y = cvt_pk_bf16(v0[2], v0[3]); w.z = cvt_pk_bf16(v1[0], v1[1]); w.w = cvt_pk_bf16(v1[2], v1[3]);
                    *(v4u*)(rowp + bj * HALF) = w; } }
    }
};
struct EpiOutProj {
    static constexpr bool PERM = false;
    const float* X; bf16* X1; const float* macc; const float* adab; float* SSQ;
    __device__ __forceinline__ void operator()(const f32x4 (&acc)[2][2][4][2], const Unit& u, int wr, int wc, int fr, int fq) const {
        const int row0 = u.pm * BM + wr * 64 + fr, col0 = u.pn * BM + wc * 32 + 4 * fq;
        const int b = (u.pm * BM) / SEQ;
        f32x4 gv[2][2];
#pragma unroll
        for (int bj = 0; bj < 2; ++bj)
#pragma unroll
            for (int n = 0; n < 2; ++n) { const int c = col0 + bj * HALF + n * 16; gv[bj][n] = modv(macc, adab, b, 2 * 2048 + c) * (1.0f / 256.0f); }
#pragma unroll
        for (int ai = 0; ai < 2; ++ai) {
            f32x4 xq[4][2][2];
#pragma unroll
            for (int m = 0; m < 4; ++m) { const size_t off = (size_t)(row0 + ai * HALF + m * 16) * D + col0;
#pragma unroll
                for (int bj = 0; bj < 2; ++bj)
#pragma unroll
                    for (int n = 0; n < 2; ++n) xq[m][bj][n] = *(const f32x4*)(X + off + bj * HALF + n * 16); }
            asm volatile("" ::: "memory");
#pragma unroll
            for (int m = 0; m < 4; ++m) { const int row = row0 + ai * HALF + m * 16; const size_t off = (size_t)row * D + col0; float sq[2] = {0.f, 0.f};
#pragma unroll
                for (int bj = 0; bj < 2; ++bj)
#pragma unroll
                    for (int n = 0; n < 2; ++n) { const f32x4 xv = xq[m][bj][n]; const f32x4 o = xv + gv[bj][n] * acc[ai][bj][m][n]; { v2u ob; ob.x = pk2(o.x, o.y); ob.y = pk2(o.z, o.w); *(v2u*)(X1 + off + bj * HALF + n * 16) = ob; }
                        sq[bj] += (o.x * o.x + o.y * o.y) + (o.z * o.z + o.w * o.w); }
#pragma unroll
                for (int bj = 0; bj < 2; ++bj) { float t = sq[bj]; t += __shfl_xor(t, 16); t += __shfl_xor(t, 32); if (fq == 0) SSQ[(size_t)row * 64 + u.pn * 8 + bj * 4 + wc] = t; } } }
    }
};
__device__ __forceinline__ unsigned pk4_fp8(float a, float b, float c, float d) { int w = __builtin_amdgcn_cvt_pk_fp8_f32(a, b, 0, false); w = __builtin_amdgcn_cvt_pk_fp8_f32(c, d, w, true); return (unsigned)w; }
struct EpiSwiglu {
    static constexpr bool PERM = true;
    unsigned char* ws; const float* bg; const float* bu;
    __device__ __forceinline__ void operator()(const f32x4 (&acc)[2][2][4][2], const Unit& u, int wr, int wc, int fr, int fq) const {
        const int row0 = u.pm * BM + wr * 64 + fr, col0 = u.pn * HALF + wc * 32 + 8 * fq;
        const float* pg = bg + (size_t)u.e * 2048 + col0; const float* pu = bu + (size_t)u.e * 2048 + col0;
        f32x4 bgv[2], buv[2];
#pragma unroll
        for (int n = 0; n < 2; ++n) { bgv[n] = *(const f32x4*)(pg + 4 * n); buv[n] = *(const f32x4*)(pu + 4 * n); }
#pragma unroll
        for (int ai = 0; ai < 2; ++ai)
#pragma unroll
            for (int m = 0; m < 4; ++m) { unsigned char* rowp = ws + WS_ACT + (size_t)(row0 + ai * HALF + m * 16) * 2048 + col0; float o[8];
#pragma unroll
                for (int n = 0; n < 2; ++n) { const f32x4 gq = acc[ai][0][m][n] * (1.0f / 64.0f) + bgv[n], uq = acc[ai][1][m][n] * (1.0f / 64.0f) + buv[n];
#pragma unroll
                    for (int j = 0; j < 4; ++j) { const float gg = fminf(gq[j], 7.0f), uu = fminf(fmaxf(uq[j], -7.0f), 7.0f);
                        const float t = gg * __builtin_amdgcn_rcpf(1.0f + __builtin_amdgcn_exp2f(-2.4554669595930156f * gg));
                        o[4 * n + j] = __builtin_fmaf(uu, t, t); } }
                v2u w; w.x = pk4_fp8(o[0], o[1], o[2], o[3]); w.y = pk4_fp8(o[4], o[5], o[6], o[7]);
                *(v2u*)rowp = w; }
    }
};
struct EpiDown {
    static constexpr bool PERM = true;
    unsigned char* ws; const float* bd;
    __device__ __forceinline__ void operator()(const f32x4 (&acc)[2][2][4][2], const Unit& u, int wr, int wc, int fr, int fq) const {
        const int row0 = u.pm * BM + wr * 64 + fr, col0 = u.pn * BM + wc * 32 + 8 * fq;
        const float* pb = bd + (size_t)u.e * 2048 + col0;
        const int* et = (const int*)(ws + WS_ETAB); const int lim = et[u.e] + et[64 + u.e];
        const int* rowdst = (const int*)(ws + WS_ROWDST); const float* rowgate = (const float*)(ws + WS_ROWGATE); unsigned char* SLOT = ws + WS_SLOT;
        f32x4 bv[2][2];
#pragma unroll
        for (int bj = 0; bj < 2; ++bj)
#pragma unroll
            for (int n = 0; n < 2; ++n) bv[bj][n] = *(const f32x4*)(pb + bj * HALF + 4 * n);
        int dsts[8]; float gts[8];
#pragma unroll
        for (int i = 0; i < 8; ++i) { const int row = row0 + (i >> 2) * HALF + (i & 3) * 16, rc = row < lim ? row : lim - 1; dsts[i] = rowdst[rc]; gts[i] = 16.0f * rowgate[rc]; }
#pragma unroll
        for (int ai = 0; ai < 2; ++ai)
#pragma unroll
            for (int m = 0; m < 4; ++m) { const int row = row0 + ai * HALF + m * 16;
                if (row < lim) { const float gt = gts[ai * 4 + m]; unsigned char* rowp = SLOT + (size_t)dsts[ai * 4 + m] * 2048 + col0;
#pragma unroll
                    for (int bj = 0; bj < 2; ++bj) { const f32x4 v0 = (acc[ai][bj][m][0] * (1.0f / 64.0f) + bv[bj][0]) * gt, v1 = (acc[ai][bj][m][1] * (1.0f / 64.0f) + bv[bj][1]) * gt;
                        v2u w; w.x = pk4_fp8(v0[0], v0[1], v0[2], v0[3]); w.y = pk4_fp8(v1[0], v1[1], v1[2], v1[3]);
                        *(v2u*)(rowp + bj * HALF) = w; } } }
    }
};
}

__device__ __forceinline__ f32x4 unpk4(v2u w) { return (f32x4){bflo(w.x), bfhi(w.x), bflo(w.y), bfhi(w.y)}; }
__device__ __forceinline__ v2u pk4(f32x4 v) { v2u o; o.x = pk2(v.x, v.y); o.y = pk2(v.z, v.w); return o; }
__device__ __forceinline__ f32x4 ldz4(const bf16* p, bool ok) { return ok ? unpk4(*(const GAS v2u*)p) : (f32x4){0.f, 0.f, 0.f, 0.f}; }

__device__ __forceinline__ void p4_prep(Frame& F) {
    const int gw = F.bid * 8 + F.wave, NGW = F.G * 8, lane = F.lane;
    const bf16* Z = wsp<bf16>(F, WS_Z); const bf16* EA = wsp<bf16>(F, WS_EA); float* KI = wsp<float>(F, WS_KKINV); bf16* ZC = wsp<bf16>(F, WS_ZC);
    bf16* UT = wsp<bf16>(F, WS_UT); bf16* X0T = wsp<bf16>(F, WS_X0T); float* BS = wsp<float>(F, WS_BS);
    const float* cw = F.in[I_CONVW]; const float* cb = F.in[I_CONVB];
#define ZB(cblk, row) (Z + ((size_t)(cblk) * MROWS + (size_t)(row)) * 256 + 4 * lane)
    constexpr int NU_LAT = 16 * 64 * 8, NU = NU_LAT + 16 * 32 * 4;
    for (int u = gw; u < NU; u += NGW) {
        int b, t0, slice, ng8; bool lat;
        if (u < NU_LAT) { lat = true; const int w = u % 8, blk = u / 8, sp = blk % 4, cg = (blk / 4) % 16; b = blk / 64;
            t0 = (4 * cg + (w % 4)) * 32; slice = sp + 4 * (w / 4); ng8 = 4; }
        else { lat = false; const int v = u - NU_LAT; b = v / 128; t0 = ((v % 128) / 4) * 8; slice = 4 + (v % 4); ng8 = 1; }
        const int Ls = lat ? SEQ : CTXL, rowbase = lat ? b * SEQ : NLAT + b * CTXL;
        if (slice < 4) {
            const int c0 = 256 * slice + 4 * lane;
            f32x4 w[3][3], bi[3];
#pragma unroll
            for (int a = 0; a < 3; ++a) { bi[a] = *(const GAS f32x4*)(cb + a * 1024 + c0);
#pragma unroll
                for (int tp = 0; tp < 3; ++tp) w[a][tp] = *(const GAS f32x4*)(cw + (size_t)tp * PW + a * 1024 + c0); }
            f32x4 pv[3], cu[3];
#pragma unroll
            for (int a = 0; a < 3; ++a) { pv[a] = ldz4(ZB(a * 4 + slice, rowbase + t0 - 1), t0 > 0); cu[a] = ldz4(ZB(a * 4 + slice, rowbase + t0), true); }
            v2u raw[8][3];
#define PZ_LD(cblk, tt) (*(const GAS v2u*)ZB((cblk), rowbase + ((tt) < Ls ? (tt) : Ls - 1)))
#pragma unroll
            for (int i = 0; i < 8; ++i)
#pragma unroll
                for (int a = 0; a < 3; ++a) raw[i][a] = PZ_LD(a * 4 + slice, t0 + i + 1);
#define HY_GROUP(G8, REFILL) { float x0v[4][8], uv[4][8]; \
                _Pragma("unroll") for (int i = 0; i < 8; ++i) { const int t = t0 + 8 * (G8) + i; f32x4 zc[3]; \
                    _Pragma("unroll") for (int a = 0; a < 3; ++a) { f32x4 nx = unpk4(raw[i][a]); if (!(t + 1 < Ls)) nx = (f32x4){0.f, 0.f, 0.f, 0.f}; \
                        if (REFILL) raw[i][a] = PZ_LD(a * 4 + slice, t + 9); \
                        zc[a] = pv[a] * w[a][0] + cu[a] * w[a][1] + nx * w[a][2] + bi[a]; pv[a] = cu[a]; cu[a] = nx; } \
                    const f32x4 uu = zc[2] * zc[1]; \
                    _Pragma("unroll") for (int j = 0; j < 4; ++j) { x0v[j][i] = zc[0][j]; uv[j][i] = uu[j]; } } \
                _Pragma("unroll") for (int j = 0; j < 4; ++j) { const size_t o = ((size_t)(c0 + j) * 16 + b) * SEQ + t0 + 8 * (G8); \
                    v4u a, c; a.x = pk2(x0v[j][0], x0v[j][1]); a.y = pk2(x0v[j][2], x0v[j][3]); a.z = pk2(x0v[j][4], x0v[j][5]); a.w = pk2(x0v[j][6], x0v[j][7]); \
                    c.x = pk2(uv[j][0], uv[j][1]); c.y = pk2(uv[j][2], uv[j][3]); c.z = pk2(uv[j][4], uv[j][5]); c.w = pk2(uv[j][6], uv[j][7]); \
                    *(GAS v4u*)(X0T + o) = a; *(GAS v4u*)(UT + o) = c; } }
            for (int g8 = 0; g8 < 3; ++g8) HY_GROUP(g8, true)
            HY_GROUP(3, false)
#undef HY_GROUP
        } else {
            const int q = slice - 4, c0 = 256 * q + 4 * lane;
            f32x4 w[3][3], bi[3];
#pragma unroll
            for (int a = 0; a < 3; ++a) { bi[a] = *(const GAS f32x4*)(cb + 3072 + a * 1024 + c0);
#pragma unroll
                for (int tp = 0; tp < 3; ++tp) w[a][tp] = *(const GAS f32x4*)(cw + (size_t)tp * PW + 3072 + a * 1024 + c0); }
            const f32x4 kkw = *(const GAS f32x4*)(F.in[I_RKK] + c0), kaw = *(const GAS f32x4*)(F.in[I_RKA] + c0), rkw = *(const GAS f32x4*)(F.in[I_RRK] + c0);
            f32x4 pv[3], cu[3];
#pragma unroll
            for (int a = 0; a < 3; ++a) { pv[a] = ldz4(ZB(12 + a * 4 + q, rowbase + t0 - 1), t0 > 0); cu[a] = ldz4(ZB(12 + a * 4 + q, rowbase + t0), true); }
            v2u raw[8][3], ra[8][2];
#pragma unroll
            for (int i = 0; i < 8; ++i) { const bf16* ep = EA + (size_t)(rowbase + t0 + i) * NLORA + 2048 + c0;
#pragma unroll
                for (int a = 0; a < 3; ++a) raw[i][a] = PZ_LD(12 + a * 4 + q, t0 + i + 1);
                ra[i][0] = *(const GAS v2u*)ep; ra[i][1] = *(const GAS v2u*)(ep + 1024); }
#define RW_GROUP(G8, REFILL) { \
                _Pragma("unroll") for (int i = 0; i < 8; ++i) { const int t = t0 + 8 * (G8) + i, row = rowbase + t; f32x4 zc[3]; \
                    _Pragma("unroll") for (int a = 0; a < 3; ++a) { f32x4 nx = unpk4(raw[i][a]); if (!(t + 1 < Ls)) nx = (f32x4){0.f, 0.f, 0.f, 0.f}; \
                        if (REFILL) raw[i][a] = PZ_LD(12 + a * 4 + q, t + 9); \
                        zc[a] = pv[a] * w[a][0] + cu[a] * w[a][1] + nx * w[a][2] + bi[a]; pv[a] = cu[a]; cu[a] = nx; } \
                    const f32x4 a0 = unpk4(ra[i][0]), a1 = unpk4(ra[i][1]); \
                    if (REFILL) { const bf16* ep = EA + (size_t)(row + 8) * NLORA + 2048 + c0; ra[i][0] = *(const GAS v2u*)ep; ra[i][1] = *(const GAS v2u*)(ep + 1024); } \
                    const f32x4 zr = zc[0], zk = zc[1]; \
                    const f32x4 kk = zk * kkw; \
                    const float n2 = row16_sum((kk.x * kk.x + kk.y * kk.y) + (kk.z * kk.z + kk.w * kk.w)); \
                    const float inv = 1.0f / fmaxf(sqrtf(n2), 1e-12f); \
                    const f32x4 bt = zr * zk * (2.0f + (a0 + a1 - 2.0f) * kaw) * rkw; \
                    const float bsum = row16_sum((bt.x + bt.y) + (bt.z + bt.w)); \
                    bf16* zo = ZC + ((size_t)(4 * q + (lane >> 4)) * MROWS + row) * 192 + 4 * (lane & 15);         \
                    *(GAS v2u*)(zo) = pk4(zr); *(GAS v2u*)(zo + 64) = pk4(zk); *(GAS v2u*)(zo + 128) = pk4(zc[2]); \
                    if ((lane & 15) == 0) { KI[(size_t)row * 16 + 4 * q + (lane >> 4)] = inv; if (lat) BS[(size_t)row * 16 + 4 * q + (lane >> 4)] = bsum; } } }
            for (int g8 = 0; g8 < ng8 - 1; ++g8) RW_GROUP(g8, true)
            RW_GROUP(ng8 - 1, false)
#undef RW_GROUP
#undef PZ_LD
        }
    }
}
#undef ZB

typedef short bf16x4 __attribute__((ext_vector_type(4)));
__device__ __forceinline__ int scan_row(int s, int dir, int b) {
    return s < CTXL ? NLAT + b * CTXL + (dir ? CTXL - 1 - s : s) : b * SEQ + (dir ? SEQ - 1 - (s - CTXL) : (s - CTXL));
}
__device__ __forceinline__ bf16x4 pack4(f32x4 v) { v2u o; o.x = pk2(v.x, v.y); o.y = pk2(v.z, v.w); return __builtin_bit_cast(bf16x4, o); }
__device__ __forceinline__ bf16x8 cat8(bf16x4 a, bf16x4 b) { return __builtin_shufflevector(a, b, 0, 1, 2, 3, 4, 5, 6, 7); }
#define MF16(a, b, c) __builtin_amdgcn_mfma_f32_16x16x32_bf16(cat8((a), (bf16x4){0, 0, 0, 0}), cat8((b), (bf16x4){0, 0, 0, 0}), (c), 0, 0, 0)
#define MF32(a, b, c) __builtin_amdgcn_mfma_f32_16x16x32_bf16((a), (b), (c), 0, 0, 0)
template <int CTRL> __device__ __forceinline__ float dpp_shr0(float x) { return __builtin_bit_cast(float, __builtin_amdgcn_update_dpp(0, __builtin_bit_cast(int, x), CTRL, 0xF, 0xF, true)); }
__device__ __forceinline__ float row16_incl_scan(float x) { x += dpp_shr0<0x111>(x); x += dpp_shr0<0x112>(x); x += dpp_shr0<0x114>(x); x += dpp_shr0<0x118>(x); return x; }
constexpr int SC_AT = 0, SC_RT = 2304, SC_BT = 4608, SC_KT = 6912, SC_BHT = 9216, SC_KHT = 11264, SC_VT = 13312, SC_GC = 15360, SC_BUF = 15616, SC_CW = 2 * SC_BUF, SC_CHAIN = 2 * SC_BUF + 14 * 256;
#define SCAN_BODY(CKX, ldcur, ldnext) { const int ck = (CKX); const int p = ck & 1; if (ck + 3 < NCK) SCAN_ISSUE(ldcur, ck + 3); \
            ConvItem cvi; cvi.src = nullptr; cvi.dst = nullptr; const bool cvon = ck < NCONV; if (cvon) { cvi = conv_item(F, gwv + ck * NGWV); conv_issue_m(cvi, cv, lane); } \
            const LAS unsigned char* d = cb + p * SC_BUF; \
            bf16x8 Af[2], Rf[2], Bf[2], Kf[2]; \
_Pragma("unroll") \
            for (int m = 0; m < 2; ++m) { const int o = lr * 144 + m * 64 + q * 16; \
                Af[m] = *(const LAS bf16x8*)(d + SC_AT + o); Rf[m] = *(const LAS bf16x8*)(d + SC_RT + o); Bf[m] = *(const LAS bf16x8*)(d + SC_BT + o); Kf[m] = *(const LAS bf16x8*)(d + SC_KT + o); } \
            const bf16x4 Vf = *(const LAS bf16x4*)(d + SC_VT + (16 * w4 + lr) * 32 + 8 * q); \
            f32x4 GabT = MF32(Bf[0], Af[0], zero4); GabT = MF32(Bf[1], Af[1], GabT); \
            f32x4 Gab = MF32(Af[0], Bf[0], zero4); Gab = MF32(Af[1], Bf[1], Gab); \
            f32x4 GakT = MF32(Kf[0], Af[0], zero4); GakT = MF32(Kf[1], Af[1], GakT); \
            f32x4 GrbT = MF32(Bf[0], Rf[0], zero4); GrbT = MF32(Bf[1], Rf[1], GrbT); \
            f32x4 GrkT = MF32(Kf[0], Rf[0], zero4); GrkT = MF32(Kf[1], Rf[1], GrkT); \
_Pragma("unroll") \
            for (int j = 0; j < 4; ++j) { const int i = 4 * q + j; \
                GabT[j] = (i < lr) ? GabT[j] : 0.f; GakT[j] = (i < lr) ? GakT[j] : 0.f; GrbT[j] = (i <= lr) ? GrbT[j] : 0.f; GrkT[j] = (i <= lr) ? GrkT[j] : 0.f; \
                Gab[j] = (lr < i) ? Gab[j] : 0.f; } \
            const bf16x4 LakA = pack4(GakT), LrbA = pack4(GrbT), LrkA = pack4(GrkT); \
            f32x4 X = GabT, Y = Gab, Tt = GabT; \
_Pragma("unroll") \
            for (int j = 0; j < 4; ++j) Tt[j] += (4 * q + j == lr) ? 1.0f : 0.f; \
_Pragma("unroll") \
            for (int lv = 0; lv < 3; ++lv) { const bf16x4 x = pack4(X), y = pack4(Y); \
                const f32x4 Y2 = MF16(x, y, zero4), X2 = MF16(y, x, zero4); \
                Tt = MF16(pack4(Y2), pack4(Tt), Tt); \
                X = X2; Y = Y2; } \
            const bf16x4 TinvA = pack4(Tt); \
            bf16x4 Sb[4]; \
_Pragma("unroll") \
            for (int kb = 0; kb < 4; ++kb) Sb[kb] = pack4(ST[kb]); \
            const bf16x8 SB0 = cat8(Sb[0], Sb[1]), SB1 = cat8(Sb[2], Sb[3]); \
            f32x4 W = MF16(LakA, Vf, zero4); W = MF32(Af[0], SB0, W); W = MF32(Af[1], SB1, W); \
            const f32x4 U = MF16(TinvA, pack4(W), zero4); \
            const bf16x4 Ub = pack4(U); \
            f32x4 Yt = MF16(LrkA, Vf, zero4); Yt = MF32(Rf[0], SB0, Yt); Yt = MF32(Rf[1], SB1, Yt); Yt = MF16(LrbA, Ub, Yt); \
_Pragma("unroll") \
            for (int kb = 0; kb < 4; ++kb) { const f32x4 g = *(const LAS f32x4*)(d + SC_GC + (16 * kb + 4 * q) * 4); \
                const bf16x4 bh = *(const LAS bf16x4*)(d + SC_BHT + (16 * kb + lr) * 32 + 8 * q), kh = *(const LAS bf16x4*)(d + SC_KHT + (16 * kb + lr) * 32 + 8 * q); \
                f32x4 s = ST[kb] * g; s = MF16(bh, Ub, s); s = MF16(kh, Vf, s); ST[kb] = s; } \
            if (ck >= CTXL / 16) { \
_Pragma("unroll") \
                for (int j = 0; j < 4; ++j) { const unsigned row = (unsigned)scan_row(ck * 16 + 4 * q + j, dir, b); *(GAS float*)((char*)YS + (((unsigned)dir * NLAT + row) * 4096u + 4u * (unsigned)(h * 64 + 16 * w4 + lr))) = Yt[j]; } } \
            if (cvon) conv_finish_m(cvi, cv, csel, lane); \
            if (ck + 1 < NCK) SCAN_COMMIT(ldnext, p ^ 1); \
            __syncthreads(); }
__device__ __forceinline__ void p5_scan(Frame& F) {
    const int cwv = F.wave >> 2, w4 = F.wave & 3, lane = F.lane, tc = F.tid & 255, q = lane >> 4, lr = lane & 15;
    const bf16* ZC = wsp<bf16>(F, WS_ZC); const bf16* EA = wsp<bf16>(F, WS_EA); const float* KI = wsp<float>(F, WS_KKINV); float* YS = wsp<float>(F, WS_YS);
    for (int cp = F.bid; cp < 256; cp += F.G) {
        const int chain = cp * 2 + cwv, dir = chain >> 8, b = (chain >> 4) & 15, h = chain & 15;
        LAS unsigned char* cb = F.lds + cwv * SC_CHAIN;
        const int sl = lr, jc = 4 * w4 + q, coff = h * 64 + 4 * jc;
        const int ppos = 32 * (jc >> 3) + 8 * (jc & 3) + 4 * ((jc >> 2) & 1);
        v2u ld0[6], ld1[6], ld2[6];
#define SCAN_ISSUE(ld, ck_) do { const unsigned row_ = (unsigned)scan_row((ck_) * 16 + sl, dir, b); const char* zp_ = (const char*)ZC + (((unsigned)h * MROWS + row_) * 384u + 8u * (unsigned)jc); \
            ld[0] = *(const GAS v2u*)(zp_); ld[1] = *(const GAS v2u*)(zp_ + 128); ld[2] = *(const GAS v2u*)(zp_ + 256); \
            const char* ep_ = (const char*)EA + (row_ * (2u * NLORA) + 2u * (unsigned)(dir * 1024 + coff)); \
            ld[3] = *(const GAS v2u*)(ep_); ld[4] = *(const GAS v2u*)(ep_ + 4096); \
            ld[5].x = *(const GAS unsigned*)((const char*)KI + (row_ * 64u + 4u * (unsigned)h)); ld[5].y = 0u; } while (0)
#define SCAN_COMMIT(ld, p_) do { LAS unsigned char* d_ = cb + (p_) * SC_BUF; const LAS f32x4* cw_ = (const LAS f32x4*)(cb + SC_CW) + jc; \
            const f32x4 r_ = unpk4(ld[0]), zk_ = unpk4(ld[1]), v_ = unpk4(ld[2]); \
            const f32x4 e_ = unpk4(ld[3]), as_ = unpk4(ld[4]); const float inv_ = __builtin_bit_cast(float, ld[5].x); \
            const f32x4 kk_ = zk_ * cw_[0] * inv_, kd_ = zk_ * (1.0f + (as_ - 1.0f) * cw_[16]), b_ = kk_ * as_; \
            f32x4 Ei_, Et_; \
            _Pragma("unroll") for (int i_ = 0; i_ < 4; ++i_) { Ei_[i_] = row16_incl_scan(e_[i_]); Et_[i_] = row16_sum(e_[i_]); } \
            f32x4 gin_, gex_, ginv_, grem_; \
            _Pragma("unroll") for (int i_ = 0; i_ < 4; ++i_) { gin_[i_] = __expf(-Ei_[i_]); gex_[i_] = __expf(e_[i_] - Ei_[i_]); ginv_[i_] = __expf(Ei_[i_]); grem_[i_] = __expf(Ei_[i_] - Et_[i_]); } \
            *(LAS v2u*)(d_ + SC_AT + sl * 144 + 2 * ppos) = pk4(-kk_ * gex_); \
            *(LAS v2u*)(d_ + SC_RT + sl * 144 + 2 * ppos) = pk4(r_ * gin_); \
            *(LAS v2u*)(d_ + SC_BT + sl * 144 + 2 * ppos) = pk4(b_ * ginv_); \
            *(LAS v2u*)(d_ + SC_KT + sl * 144 + 2 * ppos) = pk4(kd_ * ginv_); \
            const f32x4 bh_ = b_ * grem_, kh_ = kd_ * grem_; \
            _Pragma("unroll") for (int i_ = 0; i_ < 4; ++i_) { \
                *(LAS bf16*)(d_ + SC_BHT + (4 * jc + i_) * 32 + 2 * sl) = (bf16)f2bf(bh_[i_]); \
                *(LAS bf16*)(d_ + SC_KHT + (4 * jc + i_) * 32 + 2 * sl) = (bf16)f2bf(kh_[i_]); \
                *(LAS bf16*)(d_ + SC_VT + (4 * jc + i_) * 32 + 2 * sl) = (bf16)f2bf(v_[i_]); } \
            if (sl == 0) *(LAS f32x4*)(d_ + SC_GC + 16 * jc) = (f32x4){__expf(-Et_.x), __expf(-Et_.y), __expf(-Et_.z), __expf(-Et_.w)}; } while (0)
        if (tc < 32) { const int a_ = tc >> 4, j_ = tc & 15; ((LAS f32x4*)(cb + SC_CW))[a_ * 16 + j_] = *(const GAS f32x4*)(F.in[a_ == 0 ? I_RKK : I_RKA] + h * 64 + 4 * j_); }
        __syncthreads();
        f32x4 cv[8]; const ConvSel csel = conv_sel(lane); LAS float* cscr = (LAS float*)(F.lds + 2 * SC_CHAIN + F.wave * 8448); const int gwv = F.bid * 8 + F.wave, NGWV = F.G * 8;
        constexpr int NCONV = NE * 6144 / 2048; static_assert(NCONV <= (CTXL + SEQ) / 16, "one expert-weight item per chunk");
        f32x4 ST[4];
#pragma unroll
        for (int i = 0; i < 4; ++i) ST[i] = (f32x4){0.f, 0.f, 0.f, 0.f};
        SCAN_ISSUE(ld0, 0); SCAN_ISSUE(ld1, 1); SCAN_ISSUE(ld2, 2); SCAN_COMMIT(ld0, 0); __syncthreads();
        constexpr int NCK = (CTXL + SEQ) / 16; static_assert(NCK % 3 == 0, "chunk loop unrolled by 3");
        const f32x4 zero4 = (f32x4){0.f, 0.f, 0.f, 0.f};
        for (int ck3 = 0; ck3 < NCK; ck3 += 3) { SCAN_BODY(ck3, ld0, ld1) SCAN_BODY(ck3 + 1, ld1, ld2) SCAN_BODY(ck3 + 2, ld2, ld0) }
    }
}

constexpr int HY_UROW = 4128, HY_GOFF = 16 * HY_UROW, HY_CS = 8208;
__device__ __forceinline__ void p6_hyena(Frame& F) {
    const int lane = F.lane, tl = lane & 15, q = lane >> 4, wave = F.wave, tid = F.tid;
    const bf16* UT = wsp<bf16>(F, WS_UT); const bf16* Gt = wsp<bf16>(F, WS_G); bf16* YCT = wsp<bf16>(F, WS_YCT);
    LAS unsigned char* lds = F.lds;
    const int r = (8 - (tl & 7)) & 7;
    const int abase = HY_GOFF + r * HY_CS + 2 * (2048 + 8 * q - (tl + r)) - 32 * (16 * wave);
    const int bbase = tl * HY_UROW + 16 * q;
    for (int c = F.bid; c < 1024; c += F.G) {
#pragma unroll
        for (int i = 0; i < 8; ++i) { const int id = tid + 512 * i, bb = id >> 8, ch = id & 255;
            const v4u v = *(const GAS v4u*)(UT + ((size_t)c * 16 + bb) * SEQ + 8 * ch); *(LAS v4u*)(lds + bb * HY_UROW + 16 * ch) = v; }
        { const v4u v = *(const GAS v4u*)(Gt + (size_t)c * 4096 + 8 * tid); *(LAS v4u*)(lds + HY_GOFF + 16 * tid) = v; }
        __syncthreads();
        { unsigned d[8]; const v4u lo = *(const LAS v4u*)(lds + HY_GOFF + 16 * tid); const v4u hi = tid < 511 ? *(const LAS v4u*)(lds + HY_GOFF + 16 * tid + 16) : (v4u){0u, 0u, 0u, 0u};
            d[0] = lo.x; d[1] = lo.y; d[2] = lo.z; d[3] = lo.w; d[4] = hi.x; d[5] = hi.y; d[6] = hi.z; d[7] = hi.w;
#pragma unroll
            for (int rr = 1; rr < 8; ++rr) { v4u o;
                if ((rr & 1) == 0) { o.x = d[rr / 2]; o.y = d[rr / 2 + 1]; o.z = d[rr / 2 + 2]; o.w = d[rr / 2 + 3]; }
                else { const int e = (rr - 1) / 2; o.x = __builtin_amdgcn_alignbit(d[e + 1], d[e], 16); o.y = __builtin_amdgcn_alignbit(d[e + 2], d[e + 1], 16);
                       o.z = __builtin_amdgcn_alignbit(d[e + 3], d[e + 2], 16); o.w = __builtin_amdgcn_alignbit(d[e + 4], d[e + 3], 16); }
                *(LAS v4u*)(lds + HY_GOFF + rr * HY_CS + 16 * tid) = o; } }
        __syncthreads();
        f32x4 acc[16]; bf16x8 P[16];
#pragma unroll
        for (int it = 0; it < 16; ++it) acc[it] = (f32x4){0.f, 0.f, 0.f, 0.f};
#pragma unroll
        for (int it = 2; it < 16; ++it) P[it] = *(const LAS bf16x8*)(lds + abase - 32 * it);
        for (int i8 = 0; i8 < 8; ++i8) {
#pragma unroll
            for (int u = 0; u < 8; ++u) {
                const int isb = i8 * 8 + u;
                const bf16x8 bf = *(const LAS bf16x8*)(lds + bbase + 64 * isb);
                P[(16 - 2 * u) & 15] = *(const LAS bf16x8*)(lds + abase + 64 * isb);
                P[(17 - 2 * u) & 15] = *(const LAS bf16x8*)(lds + abase + 64 * isb - 32);
#pragma unroll
                for (int k = 0; k < 16; ++k) { const int it = (k + 2) & 15;
                    acc[it] = __builtin_amdgcn_mfma_f32_16x16x32_bf16(P[(it - 2 * u) & 15], bf, acc[it], 0, 0, 0); }
            }
        }
#pragma unroll
        for (int it = 0; it < 16; ++it) { v2u o; o.x = pk2(acc[it].x, acc[it].y); o.y = pk2(acc[it].z, acc[it].w);
            *(GAS v2u*)(YCT + ((size_t)c * 16 + tl) * SEQ + 256 * wave + 16 * it + 4 * q) = o; }
        __syncthreads();
    }
}

__device__ __forceinline__ void p7_assemble(Frame& F) {
    const int gw = F.bid * 8 + F.wave, NGW = F.G * 8, lane = F.lane;
    unsigned char* A2 = wsp<unsigned char>(F, WS_A2);
    const bf16* YCT = wsp<bf16>(F, WS_YCT); const bf16* X0T = wsp<bf16>(F, WS_X0T); const bf16* UT = wsp<bf16>(F, WS_UT);
    const float* YS = wsp<float>(F, WS_YS); const float* BS = wsp<float>(F, WS_BS); const bf16* ZC = wsp<bf16>(F, WS_ZC); const bf16* EA = wsp<bf16>(F, WS_EA);
    LAS unsigned char* tile = F.lds + F.wave * 9216;
    constexpr int NU_H = 16 * 32 * 16, NU = NU_H + (NLAT / 16) * 4;
    for (int u = gw; u < NU; u += NGW) {
        if (u < NU_H) {
            const int b = u / 512, rem = u % 512, tb = rem / 16, g = rem % 16, ci = lane >> 3, tq = lane & 7;
            float val[8][8]; float ss[8];
#pragma unroll
            for (int k = 0; k < 8; ++k) ss[k] = 0.f;
#pragma unroll
            for (int i = 0; i < 8; ++i) { const int ch = g * 64 + 8 * ci + i; const size_t o = ((size_t)ch * 16 + b) * SEQ + 64 * tb + 8 * tq;
                const v4u yc = *(const GAS v4u*)(YCT + o), x0 = *(const GAS v4u*)(X0T + o), uu = *(const GAS v4u*)(UT + o); const float bias = F.in[I_HBIAS][ch];
                const unsigned ycw[4] = {yc.x, yc.y, yc.z, yc.w}, x0w[4] = {x0.x, x0.y, x0.z, x0.w}, uw[4] = {uu.x, uu.y, uu.z, uu.w};
#pragma unroll
                for (int k = 0; k < 4; ++k) { const float v0 = bflo(x0w[k]) * (bflo(ycw[k]) + bias * bflo(uw[k])), v1 = bfhi(x0w[k]) * (bfhi(ycw[k]) + bias * bfhi(uw[k]));
                    val[i][2 * k] = v0; val[i][2 * k + 1] = v1; ss[2 * k] += v0 * v0; ss[2 * k + 1] += v1 * v1; } }
#pragma unroll
            for (int k = 0; k < 8; ++k) { float s = ss[k]; s += __shfl_xor(s, 8); s += __shfl_xor(s, 16); s += __shfl_xor(s, 32); ss[k] = 1.0f / sqrtf(s * (1.0f / 64.0f) + 1e-6f); }
            float ng[8];
#pragma unroll
            for (int i = 0; i < 8; ++i) ng[i] = 4.0f * F.in[I_HNG][g * 64 + 8 * ci + i];
#pragma unroll
            for (int k = 0; k < 8; ++k) { v2u o; o.x = pg8::pk4_fp8(val[0][k] * ss[k] * ng[0], val[1][k] * ss[k] * ng[1], val[2][k] * ss[k] * ng[2], val[3][k] * ss[k] * ng[3]);
                o.y = pg8::pk4_fp8(val[4][k] * ss[k] * ng[4], val[5][k] * ss[k] * ng[5], val[6][k] * ss[k] * ng[6], val[7][k] * ss[k] * ng[7]);
                *(LAS v2u*)(tile + (8 * tq + k) * 72 + 8 * ci) = o; }
            LDS_WAIT(); asm volatile("" ::: "memory");
#pragma unroll
            for (int i = 0; i < 8; ++i) { const int t = (lane >> 3) + 8 * i, pc = lane & 7; const v2u o = *(const LAS v2u*)(tile + t * 72 + 8 * pc);
                *(GAS v2u*)(A2 + (size_t)(b * SEQ + 64 * tb + t) * D + g * 64 + 8 * pc) = o; }
            LDS_WAIT(); asm volatile("" ::: "memory");
        } else {
            const int v = u - NU_H, tk = v / 4, q = v % 4, c0 = 256 * q + 4 * lane;
            const f32x4 lg = *(const GAS f32x4*)(F.in[I_LNG] + c0), lb = *(const GAS f32x4*)(F.in[I_LNB] + c0);
            for (int i8 = 0; i8 < 16; i8 += 8) {
                f32x4 ya[8], yb[8]; v2u vr[8], gr[8]; float bs[8];
#pragma unroll
                for (int r = 0; r < 8; ++r) { const int row = tk * 16 + i8 + r;
                    ya[r] = *(const GAS f32x4*)(YS + (size_t)row * 1024 + c0); yb[r] = *(const GAS f32x4*)(YS + ((size_t)NLAT + row) * 1024 + c0);
                    vr[r] = *(const GAS v2u*)(ZC + ((size_t)(4 * q + (lane >> 4)) * MROWS + row) * 192 + 128 + 4 * (lane & 15)); gr[r] = *(const GAS v2u*)(EA + (size_t)row * NLORA + 4096 + c0);
                    bs[r] = BS[(size_t)row * 16 + 4 * q + (lane >> 4)]; }
                asm volatile("" ::: "memory");
#pragma unroll
                for (int r = 0; r < 8; ++r) { const int row = tk * 16 + i8 + r;
                    const f32x4 y = ya[r] + yb[r];
                    const float mu = row16_sum((y.x + y.y) + (y.z + y.w)) * (1.0f / 64.0f);
                    const f32x4 d = y - mu;
                    const float var = row16_sum((d.x * d.x + d.y * d.y) + (d.z * d.z + d.w * d.w)) * (1.0f / 64.0f);
                    const float rs = __builtin_amdgcn_rsqf(var + 64e-5f);
                    const f32x4 vv = unpk4(vr[r]), gt = unpk4(gr[r]);
                    const f32x4 o = (d * rs * lg + lb + bs[r] * vv) * gt;
                    *(GAS unsigned*)(A2 + (size_t)row * D + 1024 + c0) = pg8::pk4_fp8(4.0f * o.x, 4.0f * o.y, 4.0f * o.z, 4.0f * o.w); } }
        }
    }
}

__device__ __forceinline__ void p9_router(Frame& F) {
    const int lane = F.lane, rw = lane & 15, q = lane >> 4, wave = F.wave;
    const bf16* X1 = wsp<bf16>(F, WS_X1B); const float* MT = wsp<float>(F, WS_MODT); unsigned char* H2 = wsp<unsigned char>(F, WS_H2); const bf16* Wr = wsp<bf16>(F, WS_WR);
    int* TOKE = wsp<int>(F, WS_TOKE); float* TOKG = wsp<float>(F, WS_TOKG); int* WCNT = wsp<int>(F, WS_WCNT); int* BCNT = wsp<int>(F, WS_BCNT);
    LAS float* lg = (LAS float*)(F.lds + wave * 2048);
    LAS int* wc = (LAS int*)(F.lds + 16384 + wave * 128);
    {
        const int gw = F.bid * 8 + wave, tok0 = gw * 16, token = tok0 + rw, b = token / SEQ;
        const bf16* xr = X1 + (size_t)token * D + 8 * q;
        float ss = 0.f;
        { const float* sp = wsp<float>(F, WS_SSQ) + (size_t)token * 64 + 16 * q;
#pragma unroll
            for (int i = 0; i < 4; ++i) { const f32x4 a = *(const GAS f32x4*)(sp + 4 * i); ss += (a.x + a.y) + (a.z + a.w); } }
        ss += __shfl_xor(ss, 16); ss += __shfl_xor(ss, 32);
        const float rstd = 1.0f / sqrtf(ss * (1.0f / D) + 1e-6f);
        LAS float* TB = (LAS float*)(F.lds + 32768);
#pragma unroll
        for (int k = 0; k < 2; ++k) { const int idx = F.tid + 512 * k; *(LAS f32x4*)(TB + 4 * idx) = *(const GAS f32x4*)(MT + (size_t)b * 6144 + 4 * idx); }
        __syncthreads();
        f32x4 acc[2] = {(f32x4){0.f, 0.f, 0.f, 0.f}, (f32x4){0.f, 0.f, 0.f, 0.f}};
        v4u X0, X1r, X2, X3; bf16x8 W0[4], W1[4], W2[4], W3[4];
#define RT_LDX(buf, ks_) do { buf = *(const GAS v4u*)(xr + 32 * (ks_)); } while (0)
#define RT_LDW(buf, ks_) do { _Pragma("unroll") for (int nb = 0; nb < 2; ++nb) { const bf16* wp = Wr + (size_t)(16 * nb + rw) * D + 32 * (ks_) + 8 * q; \
            buf[2 * nb] = *(const GAS bf16x8*)wp; buf[2 * nb + 1] = *(const GAS bf16x8*)(wp + 32 * D); } } while (0)
#define RT_STEP(xc, xn, wcur, wnx, ks_) do { const int ks = (ks_); { RT_LDW(wnx, (ks + 3) & 63); RT_LDX(xn, (ks + 3) & 63); } \
            const LAS float* tp = TB + 32 * ks + 8 * q; \
            const f32x4 ma = *(const LAS f32x4*)tp, mb = *(const LAS f32x4*)(tp + 4), sa = *(const LAS f32x4*)(tp + 2048), sb = *(const LAS f32x4*)(tp + 2052); \
            const f32x4 xa = (f32x4){bflo(xc.x), bfhi(xc.x), bflo(xc.y), bfhi(xc.y)}, xb = (f32x4){bflo(xc.z), bfhi(xc.z), bflo(xc.w), bfhi(xc.w)}; \
            const f32x4 ha = xa * rstd * ma + sa, hb = xb * rstd * mb + sb; \
            const float hv[8] = {ha.x, ha.y, ha.z, ha.w, hb.x, hb.y, hb.z, hb.w}; \
            unsigned ph[4], pl[4]; \
            _Pragma("unroll") for (int p_ = 0; p_ < 4; ++p_) { ph[p_] = pk2(hv[2 * p_], hv[2 * p_ + 1]); \
                pl[p_] = pk2(hv[2 * p_] - __builtin_bit_cast(float, ph[p_] << 16), hv[2 * p_ + 1] - __builtin_bit_cast(float, ph[p_] & 0xffff0000u)); } \
            { v2u h8; h8.x = pg8::pk4_fp8(hv[0], hv[1], hv[2], hv[3]); h8.y = pg8::pk4_fp8(hv[4], hv[5], hv[6], hv[7]); *(GAS v2u*)(H2 + (size_t)token * D + 32 * ks + 8 * q) = h8; } \
            const bf16x8 Ah = __builtin_bit_cast(bf16x8, (v4u){ph[0], ph[1], ph[2], ph[3]}), Al = __builtin_bit_cast(bf16x8, (v4u){pl[0], pl[1], pl[2], pl[3]}); \
            _Pragma("unroll") for (int nb = 0; nb < 2; ++nb) { \
                acc[nb] = __builtin_amdgcn_mfma_f32_16x16x32_bf16(Ah, wcur[2 * nb], acc[nb], 0, 0, 0); \
                acc[nb] = __builtin_amdgcn_mfma_f32_16x16x32_bf16(Ah, wcur[2 * nb + 1], acc[nb], 0, 0, 0); \
                acc[nb] = __builtin_amdgcn_mfma_f32_16x16x32_bf16(Al, wcur[2 * nb], acc[nb], 0, 0, 0); } } while (0)
        RT_LDW(W0, 0); RT_LDX(X0, 0); RT_LDW(W1, 1); RT_LDX(X1r, 1); RT_LDW(W2, 2); RT_LDX(X2, 2);
        for (int ks4 = 0; ks4 < 64; ks4 += 4) { RT_STEP(X0, X3, W0, W3, ks4); RT_STEP(X1r, X0, W1, W0, ks4 + 1); RT_STEP(X2, X1r, W2, W1, ks4 + 2); RT_STEP(X3, X2, W3, W2, ks4 + 3); }
#undef RT_LDX
#undef RT_LDW
#undef RT_STEP
#pragma unroll
        for (int nb = 0; nb < 2; ++nb) { const float rb = F.in[I_ROUTB][16 * nb + rw];
#pragma unroll
            for (int j = 0; j < 4; ++j) lg[(4 * q + j) * 32 + 16 * nb + rw] = acc[nb][j] + rb; }
        if (lane < 32) wc[lane] = 0;
        LDS_WAIT(); asm volatile("" ::: "memory");
        if (lane < 16) {
            float lv[32];
#pragma unroll
            for (int e4 = 0; e4 < 8; ++e4) { const f32x4 t = *(const LAS f32x4*)(lg + lane * 32 + 4 * e4); lv[4 * e4] = t.x; lv[4 * e4 + 1] = t.y; lv[4 * e4 + 2] = t.z; lv[4 * e4 + 3] = t.w; }
            int sel[4]; float sv[4];
#pragma unroll
            for (int k = 0; k < 4; ++k) { float best = -3.0e38f; int bi = 0;
#pragma unroll
                for (int e = 0; e < 32; ++e) { bool taken = false;
#pragma unroll
                    for (int kk = 0; kk < k; ++kk) taken = taken || (sel[kk] == e);
                    if (!taken && lv[e] > best) { best = lv[e]; bi = e; } }
                sel[k] = bi; sv[k] = best; }
            const float e1 = __expf(sv[1] - sv[0]), e2 = __expf(sv[2] - sv[0]), e3 = __expf(sv[3] - sv[0]), inv = 1.0f / (1.0f + e1 + e2 + e3);
            const int tk = tok0 + lane;
            *(GAS v4u*)(TOKE + (size_t)tk * 4) = (v4u){(unsigned)sel[0], (unsigned)sel[1], (unsigned)sel[2], (unsigned)sel[3]};
            *(GAS f32x4*)(TOKG + (size_t)tk * 4) = (f32x4){inv, e1 * inv, e2 * inv, e3 * inv};
#pragma unroll
            for (int k = 0; k < 4; ++k) __hip_atomic_fetch_add(&wc[sel[k]], 1, __ATOMIC_RELAXED, __HIP_MEMORY_SCOPE_WORKGROUP);
        }
        LDS_WAIT(); asm volatile("" ::: "memory");
        if (lane < 32) WCNT[(size_t)gw * 32 + lane] = wc[lane];
        __syncthreads();
        if (wave == 0 && lane < 32) { int s = 0;
#pragma unroll
            for (int w = 0; w < 8; ++w) s += ((LAS int*)(F.lds + 16384 + w * 128))[lane];
            BCNT[F.bid * 32 + lane] = s; }
        __syncthreads();
    }
}

__device__ __forceinline__ void p10_sort(Frame& F) {
    const int lane = F.lane, wave = F.wave, gw = F.bid * 8 + wave;
    const int* TOKE = wsp<int>(F, WS_TOKE); const float* TOKG = wsp<float>(F, WS_TOKG); const int* WCNT = wsp<int>(F, WS_WCNT); const int* BCNT = wsp<int>(F, WS_BCNT);
    int* ETAB = wsp<int>(F, WS_ETAB); int* ROWTOK = wsp<int>(F, WS_ROWTOK); int* ROWDST = wsp<int>(F, WS_ROWDST); float* ROWGATE = wsp<float>(F, WS_ROWGATE);
    const int e = lane & 31, half = lane >> 5;
    int tot = 0, pre = 0;
#pragma unroll 32
    for (int bb = half; bb < 256; bb += 2) { const int c = BCNT[bb * 32 + e]; tot += c; pre += (bb < F.bid) ? c : 0; }
    tot += __shfl_xor(tot, 32); pre += __shfl_xor(pre, 32);
    { int wcn[7];
#pragma unroll
        for (int w = 0; w < 7; ++w) wcn[w] = WCNT[(size_t)(F.bid * 8 + w) * 32 + e];
#pragma unroll
        for (int w = 0; w < 7; ++w) pre += (w < wave) ? wcn[w] : 0; }
    const int padded = ((tot + 255) / 256) * 256;
    int incl = padded;
#pragma unroll
    for (int o = 1; o < 32; o <<= 1) { const int t = __shfl_up(incl, o, 32); if (e >= o) incl += t; }
    const int pstart = incl - padded;
    if (F.bid == 0) {
        LAS int* tb = (LAS int*)F.lds;
        if (wave == 0 && lane < 32) { ETAB[e] = pstart; ETAB[64 + e] = tot; tb[e] = pstart; tb[32 + e] = padded; if (e == 31) { ETAB[32] = incl; ETAB[128] = incl / 256; } }
        __syncthreads();
        for (int t = F.tid; t < MAXTILES; t += 512) { int te = 0;
#pragma unroll 8
            for (int x = 0; x < 32; ++x) { const int ps = tb[x], pd = tb[32 + x]; if (t * 256 >= ps && t * 256 < ps + pd) te = x; }
            ETAB[256 + t] = te; }
    }
    const int token = 16 * gw + (lane >> 2), slot = lane & 3;
    const int me = TOKE[(size_t)token * 4 + slot]; const float mg = TOKG[(size_t)token * 4 + slot];
    int rank = 0;
    for (int x = 0; x < 32; ++x) { const unsigned long long m = __ballot(me == x); if (me == x) rank = __popcll(m & ((1ull << lane) - 1ull)); }
    const int row = __shfl(pstart, me) + __shfl(pre, me) + rank;
    ROWTOK[row] = token; ROWDST[row] = token * 4 + slot; ROWGATE[row] = mg;
}

__device__ __forceinline__ void p13_final(Frame& F) {
    const int gw = F.bid * 8 + F.wave, NGW = F.G * 8, lane = F.lane;
    const float* MT = wsp<float>(F, WS_MODT); const unsigned char* SLOT = wsp<unsigned char>(F, WS_SLOT);
    for (int row = gw; row < NLAT; row += NGW) {
        int l4 = 4 * lane; asm volatile("" : "+v"(l4));
        const int b = row / SEQ; float* xr = F.out + (size_t)row * D; const bf16* x1r = wsp<bf16>(F, WS_X1B) + (size_t)row * D;
        f32x4 v[8]; float ss = 0.f;
#pragma unroll
        for (int j = 0; j < 8; ++j) { const int c = l4 + 256 * j;
            f32x4 m = (f32x4){0.f, 0.f, 0.f, 0.f};
#pragma unroll
            for (int s = 0; s < 4; ++s) { const int w8 = *(const GAS int*)(SLOT + ((size_t)row * 4 + s) * D + c); const f32x2 lo = __builtin_amdgcn_cvt_pk_f32_fp8(w8, false), hi = __builtin_amdgcn_cvt_pk_f32_fp8(w8, true); m += (f32x4){lo.x, lo.y, hi.x, hi.y}; }
            const f32x4 g5 = *(const GAS f32x4*)(MT + (size_t)b * 6144 + 4096 + c);
            v[j] = unpk4(*(const GAS v2u*)(x1r + c)) + g5 * m * (1.0f / 16.0f);
            ss += (v[j].x * v[j].x + v[j].y * v[j].y) + (v[j].z * v[j].z + v[j].w * v[j].w); }
        const float rstd = 1.0f / sqrtf(wave_sum(ss) * (1.0f / D) + 1e-6f);
#pragma unroll
        for (int j = 0; j < 8; ++j) *(GAS f32x4*)(xr + l4 + 256 * j) = v[j] * rstd * *(const GAS f32x4*)(F.in[I_FING] + l4 + 256 * j);
    }
}

constexpr int NPH = 13;
__global__ void __launch_bounds__(512, 2) mk_fwd(Args args) {
    extern __shared__ __attribute__((aligned(16))) unsigned char lds_raw[];
    Frame F;
    F.lds = (LAS unsigned char*)lds_raw; F.in = args.in; F.out = args.out; F.ws = args.ws;
    F.tid = threadIdx.x; F.lane = F.tid & 63; F.wave = __builtin_amdgcn_readfirstlane(F.tid >> 6); F.G = gridDim.x; F.bid = blockIdx.x;
    volatile LAS unsigned* MISC = (volatile LAS unsigned*)(F.lds + MISC_OFF);
    if (F.tid < 32) MISC[F.tid] = 0u;
    __syncthreads();
    const int lo = args.ph_lo, hi = args.ph_hi;
    unsigned* ctl = (unsigned*)(F.ws + WS_CTL);
    XcdBarrier bar; bar.bar = ctl + CW_BAR; bar.x = 0; bar.st = nullptr;
    if (hi - lo > 1) bar = xcd_barrier_post(ctl + CW_BAR, MISC + 8);
#ifndef PH_MASK
#define PH_MASK 0x1FFF
#endif
#define IN(k) (((PH_MASK >> (k)) & 1) && lo <= (k) && (k) < hi)
#ifndef REP_PH
#define REP_PH -1
#endif
#define SEAM(k) do { if (IN(k) && IN((k) + 1)) xcd_barrier(bar); } while (0)

    if (IN(0)) { p0_adaln(F); p0_small_weights(F); p0_filter(F); }
    if (REP_PH == 0 && IN(0)) { p0_adaln(F); p0_small_weights(F); p0_filter(F); }
    if (REP_PH == 100 && IN(0)) { p0_adaln(F); }
    if (REP_PH == 101 && IN(0)) { p0_small_weights(F); }
    if (REP_PH == 102 && IN(0)) { p0_filter(F); }
    SEAM(0);
#define PHBODY_1  p1_norm1(F); p1_filter_out(F);
    if (IN(1)) { PHBODY_1 }
    if (REP_PH == 1 && IN(1)) { PHBODY_1 }
    SEAM(1);
#define PHBODY_2     \
        pg8::Gemm g{wsp<bf16>(F, WS_A1), wsp<bf16>(F, WS_BTIN), D, 0, D, D}; \
        pg8::InProjOrder S{F.G, F.bid}; \
        pg8::EpiInProj E{wsp<bf16>(F, WS_Z), wsp<bf16>(F, WS_AP)}; \
        pg8::gemm_phase<false, false>(F.lds, g, S, E); \

    if (IN(2)) { PHBODY_2 }
    if (REP_PH == 2 && IN(2)) { PHBODY_2 }
    SEAM(2);
#define PHBODY_3     \
        { pg8::Gemm g{wsp<bf16>(F, WS_AP), wsp<bf16>(F, WS_BTL), 256, 0, KLORA, KLORA}; \
          pg8::StaticOrder S; S.init(MROWS, 4096, F.G, F.bid); \
          pg8::EpiLora E{wsp<bf16>(F, WS_EA), F.in[I_RW0], F.in[I_RA0], 0}; \
          pg8::gemm_phase<false, false>(F.lds, g, S, E); } \
        { pg8::Gemm g{wsp<bf16>(F, WS_AP) + 256, wsp<bf16>(F, WS_BTL) + (size_t)4096 * KLORA + 256, 256, 0, KLORA, KLORA}; \
          pg8::StaticOrder S; S.init(NLAT, 1024, F.G, F.bid); \
          pg8::EpiLora E{wsp<bf16>(F, WS_EA), F.in[I_RW0], F.in[I_RA0], 16}; \
          pg8::gemm_phase<false, false>(F.lds, g, S, E); } \

    if (IN(3)) { PHBODY_3 }
    if (REP_PH == 3 && IN(3)) { PHBODY_3 }
    SEAM(3);
#define PHBODY_4  p4_prep(F);
    if (IN(4)) { PHBODY_4 }
    if (REP_PH == 4 && IN(4)) { PHBODY_4 }
    SEAM(4);
#define PHBODY_5  p5_scan(F); p6_hyena(F);
    if (IN(5)) { PHBODY_5 }
    if (REP_PH == 5 && IN(5)) { PHBODY_5 }
    if (REP_PH == 50 && IN(5)) { p5_scan(F); }
    if (REP_PH == 51 && IN(5)) { p6_hyena(F); }
    SEAM(5);
#define PHBODY_6  p7_assemble(F);
    if (IN(6)) { PHBODY_6 }
    if (REP_PH == 6 && IN(6)) { PHBODY_6 }
    SEAM(6);
#define PHBODY_7     \
        pg8::Gemm g{wsp<bf16>(F, WS_A2), wsp<bf16>(F, WS_BTOUT), D / 2, 0, D / 2, D / 2}; \
        pg8::StaticOrder S; S.init(NLAT, D, F.G, F.bid); \
        pg8::EpiOutProj E{F.in[I_X], wsp<bf16>(F, WS_X1B), wsp<float>(F, WS_MODACC), F.in[I_ADAB], wsp<float>(F, WS_SSQ)}; \
        pg8::gemm_phase<false, true>(F.lds, g, S, E); \

    if (IN(7)) { PHBODY_7 }
    if (REP_PH == 7 && IN(7)) { PHBODY_7 }
    SEAM(7);
#define PHBODY_8  p9_router(F);
    if (IN(8)) { PHBODY_8 }
    if (REP_PH == 8 && IN(8)) { PHBODY_8 }
    SEAM(8);
#define PHBODY_9  p10_sort(F);
    if (IN(9)) { PHBODY_9 }
    if (REP_PH == 9 && IN(9)) { PHBODY_9 }
    SEAM(9);
#define PHBODY_10    \
        const int* ET = wsp<int>(F, WS_ETAB); \
        pg8::Gemm g{wsp<bf16>(F, WS_H2), wsp<bf16>(F, WS_BTGU), D / 2, (size_t)4096 * D, D / 2, D / 2}; \
        pg8::MoeOrder S{F.G, F.bid, 16, ET[128], F.ws}; \
        pg8::EpiSwiglu E{F.ws, F.in[I_EBG], F.in[I_EBU]}; \
        pg8::gemm_phase<true, true>(F.lds, g, S, E); \

    if (IN(10)) { PHBODY_10 }
    if (REP_PH == 10 && IN(10)) { PHBODY_10 }
#ifdef SHADOW10
    if (IN(10)) { const int* ET = wsp<int>(F, WS_ETAB); pg8::Gemm g{wsp<bf16>(F, WS_H2), wsp<bf16>(F, WS_BTGU), D / 2, (size_t)4096 * D, D / 2, D / 2};
        pg8::MoeOrderT<SHADOW10 == 1> S{F.G, F.bid, 16, ET[128], F.ws}; pg8::EpiSwigluT<(SHADOW10 == 1 ? 1 : 2)> E{F.ws, F.in[I_EBG], F.in[I_EBU]};
        pg8::gemm_phase<true, true>(F.lds, g, S, E); }
#endif
    SEAM(10);
#define PHBODY_11    \
        const int* ET = wsp<int>(F, WS_ETAB); \
        pg8::Gemm g{wsp<bf16>(F, WS_ACT), wsp<bf16>(F, WS_BTD), D / 2, (size_t)D * D, D / 2, D / 2}; \
        pg8::MoeOrder S{F.G, F.bid, 8, ET[128], F.ws}; \
        pg8::EpiDown E{F.ws, F.in[I_EBD]}; \
        pg8::gemm_phase<false, true>(F.lds, g, S, E); \

    if (IN(11)) { PHBODY_11 }
    if (REP_PH == 11 && IN(11)) { PHBODY_11 }
    SEAM(11);
    if (IN(12)) { p13_final(F); }
#undef IN
#undef SEAM
}

extern "C" void kernel_launch(void* const* d_in, const int* in_sizes, int n_in, void* d_out, int out_size, void* d_ws, size_t ws_size, hipStream_t stream) {
    static int grid = 0;
    if (grid == 0) {
        if (n_in != 44 || out_size != NLAT * D || ws_size < WS_END) { fprintf(stderr, "kernel_launch: unexpected problem (n_in %d, out %d, ws %zu)\n", n_in, out_size, ws_size); grid = -1; return; }
        if (hipFuncSetAttribute((const void*)mk_fwd, hipFuncAttributeMaxDynamicSharedMemorySize, LDS_BYTES) != hipSuccess) { fprintf(stderr, "kernel_launch: hipFuncSetAttribute failed\n"); grid = -1; return; }
        int per_cu = 0;
        if (hipOccupancyMaxActiveBlocksPerMultiprocessor(&per_cu, (const void*)mk_fwd, 512, LDS_BYTES) != hipSuccess || per_cu < 1) fprintf(stderr, "kernel_launch: occupancy query says %d blocks per CU\n", per_cu);
        (void)hipGetLastError();
        grid = 256;
    }
    if (grid < 0) return;
    (void)hipMemsetAsync((char*)d_ws + WS_CTL, 0, CTL_ZERO_BYTES, stream);
    Args a{};
    for (int i = 0; i < 44; ++i) a.in[i] = (const float*)d_in[i];
    a.out = (float*)d_out; a.ws = (unsigned char*)d_ws;
#if MK_PER_PHASE
    for (int ph = 0; ph < NPH; ++ph) { a.ph_lo = ph; a.ph_hi = ph + 1; hipLaunchKernelGGL(mk_fwd, dim3(grid), dim3(512), LDS_BYTES, stream, a); }
#else
    a.ph_lo = 0; a.ph_hi = NPH;
    hipLaunchKernelGGL(mk_fwd, dim3(grid), dim3(512), LDS_BYTES, stream, a);
#endif
    const hipError_t le = hipPeekAtLastError();
    if (le != hipSuccess) fprintf(stderr, "kernel_launch: launch failed: %s\n", hipGetErrorName(le));
}
```

```cpp
#include <hip/hip_runtime.h>
#include <cstdio>
#include <cstdint>

#ifndef MK_PER_PHASE
#define MK_PER_PHASE 0
#endif

#define GAS __attribute__((address_space(1)))
#define LAS __attribute__((address_space(3)))
typedef unsigned short bf16;
typedef unsigned v4u __attribute__((ext_vector_type(4)));
typedef unsigned v2u __attribute__((ext_vector_type(2)));
typedef float f32x4 __attribute__((ext_vector_type(4)));
typedef float f32x2 __attribute__((ext_vector_type(2)));
typedef short bf16x8 __attribute__((ext_vector_type(8)));

constexpr int NB = 16, SEQ = 2048, CTXL = 256, D = 2048;
constexpr int NLAT = NB * SEQ;
constexpr int NCTX = NB * CTXL;
constexpr int MROWS = NLAT + NCTX;
constexpr int PW = 6144;
constexpr int NIN = 6656;
constexpr int NLORA = 5120, KLORA = 512;
constexpr int NE = 32, TOPK = 4;
constexpr int NASG = NLAT * TOPK;
constexpr int MAXTILES = NASG / 256 + NE;
constexpr int SIW = 7168;

constexpr size_t MiB = 1u << 20;
constexpr size_t WS_CTL = 0;
constexpr size_t WS_MODACC = 1 * MiB;
constexpr size_t CTL_ZERO_BYTES = 1 * MiB;
constexpr size_t WS_MODT = 15 * MiB;
constexpr size_t WS_BS = 3 * MiB;
constexpr size_t WS_TOKE = 5 * MiB;
constexpr size_t WS_TOKG = 6 * MiB;
constexpr size_t WS_WCNT = 7 * MiB;
constexpr size_t WS_BCNT = 7 * MiB + 512 * 1024;
constexpr size_t WS_ETAB = 7 * MiB + 768 * 1024;
constexpr size_t WS_ROWTOK = 8 * MiB;
constexpr size_t WS_ROWDST = 9 * MiB;
constexpr size_t WS_ROWGATE = 10 * MiB;
constexpr size_t WS_SSQ = 1040 * MiB;
constexpr size_t WS_H3T = 12 * MiB;
constexpr size_t WS_G = 16 * MiB;
constexpr size_t WS_BTIN = 24 * MiB;
constexpr size_t WS_BTL = 50 * MiB;
constexpr size_t WS_BTOUT = 55 * MiB;
constexpr size_t WS_WR = 63 * MiB;
constexpr size_t WS_A1 = 64 * MiB;
constexpr size_t WS_Z = 208 * MiB;
constexpr size_t WS_AP = 640 * MiB;
constexpr size_t WS_X1B = 676 * MiB;
constexpr size_t WS_EA = 676 * MiB;
constexpr size_t WS_KKINV = 1036 * MiB;
constexpr size_t WS_UT = 1540 * MiB;
constexpr size_t WS_X0T = 1604 * MiB;
constexpr size_t WS_YCT = 1668 * MiB;
constexpr size_t WS_YS = 1040 * MiB;
constexpr size_t WS_A2 = 208 * MiB;
constexpr size_t WS_ZC = 1296 * MiB;
constexpr size_t WS_H2 = 336 * MiB;
constexpr size_t WS_BTGU = 1732 * MiB;
constexpr size_t WS_BTD = 64 * MiB;
constexpr size_t WS_ACT = 400 * MiB;
constexpr size_t WS_SLOT = 1040 * MiB;
constexpr size_t WS_END = 1988 * MiB;

constexpr int CW_TMO = 0;
constexpr int CW_BAR = 4096;

constexpr int LDS_BYTES = 147456;
constexpr int MISC_OFF = 143360;

__device__ __forceinline__ unsigned f2bf(float f) { unsigned u = __builtin_bit_cast(unsigned, f); return (u + 0x7fffu + ((u >> 16) & 1u)) >> 16; }
typedef __bf16 bf16v2_t __attribute__((ext_vector_type(2)));
__device__ __forceinline__ unsigned pk2(float lo, float hi) { const f32x2 v = {lo, hi}; return __builtin_bit_cast(unsigned, __builtin_convertvector(v, bf16v2_t)); }
__device__ __forceinline__ float bf2f(unsigned b) { return __builtin_bit_cast(float, b << 16); }
__device__ __forceinline__ float bflo(unsigned w) { return __builtin_bit_cast(float, w << 16); }
__device__ __forceinline__ float bfhi(unsigned w) { return __builtin_bit_cast(float, w & 0xffff0000u); }
__device__ __forceinline__ float fsigmoid(float x) { return __builtin_amdgcn_rcpf(1.0f + __builtin_amdgcn_exp2f(-1.4426950408889634f * x)); }
__device__ __forceinline__ float ftanh(float x) { const float e = __builtin_amdgcn_exp2f(2.8853900817779268f * x); return 1.0f - 2.0f * __builtin_amdgcn_rcpf(e + 1.0f); }
#define LDS_WAIT() asm volatile("s_waitcnt lgkmcnt(0)" ::: "memory")
#define VM_WAIT() asm volatile("s_waitcnt vmcnt(0)" ::: "memory")

#define XB_TMO      128
#define XB_XCNT(j)  (256  + 64 * (j))
#define XB_XSUB(j)  (1280 + 64 * (j))
#define XB_XGEN(j)  (2304 + 64 * (j))
#define XB_TOP      3328
#define XB_TOPGEN   3392
#define XCD_BAR_WORDS 3456
#define XB_SPIN_CAP (1u << 20)

__device__ __forceinline__ unsigned xb_ld(unsigned* p)              { return __hip_atomic_load(p, __ATOMIC_RELAXED, __HIP_MEMORY_SCOPE_AGENT); }
__device__ __forceinline__ unsigned xb_add(unsigned* p, unsigned v) { return __hip_atomic_fetch_add(p, v, __ATOMIC_RELAXED, __HIP_MEMORY_SCOPE_AGENT); }
__device__ __forceinline__ unsigned xb_xcc_id() { return (unsigned)__builtin_amdgcn_s_getreg((3 << 11) | 20) & 0xFu; }
#define XB_SPIN(cond, bar) do { unsigned _sp = 0; while (cond) { __builtin_amdgcn_s_sleep(1); \
    if ((++_sp & 255u) == 0u) { if (xb_ld(&(bar)[XB_TMO])) break; if (_sp > XB_SPIN_CAP) { atomicAdd(&(bar)[XB_TMO], 1u); break; } } } } while (0)

struct XcdBarrier { unsigned* bar; unsigned x; volatile LAS unsigned* st; };

__device__ __forceinline__ XcdBarrier xcd_barrier_post(unsigned* bar, volatile LAS unsigned* st) {
    XcdBarrier b; b.bar = bar; b.x = xb_xcc_id(); b.st = st;
    if (threadIdx.x == 0) (void)xb_add(&bar[XB_XCNT(b.x)], 1u);
    return b;
}
__device__ __forceinline__ void xcd_barrier_complete(unsigned* bar, unsigned x, unsigned& nloc, unsigned& nx) {
    const unsigned G = gridDim.x * gridDim.y * gridDim.z;
    unsigned sum, cnt, mine, sp = 0u;
    for (;;) {
        sum = 0u; cnt = 0u; mine = 0u;
#pragma unroll
        for (unsigned j = 0; j < 16; ++j) { const unsigned c = xb_ld(&bar[XB_XCNT(j)]); sum += c; cnt += (c > 0u) ? 1u : 0u; mine = (j == x) ? c : mine; }
        if (sum == G) break;
        __builtin_amdgcn_s_sleep(1);
        if ((++sp & 255u) == 0u) { if (xb_ld(&bar[XB_TMO])) break; if (sp > XB_SPIN_CAP) { atomicAdd(&bar[XB_TMO], 1u); break; } }
    }
    nloc = mine > 0u ? mine : 1u; nx = cnt > 0u ? cnt : 1u;
}
__device__ __forceinline__ void xcd_barrier(const XcdBarrier& b) {
    asm volatile("s_waitcnt vmcnt(0)" ::: "memory");
    __syncthreads();
    if (threadIdx.x == 0) {
        unsigned* bar = b.bar;
        __builtin_amdgcn_s_waitcnt(0);
        unsigned nloc = b.st[0], nx = b.st[1];
        if (nloc == 0u) { xcd_barrier_complete(bar, b.x, nloc, nx); b.st[0] = nloc; b.st[1] = nx; }
        const unsigned old = xb_add(&bar[XB_XSUB(b.x)], 1u);
        const unsigned gen = old / nloc;
        if (old + 1u == (gen + 1u) * nloc) {
            __builtin_amdgcn_fence(__ATOMIC_RELEASE, "agent");
            asm volatile("s_waitcnt vmcnt(0)" ::: "memory");
            const unsigned og = xb_add(&bar[XB_TOP], 1u);
            const unsigned tg = og / nx;
            if (og + 1u == (tg + 1u) * nx) xb_add(&bar[XB_TOPGEN], 1u);
            else XB_SPIN(xb_ld(&bar[XB_TOPGEN]) == tg, bar);
            __builtin_amdgcn_fence(__ATOMIC_ACQUIRE, "agent");
            xb_add(&bar[XB_XGEN(b.x)], 1u);
            asm volatile("s_waitcnt vmcnt(0)" ::: "memory");
        } else {
            XB_SPIN(xb_ld(&bar[XB_XGEN(b.x)]) == gen, bar);
            __builtin_amdgcn_fence(__ATOMIC_ACQUIRE, "agent");
            asm volatile("s_waitcnt vmcnt(0)" ::: "memory");
        }
    }
    __syncthreads();
}

namespace pg8 {
constexpr int BM = 256, BK = 64, HALF = 128, HTB = HALF * BK * 2, STAGE_BYTES = 8 * HTB, NXCD = 8, WGM = 8;
__device__ __forceinline__ int lds_byte(int r, int c) { const int st = (r >> 4) * 2 + (c >> 5), rr = r & 15, cc = c & 31, ob = rr * 64 + cc * 2; return st * 1024 + (ob ^ (((ob >> 9) & 1) << 5)); }
__device__ __forceinline__ void stage_rc(int b, int& R, int& C) { const int st = b / 1024, sb = b % 1024, swz = sb ^ (((sb >> 9) & 1) << 5); R = (st >> 1) * 16 + swz / 64; C = (st & 1) * 32 + (swz % 64) / 2; }
__device__ __forceinline__ int perm32(int rho) { const int n = rho >> 4, i = rho & 15; return 8 * (i >> 2) + 4 * n + (i & 3); }

typedef int i32x4 __attribute__((ext_vector_type(4)));
typedef int i32x8 __attribute__((ext_vector_type(8)));
__device__ __forceinline__ i32x8 cat_i8(bf16x8 a, bf16x8 b) { return __builtin_shufflevector(__builtin_bit_cast(i32x4, a), __builtin_bit_cast(i32x4, b), 0, 1, 2, 3, 4, 5, 6, 7); }
struct Unit { int pm, pn, e; };
struct Gemm { const bf16* A; const bf16* Bt; int K; size_t bstrideE; int lda, ldb; };

__device__ __forceinline__ unsigned cvt_pk_bf16(float lo, float hi) { return pk2(lo, hi); }

template <bool GATHER, bool FP8, class Epi, class Sched>
__device__ __forceinline__ void gemm_phase(LAS unsigned char* lds, const Gemm g, const Sched& S, const Epi& E) {
    const int tid = threadIdx.x, wid = __builtin_amdgcn_readfirstlane(tid >> 6), lane = tid & 63, wr = wid >> 2, wc = wid & 3, fr = lane & 15, fq = lane >> 4;
    const int K = g.K, nt = K / BK, lda = g.lda, ldb = g.ldb;
    unsigned voffB[2]; int RA[2], CA[2];
#pragma unroll
    for (int i = 0; i < 2; ++i) { int R, C; stage_rc(tid * 16 + i * 8192, R, C); const int Rb = Epi::PERM ? ((R & ~31) + perm32(R & 31)) : R;
        RA[i] = R; CA[i] = C; voffB[i] = (unsigned)(Rb * ldb + C) * 2u; }
    const size_t kstep = (size_t)(BK * 2);
    const size_t hstep = (size_t)HALF * ldb * 2, tstep = 2 * hstep;
    const size_t hstepA = (size_t)HALF * lda * 2, tstepA = 2 * hstepA;
    const unsigned ldsw = (unsigned)wid * 1024u;
    const int aoff = lds_byte(wr * 64 + fr, fq * 8), boff = lds_byte(wc * 32 + fr, fq * 8);
#define PG8_SA(b, h) (((b) * 2 + (h)) * HTB)
#define PG8_SB(b, h) ((4 + (b) * 2 + (h)) * HTB)
#define PG8_STAGE(bufoff, gbase, voff) do { _Pragma("unroll") for (int _i = 0; _i < 2; ++_i) \
        __builtin_amdgcn_global_load_lds((const unsigned*)((const char*)(gbase) + (voff)[_i]), (LAS unsigned*)(lds + (bufoff) + ldsw + _i * 8192), 16, 0, 0); } while (0)
#define PG8_LDA(dst, b, h) do { _Pragma("unroll") for (int m = 0; m < 4; ++m) { if constexpr (FP8) dst##8[m] = cat_i8(*(const LAS bf16x8*)(lds + PG8_SA(b, h) + aoff + m * 2048), *(const LAS bf16x8*)(lds + PG8_SA(b, h) + aoff + m * 2048 + 1024)); \
        else { _Pragma("unroll") for (int k = 0; k < 2; ++k) dst[m][k] = *(const LAS bf16x8*)(lds + PG8_SA(b, h) + aoff + m * 2048 + k * 1024); } } } while (0)
#define PG8_LDB(dst, b, h) do { _Pragma("unroll") for (int n = 0; n < 2; ++n) { if constexpr (FP8) dst##8[n] = cat_i8(*(const LAS bf16x8*)(lds + PG8_SB(b, h) + boff + n * 2048), *(const LAS bf16x8*)(lds + PG8_SB(b, h) + boff + n * 2048 + 1024)); \
        else { _Pragma("unroll") for (int k = 0; k < 2; ++k) dst[n][k] = *(const LAS bf16x8*)(lds + PG8_SB(b, h) + boff + n * 2048 + k * 1024); } } } while (0)
#define PG8_F8STR(d, a, b) "v_mfma_scale_f32_16x16x128_f8f6f4 %" #d ", %" #a ", %" #b ", %" #d ", %14, %14 op_sel_hi:[0,0,0]\n\t"
#define PG8_MMA(ai, bj, At, Bt) do { __builtin_amdgcn_s_setprio(1); \
        if constexpr (FP8) { asm volatile("s_nop 1\n\t" PG8_F8STR(0, 12, 8) PG8_F8STR(1, 13, 8) PG8_F8STR(2, 12, 9) PG8_F8STR(3, 13, 9) PG8_F8STR(4, 12, 10) PG8_F8STR(5, 13, 10) PG8_F8STR(6, 12, 11) PG8_F8STR(7, 13, 11) \
            : "+v"(acc[ai][bj][0][0]), "+v"(acc[ai][bj][0][1]), "+v"(acc[ai][bj][1][0]), "+v"(acc[ai][bj][1][1]), "+v"(acc[ai][bj][2][0]), "+v"(acc[ai][bj][2][1]), "+v"(acc[ai][bj][3][0]), "+v"(acc[ai][bj][3][1]) \
            : "v"(At##8[0]), "v"(At##8[1]), "v"(At##8[2]), "v"(At##8[3]), "v"(Bt##8[0]), "v"(Bt##8[1]), "v"(f8scale)); } \
        else { _Pragma("unroll") for (int m = 0; m < 4; ++m) _Pragma("unroll") for (int n = 0; n < 2; ++n) _Pragma("unroll") for (int k = 0; k < 2; ++k) \
            acc[ai][bj][m][n] = __builtin_amdgcn_mfma_f32_16x16x32_bf16(Bt[n][k], At[m][k], acc[ai][bj][m][n], 0, 0, 0); } __builtin_amdgcn_s_setprio(0); } while (0)
#define PG8_WAIT_V(n) asm volatile("s_waitcnt vmcnt(" #n ")" ::: "memory")
#define PG8_WAIT_L(n) asm volatile("s_waitcnt lgkmcnt(" #n ")" ::: "memory")
#define PG8_BAR __builtin_amdgcn_s_barrier()
#define PG8_SCHED __builtin_amdgcn_sched_barrier(0)
    Unit cur, nxt; int ui = 0;
    if (!S.next(0, cur)) return;
    f32x4 acc[2][2][4][2];
#pragma unroll
    for (int a = 0; a < 2; ++a)
#pragma unroll
        for (int b = 0; b < 2; ++b)
#pragma unroll
            for (int m = 0; m < 4; ++m)
#pragma unroll
                for (int n = 0; n < 2; ++n) acc[a][b][m][n] = (f32x4){0.f, 0.f, 0.f, 0.f};
    bf16x8 At[4][2], B0[2][2], B1[2][2]; i32x8 At8[4], B08[2], B18[2]; int f8scale = 0x7f7f7f7f; asm volatile("" : "+v"(f8scale));
    unsigned vA0[2], vA1[2], vN0[2], vN1[2];
    const char* cA; const char* cB;
    if constexpr (GATHER) {
        cA = (const char*)g.A;
#pragma unroll
        for (int i = 0; i < 2; ++i) { vA0[i] = (unsigned)(S.arow(cur, RA[i]) * lda + CA[i]) * 2u; vA1[i] = (unsigned)(S.arow(cur, HALF + RA[i]) * lda + CA[i]) * 2u; }
    } else {
        cA = (const char*)g.A + (size_t)cur.pm * tstepA;
#pragma unroll
        for (int i = 0; i < 2; ++i) { vA0[i] = (unsigned)(RA[i] * lda + CA[i]) * 2u; vA1[i] = vA0[i] + (unsigned)hstepA; }
    }
#pragma unroll
    for (int i = 0; i < 2; ++i) { vN0[i] = vA0[i]; vN1[i] = vA1[i]; }
    cB = (const char*)g.Bt + (size_t)cur.e * g.bstrideE + (size_t)cur.pn * tstep;
    PG8_STAGE(PG8_SB(0, 0), cB, voffB); PG8_STAGE(PG8_SA(0, 0), cA, vA0); PG8_STAGE(PG8_SB(0, 1), cB + hstep, voffB); PG8_STAGE(PG8_SA(0, 1), cA, vA1);
    if (wr == 1) PG8_BAR;
    PG8_WAIT_V(4); PG8_BAR;
    PG8_STAGE(PG8_SB(1, 0), cB + kstep, voffB); PG8_STAGE(PG8_SA(1, 0), cA + kstep, vA0); PG8_STAGE(PG8_SB(1, 1), cB + hstep + kstep, voffB);
    PG8_WAIT_V(6); PG8_BAR;
    for (;;) {
        const bool has_next = S.next(ui + 1, nxt);
        const char* nA; const char* nB;
        if (has_next) {
            nB = (const char*)g.Bt + (size_t)nxt.e * g.bstrideE + (size_t)nxt.pn * tstep;
            if constexpr (GATHER) { nA = cA;
#pragma unroll
                for (int i = 0; i < 2; ++i) { vN0[i] = (unsigned)(S.arow(nxt, RA[i]) * lda + CA[i]) * 2u; vN1[i] = (unsigned)(S.arow(nxt, HALF + RA[i]) * lda + CA[i]) * 2u; }
            } else nA = (const char*)g.A + (size_t)nxt.pm * tstepA;
        } else { nA = cA; nB = cB;
#pragma unroll
            for (int i = 0; i < 2; ++i) { vN0[i] = vA0[i]; vN1[i] = vA1[i]; } }
#pragma unroll 1
        for (int t = 0; t < nt; t += 2) {
            const bool last = (t == nt - 2);
            const char* a1 = cA + (size_t)(t + 1) * kstep;
            const char* a2 = last ? nA : cA + (size_t)(t + 2) * kstep; const char* b2 = last ? nB : cB + (size_t)(t + 2) * kstep;
            const char* a3 = a2 + kstep; const char* b3 = b2 + kstep;
            unsigned w0[2], w1[2];
#pragma unroll
            for (int i = 0; i < 2; ++i) { if constexpr (GATHER) { w0[i] = last ? vN0[i] : vA0[i]; w1[i] = last ? vN1[i] : vA1[i]; } else { w0[i] = vA0[i]; w1[i] = vA1[i]; } }
            PG8_LDB(B0, 0, 0); PG8_SCHED; PG8_LDA(At, 0, 0); PG8_STAGE(PG8_SA(1, 1), a1, vA1);
            PG8_WAIT_L(8); PG8_BAR; PG8_WAIT_L(0); PG8_MMA(0, 0, At, B0); PG8_BAR; PG8_SCHED;
            PG8_LDB(B1, 0, 1); PG8_STAGE(PG8_SB(0, 0), b2, voffB);
            PG8_BAR; PG8_WAIT_L(0); PG8_MMA(0, 1, At, B1); PG8_BAR;
            PG8_LDA(At, 0, 1); PG8_STAGE(PG8_SA(0, 0), a2, w0);
            PG8_BAR; PG8_WAIT_L(0); PG8_MMA(1, 0, At, B0); PG8_BAR; PG8_SCHED;
            PG8_STAGE(PG8_SB(0, 1), b2 + hstep, voffB);
            PG8_WAIT_V(6); PG8_BAR; PG8_MMA(1, 1, At, B1); PG8_BAR;
            PG8_LDB(B0, 1, 0); PG8_SCHED; PG8_LDA(At, 1, 0); PG8_STAGE(PG8_SA(0, 1), a2, w1);
            PG8_WAIT_L(8); PG8_BAR; PG8_WAIT_L(0); PG8_MMA(0, 0, At, B0); PG8_BAR; PG8_SCHED;
            PG8_LDB(B1, 1, 1); PG8_STAGE(PG8_SB(1, 0), b3, voffB);
            PG8_BAR; PG8_WAIT_L(0); PG8_MMA(0, 1, At, B1); PG8_BAR;
            PG8_LDA(At, 1, 1); PG8_STAGE(PG8_SA(1, 0), a3, w0);
            PG8_BAR; PG8_WAIT_L(0); PG8_MMA(1, 0, At, B0); PG8_BAR; PG8_SCHED;
            PG8_STAGE(PG8_SB(1, 1), b3 + hstep, voffB);
            PG8_WAIT_V(6); PG8_BAR; PG8_MMA(1, 1, At, B1); PG8_BAR;
        }
        if constexpr (FP8) asm volatile("s_nop 15\n\ts_nop 15" ::: "memory");
        E(acc, cur, wr, wc, fr, fq);
        if (!has_next) break;
#pragma unroll
        for (int a = 0; a < 2; ++a)
#pragma unroll
            for (int b = 0; b < 2; ++b)
#pragma unroll
                for (int m = 0; m < 4; ++m)
#pragma unroll
                    for (int n = 0; n < 2; ++n) acc[a][b][m][n] = (f32x4){0.f, 0.f, 0.f, 0.f};
        cur = nxt; cA = nA; cB = nB; ++ui;
#pragma unroll
        for (int i = 0; i < 2; ++i) { vA0[i] = vN0[i]; vA1[i] = vN1[i]; }
    }
    PG8_WAIT_V(0);
    if (wr == 0) PG8_BAR;
    PG8_BAR;
#undef PG8_SA
#undef PG8_SB
#undef PG8_STAGE
#undef PG8_LDA
#undef PG8_LDB
#undef PG8_MMA
#undef PG8_WAIT_V
#undef PG8_WAIT_L
#undef PG8_BAR
#undef PG8_SCHED
}
}

struct Args { const float* in[44]; float* out; unsigned char* ws; int ph_lo, ph_hi; };
enum InIdx { I_X = 0, I_C, I_CTX, I_CCTX, I_ADAW, I_ADAB, I_N1G, I_N2G, I_INW, I_CONVW, I_CONVB, I_HW1, I_HB1, I_HW2, I_HB2, I_HW3, I_HB3, I_HFREQ, I_HW4, I_HBIAS, I_HNG,
             I_RW0, I_RW1, I_RW2, I_RA0, I_RA1, I_RA2, I_RKK, I_RKA, I_RRK, I_RG1, I_RG2, I_LNG, I_LNB, I_OUTW, I_ROUTW, I_ROUTB, I_EWG, I_EBG, I_EWU, I_EBU, I_EWD, I_EBD, I_FING };

struct Frame {
    LAS unsigned char* lds;
    const float* const* in;
    float* out; unsigned char* ws;
    int tid, lane, wave, G, bid;
};
template <class T> __device__ __forceinline__ T* wsp(const Frame& F, size_t off) { return (T*)(F.ws + off); }

template <int CTRL> __device__ __forceinline__ float dpp_mov(float x) { return __builtin_bit_cast(float, __builtin_amdgcn_update_dpp(0, __builtin_bit_cast(int, x), CTRL, 0xF, 0xF, true)); }
__device__ __forceinline__ float row16_sum(float v) {
    v += dpp_mov<0x128>(v);
    v += dpp_mov<0x124>(v);
    v += dpp_mov<0x122>(v);
    v += dpp_mov<0x121>(v);
    return v;
}

__device__ __forceinline__ float rdlane(float v, int l) { return __builtin_bit_cast(float, __builtin_amdgcn_readlane(__builtin_bit_cast(int, v), l)); }
__device__ __forceinline__ float wave_sum(float v) { v = row16_sum(v); return (rdlane(v, 0) + rdlane(v, 16)) + (rdlane(v, 32) + rdlane(v, 48)); }

__device__ __forceinline__ void tr_item(const float* src, size_t ld_src, int k0, int n0, bf16* dst, bf16* dlo, size_t ld_dst, int drow0, int dk0, LAS float* scr, int lane) {
    const int c = lane & 7;
    if (src == nullptr) {
#pragma unroll
        for (int j = 0; j < 4; ++j) { const int n = (lane >> 3) + 8 * j; *(GAS v4u*)(dst + (size_t)(drow0 + n) * ld_dst + dk0 + 8 * c) = (v4u){0u, 0u, 0u, 0u}; }
        return;
    }
#pragma unroll 8
    for (int i = 0; i < 32; ++i) { const int kk = 2 * i + (lane >> 5); scr[kk * 33 + (lane & 31)] = src[(size_t)(k0 + kk) * ld_src + n0 + (lane & 31)]; }
    LDS_WAIT(); asm volatile("" ::: "memory");
#pragma unroll
    for (int j = 0; j < 4; ++j) { const int n = (lane >> 3) + 8 * j; const LAS float* s = scr + (8 * c) * 33 + n;
        float v[8];
#pragma unroll
        for (int q = 0; q < 8; ++q) v[q] = s[q * 33];
        v4u o; o.x = pk2(v[0], v[1]); o.y = pk2(v[2], v[3]); o.z = pk2(v[4], v[5]); o.w = pk2(v[6], v[7]);
        *(GAS v4u*)(dst + (size_t)(drow0 + n) * ld_dst + dk0 + 8 * c) = o;
        if (dlo) { float r[8];
#pragma unroll
            for (int q = 0; q < 8; ++q) r[q] = v[q] - bf2f(f2bf(v[q]));
            v4u p; p.x = pk2(r[0], r[1]); p.y = pk2(r[2], r[3]); p.z = pk2(r[4], r[5]); p.w = pk2(r[6], r[7]);
            *(GAS v4u*)(dlo + (size_t)(drow0 + n) * ld_dst + dk0 + 8 * c) = p; } }
    LDS_WAIT(); asm volatile("" ::: "memory");
}

struct ConvItem { const float* src; unsigned char* dst; };
__device__ __forceinline__ ConvItem conv_item(const Frame& F, int it) {
    const int e = it / 6144, r = it % 6144; ConvItem c;
    if (r < 4096) { const int s = r / 2048, rr = r % 2048, kb = rr / 64, nb = rr % 64;
        c.src = (s ? F.in[I_EWU] : F.in[I_EWG]) + (size_t)e * D * D + (size_t)(64 * kb) * D + 32 * nb;
        c.dst = F.ws + WS_BTGU + ((size_t)e * 4096 + 256 * (nb / 4) + 128 * s + 32 * (nb % 4)) * D + 64 * kb; }
    else { const int rr = r - 4096, kb = rr / 64, nb = rr % 64;
        c.src = F.in[I_EWD] + (size_t)e * D * D + (size_t)(64 * kb) * D + 32 * nb;
        c.dst = F.ws + WS_BTD + ((size_t)e * D + 32 * nb) * D + 64 * kb; }
    return c;
}
__device__ __forceinline__ void conv_issue(const ConvItem& c, f32x4 (&cv)[8], int lane) {
#pragma unroll
    for (int i = 0; i < 8; ++i) cv[i] = *(const GAS f32x4*)(c.src + (size_t)(8 * i + (lane >> 3)) * D + 4 * (lane & 7));
}
__device__ __forceinline__ void conv_finish(const ConvItem& c, const f32x4 (&cv)[8], LAS float* scr, int lane) {
#pragma unroll
    for (int i = 0; i < 8; ++i) { LAS float* d = scr + (8 * i + (lane >> 3)) * 33 + 4 * (lane & 7); d[0] = cv[i].x; d[1] = cv[i].y; d[2] = cv[i].z; d[3] = cv[i].w; }
    LDS_WAIT(); asm volatile("" ::: "memory");
    const int cc = lane & 7;
#pragma unroll
    for (int j = 0; j < 4; ++j) { const int n = (lane >> 3) + 8 * j; const LAS float* s = scr + (8 * cc) * 33 + n;
        float v[8];
#pragma unroll
        for (int q = 0; q < 8; ++q) v[q] = s[q * 33] * 64.0f;
        int w0 = __builtin_amdgcn_cvt_pk_fp8_f32(v[0], v[1], 0, false); w0 = __builtin_amdgcn_cvt_pk_fp8_f32(v[2], v[3], w0, true);
        int w1 = __builtin_amdgcn_cvt_pk_fp8_f32(v[4], v[5], 0, false); w1 = __builtin_amdgcn_cvt_pk_fp8_f32(v[6], v[7], w1, true);
        v2u o; o.x = (unsigned)w0; o.y = (unsigned)w1;
        *(GAS v2u*)(c.dst + (size_t)n * D + 8 * cc) = o; }
    LDS_WAIT(); asm volatile("" ::: "memory");
}

typedef short bf16x8_t __attribute__((ext_vector_type(8)));
struct ConvSel { bf16x8_t b0, b1; };
__device__ __forceinline__ ConvSel conv_sel(int lane) {
    const int c = lane & 15, qd = lane >> 4, e = c & 3; const bool on = (c >> 2) == qd; const unsigned val = on ? ((e & 1) ? 0x42800000u : 0x00004280u) : 0u;
    v4u s0, s1; s0.x = (e >> 1) == 0 ? val : 0u; s0.y = (e >> 1) == 1 ? val : 0u; s0.z = 0u; s0.w = 0u; s1.x = 0u; s1.y = 0u; s1.z = s0.x; s1.w = s0.y;
    ConvSel r; r.b0 = __builtin_bit_cast(bf16x8_t, s0); r.b1 = __builtin_bit_cast(bf16x8_t, s1); return r;
}
__device__ __forceinline__ void conv_issue_m(const ConvItem& c, f32x4 (&cv)[8], int lane) {
    const int r = lane & 15, qd = lane >> 4; const float* p = c.src + (size_t)(16 * (r >> 2) + (r & 3)) * D + 4 * qd;
#pragma unroll
    for (int blk = 0; blk < 4; ++blk) { cv[2 * blk] = *(const GAS f32x4*)(p + (size_t)(4 * blk) * D); cv[2 * blk + 1] = *(const GAS f32x4*)(p + (size_t)(4 * blk) * D + 16); }
}
__device__ __forceinline__ void conv_finish_m(const ConvItem& c, const f32x4 (&cv)[8], const ConvSel& sel, int lane) {
    const int cc = lane & 15, mg = lane >> 4; unsigned w0[4], w1[4]; const f32x4 z4 = (f32x4){0.f, 0.f, 0.f, 0.f};
#pragma unroll
    for (int blk = 0; blk < 4; ++blk) { v4u a; a.x = pk2(cv[2 * blk].x, cv[2 * blk].y); a.y = pk2(cv[2 * blk].z, cv[2 * blk].w); a.z = pk2(cv[2 * blk + 1].x, cv[2 * blk + 1].y); a.w = pk2(cv[2 * blk + 1].z, cv[2 * blk + 1].w);
        const bf16x8_t A = __builtin_bit_cast(bf16x8_t, a);
        const f32x4 d0 = __builtin_amdgcn_mfma_f32_16x16x32_bf16(A, sel.b0, z4, 0, 0, 0), d1 = __builtin_amdgcn_mfma_f32_16x16x32_bf16(A, sel.b1, z4, 0, 0, 0);
        int t0 = __builtin_amdgcn_cvt_pk_fp8_f32(d0.x, d0.y, 0, false); t0 = __builtin_amdgcn_cvt_pk_fp8_f32(d0.z, d0.w, t0, true);
        int t1 = __builtin_amdgcn_cvt_pk_fp8_f32(d1.x, d1.y, 0, false); t1 = __builtin_amdgcn_cvt_pk_fp8_f32(d1.z, d1.w, t1, true);
        w0[blk] = (unsigned)t0; w1[blk] = (unsigned)t1; }
    unsigned char* dp = c.dst + (size_t)cc * D + 16 * mg;
    *(GAS v4u*)dp = (v4u){w0[0], w0[1], w0[2], w0[3]}; *(GAS v4u*)(dp + (size_t)16 * D) = (v4u){w1[0], w1[1], w1[2], w1[3]};
}

__device__ __forceinline__ void p0_small_weights(Frame& F) {
    LAS float* scr = (LAS float*)(F.lds + F.wave * 8448);
    if (F.bid < 96) return;
    const int gw = (F.bid - 96) * 8 + F.wave, NGW = (F.G - 96) * 8;
    constexpr int I_T1 = 32 * 192, I_T2 = 128, I_T3 = 128, I_T4 = 128, I_T5 = 128, I_T6 = 32 * 64, I_T7 = 160 * 8, I_T8 = 32;
    constexpr int NITEMS = I_T1 + I_T2 + I_T3 + I_T4 + I_T5 + I_T6 + I_T7 + I_T8;
    bf16* BtIn = wsp<bf16>(F, WS_BTIN); bf16* BtL = wsp<bf16>(F, WS_BTL); bf16* BtOut = wsp<bf16>(F, WS_BTOUT); bf16* Wr = wsp<bf16>(F, WS_WR);
    for (int it = gw; it < NITEMS; it += NGW) {
        int r = it;
        if (r < I_T1) { const int kb = r / 192, nb = r % 192; tr_item(F.in[I_INW], PW, 64 * kb, 32 * nb, BtIn, nullptr, D, 32 * nb, 64 * kb, scr, F.lane); continue; } r -= I_T1;
        if (r < I_T2) { const int dir = r / 64, q = r % 64, kb = q / 2, nb = q % 2; tr_item(F.in[I_RW1] + (size_t)dir * D * 64, 64, 64 * kb, 32 * nb, BtIn, nullptr, D, 6144 + 64 * dir + 32 * nb, 64 * kb, scr, F.lane); continue; } r -= I_T2;
        if (r < I_T3) { const int dir = r / 64, q = r % 64, kb = q / 2, nb = q % 2; tr_item(F.in[I_RA1] + (size_t)dir * D * 64, 64, 64 * kb, 32 * nb, BtIn, nullptr, D, 6272 + 64 * dir + 32 * nb, 64 * kb, scr, F.lane); continue; } r -= I_T3;
        if (r < I_T4) { const int kb = r / 4, nb = r % 4; tr_item(F.in[I_RG1], 128, 64 * kb, 32 * nb, BtIn, nullptr, D, 6400 + 32 * nb, 64 * kb, scr, F.lane); continue; } r -= I_T4;
        if (r < I_T5) { const int kb = r / 4, nb = r % 4; tr_item(nullptr, 0, 0, 0, BtIn, nullptr, D, 6528 + 32 * nb, 64 * kb, scr, F.lane); continue; } r -= I_T5;
        if (r < I_T6) { const int kb = r / 64, nb = r % 64; f32x4 cv[8];
            ConvItem c; c.src = F.in[I_OUTW] + (size_t)(64 * kb) * D + 32 * nb; c.dst = (unsigned char*)BtOut + (size_t)(32 * nb) * D + 64 * kb;
            conv_issue(c, cv, F.lane); conv_finish(c, cv, scr, F.lane); continue; } r -= I_T6;
        if (r < I_T7) { const int nb = r / 8, kb = r % 8, j = nb / 32, n0 = (nb % 32) * 32; const float* src = nullptr; int k0 = 0;
            if (j == 0 && kb == 0) src = F.in[I_RW2];
            else if (j == 1 && kb == 1) src = F.in[I_RW2] + 64 * 1024;
            else if (j == 2 && kb == 2) src = F.in[I_RA2];
            else if (j == 3 && kb == 3) src = F.in[I_RA2] + 64 * 1024;
            else if (j == 4 && (kb == 4 || kb == 5)) { src = F.in[I_RG2]; k0 = 64 * (kb - 4); }
            tr_item(src, 1024, k0, n0, BtL, nullptr, KLORA, 32 * nb, 64 * kb, scr, F.lane); continue; } r -= I_T7;
        { const int kb = r; tr_item(F.in[I_ROUTW], 32, 64 * kb, 0, Wr, Wr + 32 * D, D, 0, 64 * kb, scr, F.lane); }
    }
}

__device__ __forceinline__ void p0_adaln(Frame& F) {
    if (F.bid >= 96) return;
    const int kh = F.bid / 48, cg = F.bid % 48, k0 = 1024 * kh + 128 * F.wave;
    LAS float* sc = (LAS float*)(F.lds + F.wave * 8704);
    for (int i = F.lane; i < 17 * 128; i += 64) { const int b = i / 128, k = i % 128; const float c = (b < 16) ? F.in[I_C][b * D + k0 + k] : F.in[I_CCTX][k0 + k]; sc[i] = c * fsigmoid(c); }
    LDS_WAIT(); asm volatile("" ::: "memory");
    const int col = cg * 256 + F.lane * 4;
    f32x4 acc[17];
#pragma unroll
    for (int b = 0; b < 17; ++b) acc[b] = (f32x4){0.f, 0.f, 0.f, 0.f};
    const float* W = F.in[I_ADAW] + (size_t)k0 * 12288 + col;
#pragma unroll 2
    for (int k = 0; k < 128; k += 4) {
        f32x4 w[4];
#pragma unroll
        for (int j = 0; j < 4; ++j) w[j] = *(const GAS f32x4*)(W + (size_t)(k + j) * 12288);
#pragma unroll
        for (int b = 0; b < 17; ++b) { const f32x4 s = *(const LAS f32x4*)(sc + b * 128 + k);
            acc[b] += s.x * w[0]; acc[b] += s.y * w[1]; acc[b] += s.z * w[2]; acc[b] += s.w * w[3]; }
    }
    __syncthreads();
    LAS f32x4* red = (LAS f32x4*)F.lds;
#pragma unroll
    for (int st = 4; st >= 1; st >>= 1) {
        if (F.wave >= st && F.wave < 2 * st) {
#pragma unroll
            for (int b = 0; b < 17; ++b) red[((F.wave - st) * 17 + b) * 64 + F.lane] = acc[b]; }
        __syncthreads();
        if (F.wave < st) {
#pragma unroll
            for (int b = 0; b < 17; ++b) acc[b] += red[(F.wave * 17 + b) * 64 + F.lane]; }
        __syncthreads();
    }
    if (F.wave == 0) { float* mp = wsp<float>(F, WS_MODACC) + (size_t)kh * 17 * 12288;
#pragma unroll
        for (int b = 0; b < 17; ++b) *(GAS f32x4*)(mp + (size_t)b * 12288 + col) = acc[b]; }
}
__device__ __forceinline__ f32x4 modv(const float* mp, const float* adab, int b, int idx) {
    return (*(const GAS f32x4*)(mp + (size_t)b * 12288 + idx) + *(const GAS f32x4*)(mp + (size_t)(17 + b) * 12288 + idx)) + *(const GAS f32x4*)(adab + idx);
}

__device__ __forceinline__ void p0_filter(Frame& F) {
    LAS float* hs = (LAS float*)(F.lds + 81920 + F.wave * 256);
    const int gw = F.bid * 8 + F.wave, NGW = F.G * 8, j = F.lane;
    const float freq = F.in[I_HFREQ][j];
    bf16* Gt = wsp<bf16>(F, WS_G);
    for (int t = gw; t < SEQ; t += NGW) {
        const float tl = (float)t * (1.0f / 2047.0f);
        float pre = F.in[I_HB1][j] + tl * F.in[I_HW1][j];
#pragma unroll 4
        for (int i = 0; i < 16; ++i) {
            const float band = 1e-4f + (float)i * ((15.0f - 1e-4f) / 15.0f);
            float rev = band * (float)t * (1.0f / 2048.0f); rev = rev - floorf(rev);
            const float cs = __builtin_amdgcn_cosf(rev), sn = __builtin_amdgcn_sinf(rev);
            pre += cs * F.in[I_HW1][(1 + i) * 64 + j] - sn * F.in[I_HW1][(17 + i) * 64 + j];
        }
        float h = __sinf(freq * pre);
        hs[j] = h; LDS_WAIT(); asm volatile("" ::: "memory");
        pre = F.in[I_HB2][j];
#pragma unroll 8
        for (int i = 0; i < 64; ++i) pre += hs[i] * F.in[I_HW2][i * 64 + j];
        h = __sinf(freq * pre);
        LDS_WAIT(); asm volatile("" ::: "memory");
        hs[j] = h; LDS_WAIT(); asm volatile("" ::: "memory");
        pre = F.in[I_HB3][j];
#pragma unroll 8
        for (int i = 0; i < 64; ++i) pre += hs[i] * F.in[I_HW3][i * 64 + j];
        h = __sinf(freq * pre);
        LDS_WAIT(); asm volatile("" ::: "memory");
        hs[j] = h; LDS_WAIT(); asm volatile("" ::: "memory");
        wsp<float>(F, WS_H3T)[(size_t)j * SEQ + t] = h;
        LDS_WAIT(); asm volatile("" ::: "memory");
    }
}
__device__ __forceinline__ void p1_filter_out(Frame& F) {
    LAS float* ws4 = (LAS float*)(F.lds + F.wave * 8192);
    const int gw = F.bid * 8 + F.wave, NGW = F.G * 8, lane = F.lane;
    const float* H3T = wsp<float>(F, WS_H3T); bf16* Gt = wsp<bf16>(F, WS_G);
    for (int u = gw; u < 64 * 32; u += NGW) {
        const int cb = u >> 5, tb = u & 31, c0 = 16 * cb, t = 64 * tb + lane;
#pragma unroll
        for (int k = 0; k < 8; ++k) { const int n = (k < 4) ? c0 + 4 * k : 1024 + c0 + 4 * (k - 4);
            *(LAS f32x4*)(ws4 + lane * 32 + 4 * k) = *(const GAS f32x4*)(F.in[I_HW4] + (size_t)lane * 2048 + n); }
        LDS_WAIT(); asm volatile("" ::: "memory");
        f32x4 o[8];
#pragma unroll
        for (int k = 0; k < 8; ++k) o[k] = (f32x4){0.f, 0.f, 0.f, 0.f};
#pragma unroll 1
        for (int ig = 0; ig < 8; ++ig) { float hh[8];
#pragma unroll
            for (int i = 0; i < 8; ++i) hh[i] = H3T[(size_t)(8 * ig + i) * SEQ + t];
#pragma unroll
            for (int i = 0; i < 8; ++i) {
#pragma unroll
                for (int k = 0; k < 8; ++k) o[k] += hh[i] * *(const LAS f32x4*)(ws4 + (8 * ig + i) * 32 + 4 * k); } }
        const float tl = (float)t * (1.0f / 2047.0f);
        const float dlo = -3.0701134573253945f, dhi = -15.350567286626973f;
#pragma unroll
        for (int k = 0; k < 8; ++k)
#pragma unroll
            for (int q = 0; q < 4; ++q) { const int c = c0 + 4 * (k & 3) + q;
                const float delta = fabsf(dlo + (dhi - dlo) * ((float)c * (1.0f / 1023.0f)));
                const float val = o[k][q] * __expf(-tl * delta);
                if (k < 4) Gt[(size_t)c * 4096 + (2048 - t)] = (bf16)f2bf(val);
                else if (t > 0) Gt[(size_t)c * 4096 + (2048 + t)] = (bf16)f2bf(val);
                else Gt[(size_t)c * 4096] = 0; }
        LDS_WAIT(); asm volatile("" ::: "memory");
    }
}

__device__ __forceinline__ void p1_norm1(Frame& F) {
    const int lane = F.lane;
    const float* macc = wsp<float>(F, WS_MODACC); const float* adab = F.in[I_ADAB];
    bf16* A1 = wsp<bf16>(F, WS_A1);
    constexpr int RPB = MROWS / 256; static_assert(RPB * 256 == MROWS && RPB == 144, "rows per workgroup");
    const int rbase = RPB * F.bid, blo = rbase < NLAT ? rbase / SEQ : 16;
    LAS float* TL = (LAS float*)(F.lds + 65536);
    { const int c = 4 * F.tid; const f32x4 g = *(const GAS f32x4*)(F.in[I_N1G] + c);
#pragma unroll
        for (int tb = 0; tb < 2; ++tb) { const int b = blo + tb < 16 ? blo + tb : 16;
            const f32x4 sh = modv(macc, adab, b, c), sc = modv(macc, adab, b, 2048 + c);
            *(LAS f32x4*)(TL + (tb * 2 + 0) * 2048 + c) = g * (1.0f + sc); *(LAS f32x4*)(TL + (tb * 2 + 1) * 2048 + c) = sh; } }
    __syncthreads();
    f32x4 va[2][8], vb[2][8];
#define N1_XROW(row) ((row) < NLAT ? F.in[I_X] + (size_t)(row) * D : F.in[I_CTX] + (size_t)((row) - NLAT) * D)
#define N1_LOAD(buf, it_) do { _Pragma("unroll") for (int r = 0; r < 2; ++r) { const int row = rbase + 8 * ((it_) + r) + F.wave; const float* xr = N1_XROW(row) + 8 * lane; \
        _Pragma("unroll") for (int j = 0; j < 4; ++j) { buf[r][2 * j] = *(const GAS f32x4*)(xr + 512 * j); buf[r][2 * j + 1] = *(const GAS f32x4*)(xr + 512 * j + 4); } } } while (0)
#define N1_PROC(buf, it_) do { _Pragma("unroll") for (int r = 0; r < 2; ++r) { const int row = rbase + 8 * ((it_) + r) + F.wave; const int b = row < NLAT ? row / SEQ : 16; \
        const LAS float* T0 = TL + (b - blo) * 4096 + 8 * lane; float ss = 0.f; \
        _Pragma("unroll") for (int j = 0; j < 8; ++j) ss += (buf[r][j].x * buf[r][j].x + buf[r][j].y * buf[r][j].y) + (buf[r][j].z * buf[r][j].z + buf[r][j].w * buf[r][j].w); \
        const float rstd = __builtin_amdgcn_rsqf(wave_sum(ss) * (1.0f / D) + 1e-6f); \
        _Pragma("unroll") for (int j = 0; j < 4; ++j) { \
            const f32x4 y0 = buf[r][2 * j] * rstd * *(const LAS f32x4*)(T0 + 512 * j) + *(const LAS f32x4*)(T0 + 2048 + 512 * j); \
            const f32x4 y1 = buf[r][2 * j + 1] * rstd * *(const LAS f32x4*)(T0 + 512 * j + 4) + *(const LAS f32x4*)(T0 + 2048 + 512 * j + 4); \
            v4u o; o.x = pk2(y0.x, y0.y); o.y = pk2(y0.z, y0.w); o.z = pk2(y1.x, y1.y); o.w = pk2(y1.z, y1.w); \
            *(GAS v4u*)(A1 + (size_t)row * D + 8 * lane + 512 * j) = o; } } } while (0)
    N1_LOAD(va, 0);
    for (int it = 0; it < 16; it += 4) { N1_LOAD(vb, it + 2); N1_PROC(va, it); N1_LOAD(va, it + 4); N1_PROC(vb, it + 2); }
    N1_PROC(va, 16);
#undef N1_XROW
#undef N1_LOAD
#undef N1_PROC
    if (F.bid < 16) { const int b = F.bid; float* T = wsp<float>(F, WS_MODT) + (size_t)b * 6144;
        for (int k = 4 * F.tid; k < D; k += 2048) { const f32x4 sh = modv(macc, adab, b, 3 * 2048 + k), sc = modv(macc, adab, b, 4 * 2048 + k);
            *(GAS f32x4*)(T + k) = *(const GAS f32x4*)(F.in[I_N2G] + k) * (1.0f + sc); *(GAS f32x4*)(T + 2048 + k) = sh; *(GAS f32x4*)(T + 4096 + k) = modv(macc, adab, b, 5 * 2048 + k); } }
}

namespace pg8 {
__device__ __forceinline__ void static_unit(int L, int nM, int nN, Unit& u) {
    const int nwg = nM * nN; int wgid = L;
    { const int q = nwg / NXCD, r = nwg % NXCD, xcd = wgid % NXCD, off = wgid / NXCD; wgid = (xcd < r ? xcd * (q + 1) : r * (q + 1) + (xcd - r) * q) + off; }
    const int nig = WGM * nN, gid = wgid / nig, fm = gid * WGM, gsz = (nM - fm) < WGM ? (nM - fm) : WGM;
    u.pm = fm + ((wgid % nig) % gsz); u.pn = (wgid % nig) / gsz; u.e = 0;
}
struct StaticOrder {
    int nM, nN, nwg, G, c;
    __device__ void init(int M, int N, int G_, int c_) { nM = M / BM; nN = N / BM; nwg = nM * nN; G = G_; c = c_; }
    __device__ __forceinline__ bool next(int i, Unit& u) const { const long L = (long)i * G + c; if (L >= nwg) return false; static_unit((int)L, nM, nN, u); return true; }
    __device__ __forceinline__ int arow(const Unit&, int) const { return 0; }
};
struct InProjOrder {
    int G, c;
    __device__ __forceinline__ bool next(int i, Unit& u) const {
        long L = (long)i * G + c;
        if (L < 128 * 26) { static_unit((int)L, 128, 26, u); return true; }
        L -= 128 * 26; if (L >= 16 * 13) return false;
        u.pm = 128 + (int)(L % 16); u.pn = 12 + (int)(L / 16); u.e = 0; return true;
    }
    __device__ __forceinline__ int arow(const Unit&, int) const { return 0; }
};
struct MoeOrder {
    int G, c, nN, ntiles; unsigned char* ws;
    __device__ __forceinline__ bool next(int i, Unit& u) const {
        const int x = c % 8, idx = c / 8, TR = 256 / nN, th = TR / 4, pw = nN / 2;
        u.pm = i * TR + (x >> 1) * th + idx / pw; u.pn = (x & 1) * pw + idx % pw;
        if (u.pm >= ntiles) return false;
        u.e = ((const int*)(ws + WS_ETAB))[256 + u.pm]; return true;
    }
    __device__ __forceinline__ int arow(const Unit& u, int r) const { const int* et = (const int*)(ws + WS_ETAB); const int row = u.pm * 256 + r; const bool valid = (row - et[u.e]) < et[64 + u.e]; return valid ? ((const int*)(ws + WS_ROWTOK))[row] : 0; }
};

struct EpiInProj {
    static constexpr bool PERM = true;
    bf16* Z; bf16* AP;
    __device__ __forceinline__ void operator()(const f32x4 (&acc)[2][2][4][2], const Unit& u, int wr, int wc, int fr, int fq) const {
        const int row0 = u.pm * BM + wr * 64 + fr;
        const bool lora = u.pn >= 24;
        bf16* base = lora ? AP + (u.pn - 24) * BM : Z + (size_t)u.pn * MROWS * 256; const int ldc = lora ? KLORA : 256;
        const int col0 = wc * 32 + 8 * fq;
#pragma unroll
        for (int ai = 0; ai < 2; ++ai)
#pragma unroll
            for (int m = 0; m < 4; ++m) { bf16* rowp = base + (size_t)(row0 + ai * HALF + m * 16) * ldc + col0;
#pragma unroll
                for (int bj = 0; bj < 2; ++bj) { f32x4 v0 = acc[ai][bj][m][0], v1 = acc[ai][bj][m][1];
                    if (lora) { const int act = (u.pn == 24) ? (bj == 0 ? 1 : 0) : (bj == 0 ? 2 : 0);
                        if (act == 1) {
#pragma unroll
                            for (int j = 0; j < 4; ++j) { v0[j] = ftanh(v0[j]); v1[j] = ftanh(v1[j]); } }
                        if (act == 2) {
#pragma unroll
                            for (int j = 0; j < 4; ++j) { v0[j] = fsigmoid(v0[j]); v1[j] = fsigmoid(v1[j]); } } }
                    v4u w; w.x = cvt_pk_bf16(v0[0], v0[1]); w.y = cvt_pk_bf16(v0[2], v0[3]); w.z = cvt_pk_bf16(v1[0], v1[1]); w.w = cvt_pk_bf16(v1[2], v1[3]);
                    *(v4u*)(rowp + bj * HALF) = w; } }
    }
};
struct EpiLora {
    static constexpr bool PERM = true;
    bf16* EA; const float* w0; const float* a0; int pn0;
    __device__ __forceinline__ void operator()(const f32x4 (&acc)[2][2][4][2], const Unit& u, int wr, int wc, int fr, int fq) const {
        const int pn = u.pn + pn0, row0 = u.pm * BM + wr * 64 + fr, col0 = pn * BM + wc * 32 + 8 * fq;
        const int blk = pn >> 2;
        const float* bias = blk < 2 ? w0 + col0 : (blk < 4 ? a0 + (col0 - 2048) : nullptr);
        const float scale = blk < 2 ? 0.60653065971263342f * 1.4426950408889634f : 1.0f;
        f32x4 bv[2][2];
#pragma unroll
        for (int bj = 0; bj < 2; ++bj)
#pragma unroll
            for (int n = 0; n < 2; ++n) bv[bj][n] = bias ? *(const f32x4*)(bias + bj * HALF + 4 * n) : (f32x4){0.f, 0.f, 0.f, 0.f};
#pragma unroll
        for (int ai = 0; ai < 2; ++ai)
#pragma unroll
            for (int m = 0; m < 4; ++m) { bf16* rowp = EA + (size_t)(row0 + ai * HALF + m * 16) * NLORA + col0;
#pragma unroll
                for (int bj = 0; bj < 2; ++bj) { f32x4 v0 = acc[ai][bj][m][0] + bv[bj][0], v1 = acc[ai][bj][m][1] + bv[bj][1];
                    if (blk < 4) {
#pragma unroll
                        for (int j = 0; j < 4; ++j) { v0[j] = scale * fsigmoid(v0[j]); v1[j] = scale * fsigmoid(v1[j]); } }
                    v4u w; w.x = cvt_pk_bf16(v0[0], v0[1]); w.y = cvt_pk_bf16(v0[2], v0[3]); w.z = cvt_pk_bf16(v1[0], v1[1]); w.w = cvt_pk_bf16(v1[2], v1[3]);
                    *(v4u*)(rowp + bj * HALF) = w; } }
    }
};
struct EpiOutProj {
    static constexpr bool PERM = false;
    const float* X; bf16* X1; const float* macc; const float* adab; float* SSQ;
    __device__ __forceinline__ void operator()(const f32x4 (&acc)[2][2][4][2], const Unit& u, int wr, int wc, int fr, int fq) const {
        const int row0 = u.pm * BM + wr * 64 + fr, col0 = u.pn * BM + wc * 32 + 4 * fq;
        const int b = (u.pm * BM) / SEQ;
        f32x4 gv[2][2];
#pragma unroll
        for (int bj = 0; bj < 2; ++bj)
#pragma unroll
            for (int n = 0; n < 2; ++n) { const int c = col0 + bj * HALF + n * 16; gv[bj][n] = modv(macc, adab, b, 2 * 2048 + c) * (1.0f / 256.0f); }
#pragma unroll
        for (int ai = 0; ai < 2; ++ai) {
            f32x4 xq[4][2][2];
#pragma unroll
            for (int m = 0; m < 4; ++m) { const size_t off = (size_t)(row0 + ai * HALF + m * 16) * D + col0;
#pragma unroll
                for (int bj = 0; bj < 2; ++bj)
#pragma unroll
                    for (int n = 0; n < 2; ++n) xq[m][bj][n] = *(const f32x4*)(X + off + bj * HALF + n * 16); }
            asm volatile("" ::: "memory");
#pragma unroll
            for (int m = 0; m < 4; ++m) { const int row = row0 + ai * HALF + m * 16; const size_t off = (size_t)row * D + col0; float sq[2] = {0.f, 0.f};
#pragma unroll
                for (int bj = 0; bj < 2; ++bj)
#pragma unroll
                    for (int n = 0; n < 2; ++n) { const f32x4 xv = xq[m][bj][n]; const f32x4 o = xv + gv[bj][n] * acc[ai][bj][m][n]; { v2u ob; ob.x = pk2(o.x, o.y); ob.y = pk2(o.z, o.w); *(v2u*)(X1 + off + bj * HALF + n * 16) = ob; }
                        sq[bj] += (o.x * o.x + o.y * o.y) + (o.z * o.z + o.w * o.w); }
#pragma unroll
                for (int bj = 0; bj < 2; ++bj) { float t = sq[bj]; t += __shfl_xor(t, 16); t += __shfl_xor(t, 32); if (fq == 0) SSQ[(size_t)row * 64 + u.pn * 8 + bj * 4 + wc] = t; } } }
    }
};
__device__ __forceinline__ unsigned pk4_fp8(float a, float b, float c, float d) { int w = __builtin_amdgcn_cvt_pk_fp8_f32(a, b, 0, false); w = __builtin_amdgcn_cvt_pk_fp8_f32(c, d, w, true); return (unsigned)w; }
struct EpiSwiglu {
    static constexpr bool PERM = true;
    unsigned char* ws; const float* bg; const float* bu;
    __device__ __forceinline__ void operator()(const f32x4 (&acc)[2][2][4][2], const Unit& u, int wr, int wc, int fr, int fq) const {
        const int row0 = u.pm * BM + wr * 64 + fr, col0 = u.pn * HALF + wc * 32 + 8 * fq;
        const float* pg = bg + (size_t)u.e * 2048 + col0; const float* pu = bu + (size_t)u.e * 2048 + col0;
        f32x4 bgv[2], buv[2];
#pragma unroll
        for (int n = 0; n < 2; ++n) { bgv[n] = *(const f32x4*)(pg + 4 * n); buv[n] = *(const f32x4*)(pu + 4 * n); }
#pragma unroll
        for (int ai = 0; ai < 2; ++ai)
#pragma unroll
            for (int m = 0; m < 4; ++m) { unsigned char* rowp = ws + WS_ACT + (size_t)(row0 + ai * HALF + m * 16) * 2048 + col0; float o[8];
#pragma unroll
                for (int n = 0; n < 2; ++n) { const f32x4 gq = acc[ai][0][m][n] * (1.0f / 64.0f) + bgv[n], uq = acc[ai][1][m][n] * (1.0f / 64.0f) + buv[n];
#pragma unroll
                    for (int j = 0; j < 4; ++j) { const float gg = fminf(gq[j], 7.0f), uu = fminf(fmaxf(uq[j], -7.0f), 7.0f);
                        const float t = gg * __builtin_amdgcn_rcpf(1.0f + __builtin_amdgcn_exp2f(-2.4554669595930156f * gg));
                        o[4 * n + j] = __builtin_fmaf(uu, t, t); } }
                v2u w; w.x = pk4_fp8(o[0], o[1], o[2], o[3]); w.y = pk4_fp8(o[4], o[5], o[6], o[7]);
                *(v2u*)rowp = w; }
    }
};
struct EpiDown {
    static constexpr bool PERM = true;
    unsigned char* ws; const float* bd;
    __device__ __forceinline__ void operator()(const f32x4 (&acc)[2][2][4][2], const Unit& u, int wr, int wc, int fr, int fq) const {
        const int row0 = u.pm * BM + wr * 64 + fr, col0 = u.pn * BM + wc * 32 + 8 * fq;
        const float* pb = bd + (size_t)u.e * 2048 + col0;
        const int* et = (const int*)(ws + WS_ETAB); const int lim = et[u.e] + et[64 + u.e];
        const int* rowdst = (const int*)(ws + WS_ROWDST); const float* rowgate = (const float*)(ws + WS_ROWGATE); unsigned char* SLOT = ws + WS_SLOT;
        f32x4 bv[2][2];
#pragma unroll
        for (int bj = 0; bj < 2; ++bj)
#pragma unroll
            for (int n = 0; n < 2; ++n) bv[bj][n] = *(const f32x4*)(pb + bj * HALF + 4 * n);
        int dsts[8]; float gts[8];
#pragma unroll
        for (int i = 0; i < 8; ++i) { const int row = row0 + (i >> 2) * HALF + (i & 3) * 16, rc = row < lim ? row : lim - 1; dsts[i] = rowdst[rc]; gts[i] = 16.0f * rowgate[rc]; }
#pragma unroll
        for (int ai = 0; ai < 2; ++ai)
#pragma unroll
            for (int m = 0; m < 4; ++m) { const int row = row0 + ai * HALF + m * 16;
                if (row < lim) { const float gt = gts[ai * 4 + m]; unsigned char* rowp = SLOT + (size_t)dsts[ai * 4 + m] * 2048 + col0;
#pragma unroll
                    for (int bj = 0; bj < 2; ++bj) { const f32x4 v0 = (acc[ai][bj][m][0] * (1.0f / 64.0f) + bv[bj][0]) * gt, v1 = (acc[ai][bj][m][1] * (1.0f / 64.0f) + bv[bj][1]) * gt;
                        v2u w; w.x = pk4_fp8(v0[0], v0[1], v0[2], v0[3]); w.y = pk4_fp8(v1[0], v1[1], v1[2], v1[3]);
                        *(v2u*)(rowp + bj * HALF) = w; } } }
    }
};
}

__device__ __forceinline__ f32x4 unpk4(v2u w) { return (f32x4){bflo(w.x), bfhi(w.x), bflo(w.y), bfhi(w.y)}; }
__device__ __forceinline__ v2u pk4(f32x4 v) { v2u o; o.x = pk2(v.x, v.y); o.y = pk2(v.z, v.w); return o; }
__device__ __forceinline__ f32x4 ldz4(const bf16* p, bool ok) { return ok ? unpk4(*(const GAS v2u*)p) : (f32x4){0.f, 0.f, 0.f, 0.f}; }

__device__ __forceinline__ void p4_prep(Frame& F) {
    const int gw = F.bid * 8 + F.wave, NGW = F.G * 8, lane = F.lane;
    const bf16* Z = wsp<bf16>(F, WS_Z); const bf16* EA = wsp<bf16>(F, WS_EA); float* KI = wsp<float>(F, WS_KKINV); bf16* ZC = wsp<bf16>(F, WS_ZC);
    bf16* UT = wsp<bf16>(F, WS_UT); bf16* X0T = wsp<bf16>(F, WS_X0T); float* BS = wsp<float>(F, WS_BS);
    const float* cw = F.in[I_CONVW]; const float* cb = F.in[I_CONVB];
#define ZB(cblk, row) (Z + ((size_t)(cblk) * MROWS + (size_t)(row)) * 256 + 4 * lane)
    constexpr int NU_LAT = 16 * 64 * 8, NU = NU_LAT + 16 * 32 * 4;
    for (int u = gw; u < NU; u += NGW) {
        int b, t0, slice, ng8; bool lat;
        if (u < NU_LAT) { lat = true; const int w = u % 8, blk = u / 8, sp = blk % 4, cg = (blk / 4) % 16; b = blk / 64;
            t0 = (4 * cg + (w % 4)) * 32; slice = sp + 4 * (w / 4); ng8 = 4; }
        else { lat = false; const int v = u - NU_LAT; b = v / 128; t0 = ((v % 128) / 4) * 8; slice = 4 + (v % 4); ng8 = 1; }
        const int Ls = lat ? SEQ : CTXL, rowbase = lat ? b * SEQ : NLAT + b * CTXL;
        if (slice < 4) {
            const int c0 = 256 * slice + 4 * lane;
            f32x4 w[3][3], bi[3];
#pragma unroll
            for (int a = 0; a < 3; ++a) { bi[a] = *(const GAS f32x4*)(cb + a * 1024 + c0);
#pragma unroll
                for (int tp = 0; tp < 3; ++tp) w[a][tp] = *(const GAS f32x4*)(cw + (size_t)tp * PW + a * 1024 + c0); }
            f32x4 pv[3], cu[3];
#pragma unroll
            for (int a = 0; a < 3; ++a) { pv[a] = ldz4(ZB(a * 4 + slice, rowbase + t0 - 1), t0 > 0); cu[a] = ldz4(ZB(a * 4 + slice, rowbase + t0), true); }
            v2u raw[8][3];
#define PZ_LD(cblk, tt) (*(const GAS v2u*)ZB((cblk), rowbase + ((tt) < Ls ? (tt) : Ls - 1)))
#pragma unroll
            for (int i = 0; i < 8; ++i)
#pragma unroll
                for (int a = 0; a < 3; ++a) raw[i][a] = PZ_LD(a * 4 + slice, t0 + i + 1);
#define HY_GROUP(G8, REFILL) { float x0v[4][8], uv[4][8]; \
                _Pragma("unroll") for (int i = 0; i < 8; ++i) { const int t = t0 + 8 * (G8) + i; f32x4 zc[3]; \
                    _Pragma("unroll") for (int a = 0; a < 3; ++a) { f32x4 nx = unpk4(raw[i][a]); if (!(t + 1 < Ls)) nx = (f32x4){0.f, 0.f, 0.f, 0.f}; \
                        if (REFILL) raw[i][a] = PZ_LD(a * 4 + slice, t + 9); \
                        zc[a] = pv[a] * w[a][0] + cu[a] * w[a][1] + nx * w[a][2] + bi[a]; pv[a] = cu[a]; cu[a] = nx; } \
                    const f32x4 uu = zc[2] * zc[1]; \
                    _Pragma("unroll") for (int j = 0; j < 4; ++j) { x0v[j][i] = zc[0][j]; uv[j][i] = uu[j]; } } \
                _Pragma("unroll") for (int j = 0; j < 4; ++j) { const size_t o = ((size_t)(c0 + j) * 16 + b) * SEQ + t0 + 8 * (G8); \
                    v4u a, c; a.x = pk2(x0v[j][0], x0v[j][1]); a.y = pk2(x0v[j][2], x0v[j][3]); a.z = pk2(x0v[j][4], x0v[j][5]); a.w = pk2(x0v[j][6], x0v[j][7]); \
                    c.x = pk2(uv[j][0], uv[j][1]); c.y = pk2(uv[j][2], uv[j][3]); c.z = pk2(uv[j][4], uv[j][5]); c.w = pk2(uv[j][6], uv[j][7]); \
                    *(GAS v4u*)(X0T + o) = a; *(GAS v4u*)(UT + o) = c; } }
            for (int g8 = 0; g8 < 3; ++g8) HY_GROUP(g8, true)
            HY_GROUP(3, false)
#undef HY_GROUP
        } else {
            const int q = slice - 4, c0 = 256 * q + 4 * lane;
            f32x4 w[3][3], bi[3];
#pragma unroll
            for (int a = 0; a < 3; ++a) { bi[a] = *(const GAS f32x4*)(cb + 3072 + a * 1024 + c0);
#pragma unroll
                for (int tp = 0; tp < 3; ++tp) w[a][tp] = *(const GAS f32x4*)(cw + (size_t)tp * PW + 3072 + a * 1024 + c0); }
            const f32x4 kkw = *(const GAS f32x4*)(F.in[I_RKK] + c0), kaw = *(const GAS f32x4*)(F.in[I_RKA] + c0), rkw = *(const GAS f32x4*)(F.in[I_RRK] + c0);
            f32x4 pv[3], cu[3];
#pragma unroll
            for (int a = 0; a < 3; ++a) { pv[a] = ldz4(ZB(12 + a * 4 + q, rowbase + t0 - 1), t0 > 0); cu[a] = ldz4(ZB(12 + a * 4 + q, rowbase + t0), true); }
            v2u raw[8][3], ra[8][2];
#pragma unroll
            for (int i = 0; i < 8; ++i) { const bf16* ep = EA + (size_t)(rowbase + t0 + i) * NLORA + 2048 + c0;
#pragma unroll
                for (int a = 0; a < 3; ++a) raw[i][a] = PZ_LD(12 + a * 4 + q, t0 + i + 1);
                ra[i][0] = *(const GAS v2u*)ep; ra[i][1] = *(const GAS v2u*)(ep + 1024); }
#define RW_GROUP(G8, REFILL) { \
                _Pragma("unroll") for (int i = 0; i < 8; ++i) { const int t = t0 + 8 * (G8) + i, row = rowbase + t; f32x4 zc[3]; \
                    _Pragma("unroll") for (int a = 0; a < 3; ++a) { f32x4 nx = unpk4(raw[i][a]); if (!(t + 1 < Ls)) nx = (f32x4){0.f, 0.f, 0.f, 0.f}; \
                        if (REFILL) raw[i][a] = PZ_LD(12 + a * 4 + q, t + 9); \
                        zc[a] = pv[a] * w[a][0] + cu[a] * w[a][1] + nx * w[a][2] + bi[a]; pv[a] = cu[a]; cu[a] = nx; } \
                    const f32x4 a0 = unpk4(ra[i][0]), a1 = unpk4(ra[i][1]); \
                    if (REFILL) { const bf16* ep = EA + (size_t)(row + 8) * NLORA + 2048 + c0; ra[i][0] = *(const GAS v2u*)ep; ra[i][1] = *(const GAS v2u*)(ep + 1024); } \
                    const f32x4 zr = zc[0], zk = zc[1]; \
                    const f32x4 kk = zk * kkw; \
                    const float n2 = row16_sum((kk.x * kk.x + kk.y * kk.y) + (kk.z * kk.z + kk.w * kk.w)); \
                    const float inv = 1.0f / fmaxf(sqrtf(n2), 1e-12f); \
                    const f32x4 bt = zr * zk * (2.0f + (a0 + a1 - 2.0f) * kaw) * rkw; \
                    const float bsum = row16_sum((bt.x + bt.y) + (bt.z + bt.w)); \
                    bf16* zo = ZC + ((size_t)(4 * q + (lane >> 4)) * MROWS + row) * 192 + 4 * (lane & 15);         \
                    *(GAS v2u*)(zo) = pk4(zr); *(GAS v2u*)(zo + 64) = pk4(zk); *(GAS v2u*)(zo + 128) = pk4(zc[2]); \
                    if ((lane & 15) == 0) { KI[(size_t)row * 16 + 4 * q + (lane >> 4)] = inv; if (lat) BS[(size_t)row * 16 + 4 * q + (lane >> 4)] = bsum; } } }
            for (int g8 = 0; g8 < ng8 - 1; ++g8) RW_GROUP(g8, true)
            RW_GROUP(ng8 - 1, false)
#undef RW_GROUP
#undef PZ_LD
        }
    }
}
#undef ZB

typedef short bf16x4 __attribute__((ext_vector_type(4)));
__device__ __forceinline__ int scan_row(int s, int dir, int b) {
    return s < CTXL ? NLAT + b * CTXL + (dir ? CTXL - 1 - s : s) : b * SEQ + (dir ? SEQ - 1 - (s - CTXL) : (s - CTXL));
}
__device__ __forceinline__ bf16x4 pack4(f32x4 v) { v2u o; o.x = pk2(v.x, v.y); o.y = pk2(v.z, v.w); return __builtin_bit_cast(bf16x4, o); }
__device__ __forceinline__ bf16x8 cat8(bf16x4 a, bf16x4 b) { return __builtin_shufflevector(a, b, 0, 1, 2, 3, 4, 5, 6, 7); }
#define MF16(a, b, c) __builtin_amdgcn_mfma_f32_16x16x32_bf16(cat8((a), (bf16x4){0, 0, 0, 0}), cat8((b), (bf16x4){0, 0, 0, 0}), (c), 0, 0, 0)
#define MF32(a, b, c) __builtin_amdgcn_mfma_f32_16x16x32_bf16((a), (b), (c), 0, 0, 0)
template <int CTRL> __device__ __forceinline__ float dpp_shr0(float x) { return __builtin_bit_cast(float, __builtin_amdgcn_update_dpp(0, __builtin_bit_cast(int, x), CTRL, 0xF, 0xF, true)); }
__device__ __forceinline__ float row16_incl_scan(float x) { x += dpp_shr0<0x111>(x); x += dpp_shr0<0x112>(x); x += dpp_shr0<0x114>(x); x += dpp_shr0<0x118>(x); return x; }
constexpr int SC_AT = 0, SC_RT = 2304, SC_BT = 4608, SC_KT = 6912, SC_BHT = 9216, SC_KHT = 11264, SC_VT = 13312, SC_GC = 15360, SC_BUF = 15616, SC_CW = 2 * SC_BUF, SC_CHAIN = 2 * SC_BUF + 14 * 256;
#define SCAN_BODY(CKX, ldcur, ldnext) { const int ck = (CKX); const int p = ck & 1; if (ck + 3 < NCK) SCAN_ISSUE(ldcur, ck + 3); \
            ConvItem cvi; cvi.src = nullptr; cvi.dst = nullptr; const bool cvon = ck < NCONV; if (cvon) { cvi = conv_item(F, gwv + ck * NGWV); conv_issue_m(cvi, cv, lane); } \
            const LAS unsigned char* d = cb + p * SC_BUF; \
            bf16x8 Af[2], Rf[2], Bf[2], Kf[2]; \
_Pragma("unroll") \
            for (int m = 0; m < 2; ++m) { const int o = lr * 144 + m * 64 + q * 16; \
                Af[m] = *(const LAS bf16x8*)(d + SC_AT + o); Rf[m] = *(const LAS bf16x8*)(d + SC_RT + o); Bf[m] = *(const LAS bf16x8*)(d + SC_BT + o); Kf[m] = *(const LAS bf16x8*)(d + SC_KT + o); } \
            const bf16x4 Vf = *(const LAS bf16x4*)(d + SC_VT + (16 * w4 + lr) * 32 + 8 * q); \
            f32x4 GabT = MF32(Bf[0], Af[0], zero4); GabT = MF32(Bf[1], Af[1], GabT); \
            f32x4 Gab = MF32(Af[0], Bf[0], zero4); Gab = MF32(Af[1], Bf[1], Gab); \
            f32x4 GakT = MF32(Kf[0], Af[0], zero4); GakT = MF32(Kf[1], Af[1], GakT); \
            f32x4 GrbT = MF32(Bf[0], Rf[0], zero4); GrbT = MF32(Bf[1], Rf[1], GrbT); \
            f32x4 GrkT = MF32(Kf[0], Rf[0], zero4); GrkT = MF32(Kf[1], Rf[1], GrkT); \
_Pragma("unroll") \
            for (int j = 0; j < 4; ++j) { const int i = 4 * q + j; \
                GabT[j] = (i < lr) ? GabT[j] : 0.f; GakT[j] = (i < lr) ? GakT[j] : 0.f; GrbT[j] = (i <= lr) ? GrbT[j] : 0.f; GrkT[j] = (i <= lr) ? GrkT[j] : 0.f; \
                Gab[j] = (lr < i) ? Gab[j] : 0.f; } \
            const bf16x4 LakA = pack4(GakT), LrbA = pack4(GrbT), LrkA = pack4(GrkT); \
            f32x4 X = GabT, Y = Gab, Tt = GabT; \
_Pragma("unroll") \
            for (int j = 0; j < 4; ++j) Tt[j] += (4 * q + j == lr) ? 1.0f : 0.f; \
_Pragma("unroll") \
            for (int lv = 0; lv < 3; ++lv) { const bf16x4 x = pack4(X), y = pack4(Y); \
                const f32x4 Y2 = MF16(x, y, zero4), X2 = MF16(y, x, zero4); \
                Tt = MF16(pack4(Y2), pack4(Tt), Tt); \
                X = X2; Y = Y2; } \
            const bf16x4 TinvA = pack4(Tt); \
            bf16x4 Sb[4]; \
_Pragma("unroll") \
            for (int kb = 0; kb < 4; ++kb) Sb[kb] = pack4(ST[kb]); \
            const bf16x8 SB0 = cat8(Sb[0], Sb[1]), SB1 = cat8(Sb[2], Sb[3]); \
            f32x4 W = MF16(LakA, Vf, zero4); W = MF32(Af[0], SB0, W); W = MF32(Af[1], SB1, W); \
            const f32x4 U = MF16(TinvA, pack4(W), zero4); \
            const bf16x4 Ub = pack4(U); \
            f32x4 Yt = MF16(LrkA, Vf, zero4); Yt = MF32(Rf[0], SB0, Yt); Yt = MF32(Rf[1], SB1, Yt); Yt = MF16(LrbA, Ub, Yt); \
_Pragma("unroll") \
            for (int kb = 0; kb < 4; ++kb) { const f32x4 g = *(const LAS f32x4*)(d + SC_GC + (16 * kb + 4 * q) * 4); \
                const bf16x4 bh = *(const LAS bf16x4*)(d + SC_BHT + (16 * kb + lr) * 32 + 8 * q), kh = *(const LAS bf16x4*)(d + SC_KHT + (16 * kb + lr) * 32 + 8 * q); \
                f32x4 s = ST[kb] * g; s = MF16(bh, Ub, s); s = MF16(kh, Vf, s); ST[kb] = s; } \
            if (ck >= CTXL / 16) { \
_Pragma("unroll") \
                for (int j = 0; j < 4; ++j) { const unsigned row = (unsigned)scan_row(ck * 16 + 4 * q + j, dir, b); *(GAS float*)((char*)YS + (((unsigned)dir * NLAT + row) * 4096u + 4u * (unsigned)(h * 64 + 16 * w4 + lr))) = Yt[j]; } } \
            if (cvon) conv_finish_m(cvi, cv, csel, lane); \
            if (ck + 1 < NCK) SCAN_COMMIT(ldnext, p ^ 1); \
            __syncthreads(); }
__device__ __forceinline__ void p5_scan(Frame& F) {
    const int cwv = F.wave >> 2, w4 = F.wave & 3, lane = F.lane, tc = F.tid & 255, q = lane >> 4, lr = lane & 15;
    const bf16* ZC = wsp<bf16>(F, WS_ZC); const bf16* EA = wsp<bf16>(F, WS_EA); const float* KI = wsp<float>(F, WS_KKINV); float* YS = wsp<float>(F, WS_YS);
    for (int cp = F.bid; cp < 256; cp += F.G) {
        const int chain = cp * 2 + cwv, dir = chain >> 8, b = (chain >> 4) & 15, h = chain & 15;
        LAS unsigned char* cb = F.lds + cwv * SC_CHAIN;
        const int sl = lr, jc = 4 * w4 + q, coff = h * 64 + 4 * jc;
        const int ppos = 32 * (jc >> 3) + 8 * (jc & 3) + 4 * ((jc >> 2) & 1);
        v2u ld0[6], ld1[6], ld2[6];
#define SCAN_ISSUE(ld, ck_) do { const unsigned row_ = (unsigned)scan_row((ck_) * 16 + sl, dir, b); const char* zp_ = (const char*)ZC + (((unsigned)h * MROWS + row_) * 384u + 8u * (unsigned)jc); \
            ld[0] = *(const GAS v2u*)(zp_); ld[1] = *(const GAS v2u*)(zp_ + 128); ld[2] = *(const GAS v2u*)(zp_ + 256); \
            const char* ep_ = (const char*)EA + (row_ * (2u * NLORA) + 2u * (unsigned)(dir * 1024 + coff)); \
            ld[3] = *(const GAS v2u*)(ep_); ld[4] = *(const GAS v2u*)(ep_ + 4096); \
            ld[5].x = *(const GAS unsigned*)((const char*)KI + (row_ * 64u + 4u * (unsigned)h)); ld[5].y = 0u; } while (0)
#define SCAN_COMMIT(ld, p_) do { LAS unsigned char* d_ = cb + (p_) * SC_BUF; const LAS f32x4* cw_ = (const LAS f32x4*)(cb + SC_CW) + jc; \
            const f32x4 r_ = unpk4(ld[0]), zk_ = unpk4(ld[1]), v_ = unpk4(ld[2]); \
            const f32x4 e_ = unpk4(ld[3]), as_ = unpk4(ld[4]); const float inv_ = __builtin_bit_cast(float, ld[5].x); \
            const f32x4 kk_ = zk_ * cw_[0] * inv_, kd_ = zk_ * (1.0f + (as_ - 1.0f) * cw_[16]), b_ = kk_ * as_; \
            f32x4 Ei_, Et_; \
            _Pragma("unroll") for (int i_ = 0; i_ < 4; ++i_) { Ei_[i_] = row16_incl_scan(e_[i_]); Et_[i_] = row16_sum(e_[i_]); } \
            f32x4 gin_, gex_, ginv_, grem_; \
            _Pragma("unroll") for (int i_ = 0; i_ < 4; ++i_) { gin_[i_] = __builtin_amdgcn_exp2f(-Ei_[i_]); gex_[i_] = __builtin_amdgcn_exp2f(e_[i_] - Ei_[i_]); ginv_[i_] = __builtin_amdgcn_exp2f(Ei_[i_]); grem_[i_] = __builtin_amdgcn_exp2f(Ei_[i_] - Et_[i_]); } \
            *(LAS v2u*)(d_ + SC_AT + sl * 144 + 2 * ppos) = pk4(-kk_ * gex_); \
            *(LAS v2u*)(d_ + SC_RT + sl * 144 + 2 * ppos) = pk4(r_ * gin_); \
            *(LAS v2u*)(d_ + SC_BT + sl * 144 + 2 * ppos) = pk4(b_ * ginv_); \
            *(LAS v2u*)(d_ + SC_KT + sl * 144 + 2 * ppos) = pk4(kd_ * ginv_); \
            const f32x4 bh_ = b_ * grem_, kh_ = kd_ * grem_; \
            { const v2u bhp_ = pk4(bh_), khp_ = pk4(kh_); const unsigned bw_[2] = {bhp_.x, bhp_.y}, kw_[2] = {khp_.x, khp_.y}, vw_[2] = {ld[2].x, ld[2].y}; \
            _Pragma("unroll") for (int i_ = 0; i_ < 4; ++i_) { const int sh_ = 16 * (i_ & 1); \
                *(LAS bf16*)(d_ + SC_BHT + (4 * jc + i_) * 32 + 2 * sl) = (bf16)(bw_[i_ >> 1] >> sh_); \
                *(LAS bf16*)(d_ + SC_KHT + (4 * jc + i_) * 32 + 2 * sl) = (bf16)(kw_[i_ >> 1] >> sh_); \
                *(LAS bf16*)(d_ + SC_VT + (4 * jc + i_) * 32 + 2 * sl) = (bf16)(vw_[i_ >> 1] >> sh_); } } \
            if (sl == 0) *(LAS f32x4*)(d_ + SC_GC + 16 * jc) = (f32x4){__builtin_amdgcn_exp2f(-Et_.x), __builtin_amdgcn_exp2f(-Et_.y), __builtin_amdgcn_exp2f(-Et_.z), __builtin_amdgcn_exp2f(-Et_.w)}; } while (0)
        if (tc < 32) { const int a_ = tc >> 4, j_ = tc & 15; ((LAS f32x4*)(cb + SC_CW))[a_ * 16 + j_] = *(const GAS f32x4*)(F.in[a_ == 0 ? I_RKK : I_RKA] + h * 64 + 4 * j_); }
        __syncthreads();
        f32x4 cv[8]; const ConvSel csel = conv_sel(lane); LAS float* cscr = (LAS float*)(F.lds + 2 * SC_CHAIN + F.wave * 8448); const int gwv = F.bid * 8 + F.wave, NGWV = F.G * 8;
        constexpr int NCONV = NE * 6144 / 2048; static_assert(NCONV <= (CTXL + SEQ) / 16, "one expert-weight item per chunk");
        f32x4 ST[4];
#pragma unroll
        for (int i = 0; i < 4; ++i) ST[i] = (f32x4){0.f, 0.f, 0.f, 0.f};
        SCAN_ISSUE(ld0, 0); SCAN_ISSUE(ld1, 1); SCAN_ISSUE(ld2, 2); SCAN_COMMIT(ld0, 0); __syncthreads();
        constexpr int NCK = (CTXL + SEQ) / 16; static_assert(NCK % 3 == 0, "chunk loop unrolled by 3");
        const f32x4 zero4 = (f32x4){0.f, 0.f, 0.f, 0.f};
        for (int ck3 = 0; ck3 < NCK; ck3 += 3) { SCAN_BODY(ck3, ld0, ld1) SCAN_BODY(ck3 + 1, ld1, ld2) SCAN_BODY(ck3 + 2, ld2, ld0) }
    }
}

constexpr int HY_UROW = 4128, HY_GOFF = 16 * HY_UROW, HY_CS = 8208;
__device__ __forceinline__ void p6_hyena(Frame& F) {
    const int lane = F.lane, tl = lane & 15, q = lane >> 4, wave = F.wave, tid = F.tid;
    const bf16* UT = wsp<bf16>(F, WS_UT); const bf16* Gt = wsp<bf16>(F, WS_G); bf16* YCT = wsp<bf16>(F, WS_YCT);
    LAS unsigned char* lds = F.lds;
    const int r = (8 - (tl & 7)) & 7;
    const int abase = HY_GOFF + r * HY_CS + 2 * (2048 + 8 * q - (tl + r)) - 32 * (16 * wave);
    const int bbase = tl * HY_UROW + 16 * q;
    for (int c = F.bid; c < 1024; c += F.G) {
#pragma unroll
        for (int i = 0; i < 8; ++i) { const int id = tid + 512 * i, bb = id >> 8, ch = id & 255;
            const v4u v = *(const GAS v4u*)(UT + ((size_t)c * 16 + bb) * SEQ + 8 * ch); *(LAS v4u*)(lds + bb * HY_UROW + 16 * ch) = v; }
        { const v4u v = *(const GAS v4u*)(Gt + (size_t)c * 4096 + 8 * tid); *(LAS v4u*)(lds + HY_GOFF + 16 * tid) = v; }
        __syncthreads();
        { unsigned d[8]; const v4u lo = *(const LAS v4u*)(lds + HY_GOFF + 16 * tid); const v4u hi = tid < 511 ? *(const LAS v4u*)(lds + HY_GOFF + 16 * tid + 16) : (v4u){0u, 0u, 0u, 0u};
            d[0] = lo.x; d[1] = lo.y; d[2] = lo.z; d[3] = lo.w; d[4] = hi.x; d[5] = hi.y; d[6] = hi.z; d[7] = hi.w;
#pragma unroll
            for (int rr = 1; rr < 8; ++rr) { v4u o;
                if ((rr & 1) == 0) { o.x = d[rr / 2]; o.y = d[rr / 2 + 1]; o.z = d[rr / 2 + 2]; o.w = d[rr / 2 + 3]; }
                else { const int e = (rr - 1) / 2; o.x = __builtin_amdgcn_alignbit(d[e + 1], d[e], 16); o.y = __builtin_amdgcn_alignbit(d[e + 2], d[e + 1], 16);
                       o.z = __builtin_amdgcn_alignbit(d[e + 3], d[e + 2], 16); o.w = __builtin_amdgcn_alignbit(d[e + 4], d[e + 3], 16); }
                *(LAS v4u*)(lds + HY_GOFF + rr * HY_CS + 16 * tid) = o; } }
        __syncthreads();
        f32x4 acc[16]; bf16x8 P[16];
#pragma unroll
        for (int it = 0; it < 16; ++it) acc[it] = (f32x4){0.f, 0.f, 0.f, 0.f};
#pragma unroll
        for (int it = 2; it < 16; ++it) P[it] = *(const LAS bf16x8*)(lds + abase - 32 * it);
        for (int i8 = 0; i8 < 8; ++i8) {
#pragma unroll
            for (int u = 0; u < 8; ++u) {
                const int isb = i8 * 8 + u;
                const bf16x8 bf = *(const LAS bf16x8*)(lds + bbase + 64 * isb);
                P[(16 - 2 * u) & 15] = *(const LAS bf16x8*)(lds + abase + 64 * isb);
                P[(17 - 2 * u) & 15] = *(const LAS bf16x8*)(lds + abase + 64 * isb - 32);
#pragma unroll
                for (int k = 0; k < 16; ++k) { const int it = (k + 2) & 15;
                    acc[it] = __builtin_amdgcn_mfma_f32_16x16x32_bf16(P[(it - 2 * u) & 15], bf, acc[it], 0, 0, 0); }
            }
        }
#pragma unroll
        for (int it = 0; it < 16; ++it) { v2u o; o.x = pk2(acc[it].x, acc[it].y); o.y = pk2(acc[it].z, acc[it].w);
            *(GAS v2u*)(YCT + ((size_t)c * 16 + tl) * SEQ + 256 * wave + 16 * it + 4 * q) = o; }
        __syncthreads();
    }
}

__device__ __forceinline__ void p7_assemble(Frame& F) {
    const int gw = F.bid * 8 + F.wave, NGW = F.G * 8, lane = F.lane;
    unsigned char* A2 = wsp<unsigned char>(F, WS_A2);
    const bf16* YCT = wsp<bf16>(F, WS_YCT); const bf16* X0T = wsp<bf16>(F, WS_X0T); const bf16* UT = wsp<bf16>(F, WS_UT);
    const float* YS = wsp<float>(F, WS_YS); const float* BS = wsp<float>(F, WS_BS); const bf16* ZC = wsp<bf16>(F, WS_ZC); const bf16* EA = wsp<bf16>(F, WS_EA);
    LAS unsigned char* tile = F.lds + F.wave * 9216;
    constexpr int NU_H = 16 * 32 * 16, NU = NU_H + (NLAT / 16) * 4;
    for (int u = gw; u < NU; u += NGW) {
        if (u < NU_H) {
            const int b = u / 512, rem = u % 512, tb = rem / 16, g = rem % 16, ci = lane >> 3, tq = lane & 7;
            float val[8][8]; float ss[8];
#pragma unroll
            for (int k = 0; k < 8; ++k) ss[k] = 0.f;
#pragma unroll
            for (int i = 0; i < 8; ++i) { const int ch = g * 64 + 8 * ci + i; const size_t o = ((size_t)ch * 16 + b) * SEQ + 64 * tb + 8 * tq;
                const v4u yc = *(const GAS v4u*)(YCT + o), x0 = *(const GAS v4u*)(X0T + o), uu = *(const GAS v4u*)(UT + o); const float bias = F.in[I_HBIAS][ch];
                const unsigned ycw[4] = {yc.x, yc.y, yc.z, yc.w}, x0w[4] = {x0.x, x0.y, x0.z, x0.w}, uw[4] = {uu.x, uu.y, uu.z, uu.w};
#pragma unroll
                for (int k = 0; k < 4; ++k) { const float v0 = bflo(x0w[k]) * (bflo(ycw[k]) + bias * bflo(uw[k])), v1 = bfhi(x0w[k]) * (bfhi(ycw[k]) + bias * bfhi(uw[k]));
                    val[i][2 * k] = v0; val[i][2 * k + 1] = v1; ss[2 * k] += v0 * v0; ss[2 * k + 1] += v1 * v1; } }
#pragma unroll
            for (int k = 0; k < 8; ++k) { float s = ss[k]; s += __shfl_xor(s, 8); s += __shfl_xor(s, 16); s += __shfl_xor(s, 32); ss[k] = 1.0f / sqrtf(s * (1.0f / 64.0f) + 1e-6f); }
            float ng[8];
#pragma unroll
            for (int i = 0; i < 8; ++i) ng[i] = 4.0f * F.in[I_HNG][g * 64 + 8 * ci + i];
#pragma unroll
            for (int k = 0; k < 8; ++k) { v2u o; o.x = pg8::pk4_fp8(val[0][k] * ss[k] * ng[0], val[1][k] * ss[k] * ng[1], val[2][k] * ss[k] * ng[2], val[3][k] * ss[k] * ng[3]);
                o.y = pg8::pk4_fp8(val[4][k] * ss[k] * ng[4], val[5][k] * ss[k] * ng[5], val[6][k] * ss[k] * ng[6], val[7][k] * ss[k] * ng[7]);
                *(LAS v2u*)(tile + (8 * tq + k) * 72 + 8 * ci) = o; }
            LDS_WAIT(); asm volatile("" ::: "memory");
#pragma unroll
            for (int i = 0; i < 8; ++i) { const int t = (lane >> 3) + 8 * i, pc = lane & 7; const v2u o = *(const LAS v2u*)(tile + t * 72 + 8 * pc);
                *(GAS v2u*)(A2 + (size_t)(b * SEQ + 64 * tb + t) * D + g * 64 + 8 * pc) = o; }
            LDS_WAIT(); asm volatile("" ::: "memory");
        } else {
            const int v = u - NU_H, tk = v / 4, q = v % 4, c0 = 256 * q + 4 * lane;
            const f32x4 lg = *(const GAS f32x4*)(F.in[I_LNG] + c0), lb = *(const GAS f32x4*)(F.in[I_LNB] + c0);
            for (int i = 0; i < 16; ++i) { const int row = tk * 16 + i;
                const f32x4 y = *(const GAS f32x4*)(YS + (size_t)row * 1024 + c0) + *(const GAS f32x4*)(YS + ((size_t)NLAT + row) * 1024 + c0);
                const float mu = row16_sum((y.x + y.y) + (y.z + y.w)) * (1.0f / 64.0f);
                const f32x4 d = y - mu;
                const float var = row16_sum((d.x * d.x + d.y * d.y) + (d.z * d.z + d.w * d.w)) * (1.0f / 64.0f);
                const float rs = 1.0f / sqrtf(var + 64e-5f);
                const f32x4 vv = unpk4(*(const GAS v2u*)(ZC + ((size_t)(4 * q + (lane >> 4)) * MROWS + row) * 192 + 128 + 4 * (lane & 15))), gt = unpk4(*(const GAS v2u*)(EA + (size_t)row * NLORA + 4096 + c0));
                const float bsc = BS[(size_t)row * 16 + 4 * q + (lane >> 4)];
                const f32x4 o = (d * rs * lg + lb + bsc * vv) * gt;
                *(GAS unsigned*)(A2 + (size_t)row * D + 1024 + c0) = pg8::pk4_fp8(4.0f * o.x, 4.0f * o.y, 4.0f * o.z, 4.0f * o.w); }
        }
    }
}

__device__ __forceinline__ void p9_router(Frame& F) {
    const int lane = F.lane, rw = lane & 15, q = lane >> 4, wave = F.wave;
    const bf16* X1 = wsp<bf16>(F, WS_X1B); const float* MT = wsp<float>(F, WS_MODT); unsigned char* H2 = wsp<unsigned char>(F, WS_H2); const bf16* Wr = wsp<bf16>(F, WS_WR);
    int* TOKE = wsp<int>(F, WS_TOKE); float* TOKG = wsp<float>(F, WS_TOKG); int* WCNT = wsp<int>(F, WS_WCNT); int* BCNT = wsp<int>(F, WS_BCNT);
    LAS float* lg = (LAS float*)(F.lds + wave * 2048);
    LAS int* wc = (LAS int*)(F.lds + 16384 + wave * 128);
    {
        const int gw = F.bid * 8 + wave, tok0 = gw * 16, token = tok0 + rw, b = token / SEQ;
        const bf16* xr = X1 + (size_t)token * D + 8 * q;
        float ss = 0.f;
        { const float* sp = wsp<float>(F, WS_SSQ) + (size_t)token * 64 + 16 * q;
#pragma unroll
            for (int i = 0; i < 4; ++i) { const f32x4 a = *(const GAS f32x4*)(sp + 4 * i); ss += (a.x + a.y) + (a.z + a.w); } }
        ss += __shfl_xor(ss, 16); ss += __shfl_xor(ss, 32);
        const float rstd = 1.0f / sqrtf(ss * (1.0f / D) + 1e-6f);
        LAS float* TB = (LAS float*)(F.lds + 32768);
#pragma unroll
        for (int k = 0; k < 2; ++k) { const int idx = F.tid + 512 * k; *(LAS f32x4*)(TB + 4 * idx) = *(const GAS f32x4*)(MT + (size_t)b * 6144 + 4 * idx); }
        __syncthreads();
        f32x4 acc[2] = {(f32x4){0.f, 0.f, 0.f, 0.f}, (f32x4){0.f, 0.f, 0.f, 0.f}};
        v4u X0, X1r, X2, X3; bf16x8 W0[4], W1[4], W2[4], W3[4];
#define RT_LDX(buf, ks_) do { buf = *(const GAS v4u*)(xr + 32 * (ks_)); } while (0)
#define RT_LDW(buf, ks_) do { _Pragma("unroll") for (int nb = 0; nb < 2; ++nb) { const bf16* wp = Wr + (size_t)(16 * nb + rw) * D + 32 * (ks_) + 8 * q; \
            buf[2 * nb] = *(const GAS bf16x8*)wp; buf[2 * nb + 1] = *(const GAS bf16x8*)(wp + 32 * D); } } while (0)
#define RT_STEP(xc, xn, wcur, wnx, ks_) do { const int ks = (ks_); { RT_LDW(wnx, (ks + 3) & 63); RT_LDX(xn, (ks + 3) & 63); } \
            const LAS float* tp = TB + 32 * ks + 8 * q; \
            const f32x4 ma = *(const LAS f32x4*)tp, mb = *(const LAS f32x4*)(tp + 4), sa = *(const LAS f32x4*)(tp + 2048), sb = *(const LAS f32x4*)(tp + 2052); \
            const f32x4 xa = (f32x4){bflo(xc.x), bfhi(xc.x), bflo(xc.y), bfhi(xc.y)}, xb = (f32x4){bflo(xc.z), bfhi(xc.z), bflo(xc.w), bfhi(xc.w)}; \
            const f32x4 ha = xa * rstd * ma + sa, hb = xb * rstd * mb + sb; \
            const float hv[8] = {ha.x, ha.y, ha.z, ha.w, hb.x, hb.y, hb.z, hb.w}; \
            unsigned ph[4], pl[4]; \
            _Pragma("unroll") for (int p_ = 0; p_ < 4; ++p_) { ph[p_] = pk2(hv[2 * p_], hv[2 * p_ + 1]); \
                pl[p_] = pk2(hv[2 * p_] - __builtin_bit_cast(float, ph[p_] << 16), hv[2 * p_ + 1] - __builtin_bit_cast(float, ph[p_] & 0xffff0000u)); } \
            { v2u h8; h8.x = pg8::pk4_fp8(hv[0], hv[1], hv[2], hv[3]); h8.y = pg8::pk4_fp8(hv[4], hv[5], hv[6], hv[7]); *(GAS v2u*)(H2 + (size_t)token * D + 32 * ks + 8 * q) = h8; } \
            const bf16x8 Ah = __builtin_bit_cast(bf16x8, (v4u){ph[0], ph[1], ph[2], ph[3]}), Al = __builtin_bit_cast(bf16x8, (v4u){pl[0], pl[1], pl[2], pl[3]}); \
            _Pragma("unroll") for (int nb = 0; nb < 2; ++nb) { \
                acc[nb] = __builtin_amdgcn_mfma_f32_16x16x32_bf16(Ah, wcur[2 * nb], acc[nb], 0, 0, 0); \
                acc[nb] = __builtin_amdgcn_mfma_f32_16x16x32_bf16(Ah, wcur[2 * nb + 1], acc[nb], 0, 0, 0); \
                acc[nb] = __builtin_amdgcn_mfma_f32_16x16x32_bf16(Al, wcur[2 * nb], acc[nb], 0, 0, 0); } } while (0)
        RT_LDW(W0, 0); RT_LDX(X0, 0); RT_LDW(W1, 1); RT_LDX(X1r, 1); RT_LDW(W2, 2); RT_LDX(X2, 2);
        for (int ks4 = 0; ks4 < 64; ks4 += 4) { RT_STEP(X0, X3, W0, W3, ks4); RT_STEP(X1r, X0, W1, W0, ks4 + 1); RT_STEP(X2, X1r, W2, W1, ks4 + 2); RT_STEP(X3, X2, W3, W2, ks4 + 3); }
#undef RT_LDX
#undef RT_LDW
#undef RT_STEP
#pragma unroll
        for (int nb = 0; nb < 2; ++nb) { const float rb = F.in[I_ROUTB][16 * nb + rw];
#pragma unroll
            for (int j = 0; j < 4; ++j) lg[(4 * q + j) * 32 + 16 * nb + rw] = acc[nb][j] + rb; }
        if (lane < 32) wc[lane] = 0;
        LDS_WAIT(); asm volatile("" ::: "memory");
        if (lane < 16) {
            float lv[32];
#pragma unroll
            for (int e4 = 0; e4 < 8; ++e4) { const f32x4 t = *(const LAS f32x4*)(lg + lane * 32 + 4 * e4); lv[4 * e4] = t.x; lv[4 * e4 + 1] = t.y; lv[4 * e4 + 2] = t.z; lv[4 * e4 + 3] = t.w; }
            int sel[4]; float sv[4];
#pragma unroll
            for (int k = 0; k < 4; ++k) { float best = -3.0e38f; int bi = 0;
#pragma unroll
                for (int e = 0; e < 32; ++e) { bool taken = false;
#pragma unroll
                    for (int kk = 0; kk < k; ++kk) taken = taken || (sel[kk] == e);
                    if (!taken && lv[e] > best) { best = lv[e]; bi = e; } }
                sel[k] = bi; sv[k] = best; }
            const float e1 = __expf(sv[1] - sv[0]), e2 = __expf(sv[2] - sv[0]), e3 = __expf(sv[3] - sv[0]), inv = 1.0f / (1.0f + e1 + e2 + e3);
            const int tk = tok0 + lane;
            *(GAS v4u*)(TOKE + (size_t)tk * 4) = (v4u){(unsigned)sel[0], (unsigned)sel[1], (unsigned)sel[2], (unsigned)sel[3]};
            *(GAS f32x4*)(TOKG + (size_t)tk * 4) = (f32x4){inv, e1 * inv, e2 * inv, e3 * inv};
#pragma unroll
            for (int k = 0; k < 4; ++k) __hip_atomic_fetch_add(&wc[sel[k]], 1, __ATOMIC_RELAXED, __HIP_MEMORY_SCOPE_WORKGROUP);
        }
        LDS_WAIT(); asm volatile("" ::: "memory");
        if (lane < 32) WCNT[(size_t)gw * 32 + lane] = wc[lane];
        __syncthreads();
        if (wave == 0 && lane < 32) { int s = 0;
#pragma unroll
            for (int w = 0; w < 8; ++w) s += ((LAS int*)(F.lds + 16384 + w * 128))[lane];
            BCNT[F.bid * 32 + lane] = s; }
        __syncthreads();
    }
}

__device__ __forceinline__ void p10_sort(Frame& F) {
    const int lane = F.lane, wave = F.wave, gw = F.bid * 8 + wave;
    const int* TOKE = wsp<int>(F, WS_TOKE); const float* TOKG = wsp<float>(F, WS_TOKG); const int* WCNT = wsp<int>(F, WS_WCNT); const int* BCNT = wsp<int>(F, WS_BCNT);
    int* ETAB = wsp<int>(F, WS_ETAB); int* ROWTOK = wsp<int>(F, WS_ROWTOK); int* ROWDST = wsp<int>(F, WS_ROWDST); float* ROWGATE = wsp<float>(F, WS_ROWGATE);
    const int e = lane & 31, half = lane >> 5;
    int tot = 0, pre = 0;
#pragma unroll 32
    for (int bb = half; bb < 256; bb += 2) { const int c = BCNT[bb * 32 + e]; tot += c; pre += (bb < F.bid) ? c : 0; }
    tot += __shfl_xor(tot, 32); pre += __shfl_xor(pre, 32);
    { int wcn[7];
#pragma unroll
        for (int w = 0; w < 7; ++w) wcn[w] = WCNT[(size_t)(F.bid * 8 + w) * 32 + e];
#pragma unroll
        for (int w = 0; w < 7; ++w) pre += (w < wave) ? wcn[w] : 0; }
    const int padded = ((tot + 255) / 256) * 256;
    int incl = padded;
#pragma unroll
    for (int o = 1; o < 32; o <<= 1) { const int t = __shfl_up(incl, o, 32); if (e >= o) incl += t; }
    const int pstart = incl - padded;
    if (F.bid == 0) {
        LAS int* tb = (LAS int*)F.lds;
        if (wave == 0 && lane < 32) { ETAB[e] = pstart; ETAB[64 + e] = tot; tb[e] = pstart; tb[32 + e] = padded; if (e == 31) { ETAB[32] = incl; ETAB[128] = incl / 256; } }
        __syncthreads();
        for (int t = F.tid; t < MAXTILES; t += 512) { int te = 0;
#pragma unroll 8
            for (int x = 0; x < 32; ++x) { const int ps = tb[x], pd = tb[32 + x]; if (t * 256 >= ps && t * 256 < ps + pd) te = x; }
            ETAB[256 + t] = te; }
    }
    const int token = 16 * gw + (lane >> 2), slot = lane & 3;
    const int me = TOKE[(size_t)token * 4 + slot]; const float mg = TOKG[(size_t)token * 4 + slot];
    int rank = 0;
    for (int x = 0; x < 32; ++x) { const unsigned long long m = __ballot(me == x); if (me == x) rank = __popcll(m & ((1ull << lane) - 1ull)); }
    const int row = __shfl(pstart, me) + __shfl(pre, me) + rank;
    ROWTOK[row] = token; ROWDST[row] = token * 4 + slot; ROWGATE[row] = mg;
}

__device__ __forceinline__ void p13_final(Frame& F) {
    const int gw = F.bid * 8 + F.wave, NGW = F.G * 8, lane = F.lane;
    const float* MT = wsp<float>(F, WS_MODT); const unsigned char* SLOT = wsp<unsigned char>(F, WS_SLOT);
    for (int row = gw; row < NLAT; row += NGW) {
        int l4 = 4 * lane; asm volatile("" : "+v"(l4));
        const int b = row / SEQ; float* xr = F.out + (size_t)row * D; const bf16* x1r = wsp<bf16>(F, WS_X1B) + (size_t)row * D;
        f32x4 v[8]; float ss = 0.f;
#pragma unroll
        for (int j = 0; j < 8; ++j) { const int c = l4 + 256 * j;
            f32x4 m = (f32x4){0.f, 0.f, 0.f, 0.f};
#pragma unroll
            for (int s = 0; s < 4; ++s) { const int w8 = *(const GAS int*)(SLOT + ((size_t)row * 4 + s) * D + c); const f32x2 lo = __builtin_amdgcn_cvt_pk_f32_fp8(w8, false), hi = __builtin_amdgcn_cvt_pk_f32_fp8(w8, true); m += (f32x4){lo.x, lo.y, hi.x, hi.y}; }
            const f32x4 g5 = *(const GAS f32x4*)(MT + (size_t)b * 6144 + 4096 + c);
            v[j] = unpk4(*(const GAS v2u*)(x1r + c)) + g5 * m * (1.0f / 16.0f);
            ss += (v[j].x * v[j].x + v[j].y * v[j].y) + (v[j].z * v[j].z + v[j].w * v[j].w); }
        const float rstd = 1.0f / sqrtf(wave_sum(ss) * (1.0f / D) + 1e-6f);
#pragma unroll
        for (int j = 0; j < 8; ++j) *(GAS f32x4*)(xr + l4 + 256 * j) = v[j] * rstd * *(const GAS f32x4*)(F.in[I_FING] + l4 + 256 * j);
    }
}

constexpr int NPH = 13;
__global__ void __launch_bounds__(512, 2) mk_fwd(Args args) {
    extern __shared__ __attribute__((aligned(16))) unsigned char lds_raw[];
    Frame F;
    F.lds = (LAS unsigned char*)lds_raw; F.in = args.in; F.out = args.out; F.ws = args.ws;
    F.tid = threadIdx.x; F.lane = F.tid & 63; F.wave = __builtin_amdgcn_readfirstlane(F.tid >> 6); F.G = gridDim.x; F.bid = blockIdx.x;
    volatile LAS unsigned* MISC = (volatile LAS unsigned*)(F.lds + MISC_OFF);
    if (F.tid < 32) MISC[F.tid] = 0u;
    __syncthreads();
    const int lo = args.ph_lo, hi = args.ph_hi;
    unsigned* ctl = (unsigned*)(F.ws + WS_CTL);
    XcdBarrier bar; bar.bar = ctl + CW_BAR; bar.x = 0; bar.st = nullptr;
    if (hi - lo > 1) bar = xcd_barrier_post(ctl + CW_BAR, MISC + 8);
#ifndef PH_MASK
#define PH_MASK 0x1FFF
#endif
#define IN(k) (((PH_MASK >> (k)) & 1) && lo <= (k) && (k) < hi)
#ifndef REP_PH
#define REP_PH -1
#endif
#define SEAM(k) do { if (IN(k) && IN((k) + 1)) xcd_barrier(bar); } while (0)

    if (IN(0)) { p0_adaln(F); p0_small_weights(F); p0_filter(F); }
    if (REP_PH == 0 && IN(0)) { p0_adaln(F); p0_small_weights(F); p0_filter(F); }
    if (REP_PH == 100 && IN(0)) { p0_adaln(F); }
    if (REP_PH == 101 && IN(0)) { p0_small_weights(F); }
    if (REP_PH == 102 && IN(0)) { p0_filter(F); }
    SEAM(0);
#define PHBODY_1  p1_norm1(F); p1_filter_out(F);
    if (IN(1)) { PHBODY_1 }
    if (REP_PH == 1 && IN(1)) { PHBODY_1 }
    SEAM(1);
#define PHBODY_2     \
        pg8::Gemm g{wsp<bf16>(F, WS_A1), wsp<bf16>(F, WS_BTIN), D, 0, D, D}; \
        pg8::InProjOrder S{F.G, F.bid}; \
        pg8::EpiInProj E{wsp<bf16>(F, WS_Z), wsp<bf16>(F, WS_AP)}; \
        pg8::gemm_phase<false, false>(F.lds, g, S, E); \

    if (IN(2)) { PHBODY_2 }
    if (REP_PH == 2 && IN(2)) { PHBODY_2 }
    SEAM(2);
#define PHBODY_3     \
        { pg8::Gemm g{wsp<bf16>(F, WS_AP), wsp<bf16>(F, WS_BTL), 256, 0, KLORA, KLORA}; \
          pg8::StaticOrder S; S.init(MROWS, 4096, F.G, F.bid); \
          pg8::EpiLora E{wsp<bf16>(F, WS_EA), F.in[I_RW0], F.in[I_RA0], 0}; \
          pg8::gemm_phase<false, false>(F.lds, g, S, E); } \
        { pg8::Gemm g{wsp<bf16>(F, WS_AP) + 256, wsp<bf16>(F, WS_BTL) + (size_t)4096 * KLORA + 256, 256, 0, KLORA, KLORA}; \
          pg8::StaticOrder S; S.init(NLAT, 1024, F.G, F.bid); \
          pg8::EpiLora E{wsp<bf16>(F, WS_EA), F.in[I_RW0], F.in[I_RA0], 16}; \
          pg8::gemm_phase<false, false>(F.lds, g, S, E); } \

    if (IN(3)) { PHBODY_3 }
    if (REP_PH == 3 && IN(3)) { PHBODY_3 }
    SEAM(3);
#define PHBODY_4  p4_prep(F);
    if (IN(4)) { PHBODY_4 }
    if (REP_PH == 4 && IN(4)) { PHBODY_4 }
    SEAM(4);
#define PHBODY_5  p5_scan(F); p6_hyena(F);
    if (IN(5)) { PHBODY_5 }
    if (REP_PH == 5 && IN(5)) { PHBODY_5 }
    if (REP_PH == 50 && IN(5)) { p5_scan(F); }
    if (REP_PH == 51 && IN(5)) { p6_hyena(F); }
    SEAM(5);
#define PHBODY_6  p7_assemble(F);
    if (IN(6)) { PHBODY_6 }
    if (REP_PH == 6 && IN(6)) { PHBODY_6 }
    SEAM(6);
#define PHBODY_7     \
        pg8::Gemm g{wsp<bf16>(F, WS_A2), wsp<bf16>(F, WS_BTOUT), D / 2, 0, D / 2, D / 2}; \
        pg8::StaticOrder S; S.init(NLAT, D, F.G, F.bid); \
        pg8::EpiOutProj E{F.in[I_X], wsp<bf16>(F, WS_X1B), wsp<float>(F, WS_MODACC), F.in[I_ADAB], wsp<float>(F, WS_SSQ)}; \
        pg8::gemm_phase<false, true>(F.lds, g, S, E); \

    if (IN(7)) { PHBODY_7 }
    if (REP_PH == 7 && IN(7)) { PHBODY_7 }
    SEAM(7);
#define PHBODY_8  p9_router(F);
    if (IN(8)) { PHBODY_8 }
    if (REP_PH == 8 && IN(8)) { PHBODY_8 }
    SEAM(8);
#define PHBODY_9  p10_sort(F);
    if (IN(9)) { PHBODY_9 }
    if (REP_PH == 9 && IN(9)) { PHBODY_9 }
    SEAM(9);
#define PHBODY_10    \
        const int* ET = wsp<int>(F, WS_ETAB); \
        pg8::Gemm g{wsp<bf16>(F, WS_H2), wsp<bf16>(F, WS_BTGU), D / 2, (size_t)4096 * D, D / 2, D / 2}; \
        pg8::MoeOrder S{F.G, F.bid, 16, ET[128], F.ws}; \
        pg8::EpiSwiglu E{F.ws, F.in[I_EBG], F.in[I_EBU]}; \
        pg8::gemm_phase<true, true>(F.lds, g, S, E); \

    if (IN(10)) { PHBODY_10 }
    if (REP_PH == 10 && IN(10)) { PHBODY_10 }
#ifdef SHADOW10
    if (IN(10)) { const int* ET = wsp<int>(F, WS_ETAB); pg8::Gemm g{wsp<bf16>(F, WS_H2), wsp<bf16>(F, WS_BTGU), D / 2, (size_t)4096 * D, D / 2, D / 2};
        pg8::MoeOrderT<SHADOW10 == 1> S{F.G, F.bid, 16, ET[128], F.ws}; pg8::EpiSwigluT<(SHADOW10 == 1 ? 1 : 2)> E{F.ws, F.in[I_EBG], F.in[I_EBU]};
        pg8::gemm_phase<true, true>(F.lds, g, S, E); }
#endif
    SEAM(10);
#define PHBODY_11    \
        const int* ET = wsp<int>(F, WS_ETAB); \
        pg8::Gemm g{wsp<bf16>(F, WS_ACT), wsp<bf16>(F, WS_BTD), D / 2, (size_t)D * D, D / 2, D / 2}; \
        pg8::MoeOrder S{F.G, F.bid, 8, ET[128], F.ws}; \
        pg8::EpiDown E{F.ws, F.in[I_EBD]}; \
        pg8::gemm_phase<false, true>(F.lds, g, S, E); \

    if (IN(11)) { PHBODY_11 }
    if (REP_PH == 11 && IN(11)) { PHBODY_11 }
    SEAM(11);
    if (IN(12)) { p13_final(F); }
#undef IN
#undef SEAM
}

extern "C" void kernel_launch(void* const* d_in, const int* in_sizes, int n_in, void* d_out, int out_size, void* d_ws, size_t ws_size, hipStream_t stream) {
    static int grid = 0;
    if (grid == 0) {
        if (n_in != 44 || out_size != NLAT * D || ws_size < WS_END) { fprintf(stderr, "kernel_launch: unexpected problem (n_in %d, out %d, ws %zu)\n", n_in, out_size, ws_size); grid = -1; return; }
        if (hipFuncSetAttribute((const void*)mk_fwd, hipFuncAttributeMaxDynamicSharedMemorySize, LDS_BYTES) != hipSuccess) { fprintf(stderr, "kernel_launch: hipFuncSetAttribute failed\n"); grid = -1; return; }
        int per_cu = 0;
        if (hipOccupancyMaxActiveBlocksPerMultiprocessor(&per_cu, (const void*)mk_fwd, 512, LDS_BYTES) != hipSuccess || per_cu < 1) fprintf(stderr, "kernel_launch: occupancy query says %d blocks per CU\n", per_cu);
        (void)hipGetLastError();
        grid = 256;
    }
    if (grid < 0) return;
    (void)hipMemsetAsync((char*)d_ws + WS_CTL, 0, CTL_ZERO_BYTES, stream);
    Args a{};
    for (int i = 0; i < 44; ++i) a.in[i] = (const float*)d_in[i];
    a.out = (float*)d_out; a.ws = (unsigned char*)d_ws;
#if MK_PER_PHASE
    for (int ph = 0; ph < NPH; ++ph) { a.ph_lo = ph; a.ph_hi = ph + 1; hipLaunchKernelGGL(mk_fwd, dim3(grid), dim3(512), LDS_BYTES, stream, a); }
#else
    a.ph_lo = 0; a.ph_hi = NPH;
    hipLaunchKernelGGL(mk_fwd, dim3(grid), dim3(512), LDS_BYTES, stream, a);
#endif
    const hipError_t le = hipPeekAtLastError();
    if (le != hipSuccess) fprintf(stderr, "kernel_launch: launch failed: %s\n", hipGetErrorName(le));
}
```

```cpp
#include <hip/hip_runtime.h>
#include <cstdio>
#include <cstdint>

#ifndef MK_PER_PHASE
#define MK_PER_PHASE 0
#endif

#define GAS __attribute__((address_space(1)))
#define LAS __attribute__((address_space(3)))
typedef unsigned short bf16;
typedef unsigned v4u __attribute__((ext_vector_type(4)));
typedef unsigned v2u __attribute__((ext_vector_type(2)));
typedef float f32x4 __attribute__((ext_vector_type(4)));
typedef float f32x2 __attribute__((ext_vector_type(2)));
typedef short bf16x8 __attribute__((ext_vector_type(8)));

constexpr int NB = 16, SEQ = 2048, CTXL = 256, D = 2048;
constexpr int NLAT = NB * SEQ;
constexpr int NCTX = NB * CTXL;
constexpr int MROWS = NLAT + NCTX;
constexpr int PW = 6144;
constexpr int NIN = 6656;
constexpr int NLORA = 5120, KLORA = 512;
constexpr int NE = 32, TOPK = 4;
constexpr int NASG = NLAT * TOPK;
constexpr int MAXTILES = NASG / 256 + NE;
constexpr int SIW = 7168;

constexpr size_t MiB = 1u << 20;
constexpr size_t WS_CTL = 0;
constexpr size_t WS_MODACC = 1 * MiB;
constexpr size_t CTL_ZERO_BYTES = 1 * MiB;
constexpr size_t WS_MODT = 15 * MiB;
constexpr size_t WS_BS = 3 * MiB;
constexpr size_t WS_TOKE = 5 * MiB;
constexpr size_t WS_TOKG = 6 * MiB;
constexpr size_t WS_WCNT = 7 * MiB;
constexpr size_t WS_BCNT = 7 * MiB + 512 * 1024;
constexpr size_t WS_ETAB = 7 * MiB + 768 * 1024;
constexpr size_t WS_ROWTOK = 8 * MiB;
constexpr size_t WS_ROWDST = 9 * MiB;
constexpr size_t WS_ROWGATE = 10 * MiB;
constexpr size_t WS_SSQ = 1040 * MiB;
constexpr size_t WS_H3T = 12 * MiB;
constexpr size_t WS_G = 16 * MiB;
constexpr size_t WS_BTIN = 24 * MiB;
constexpr size_t WS_BTL = 50 * MiB;
constexpr size_t WS_BTOUT = 55 * MiB;
constexpr size_t WS_WR = 63 * MiB;
constexpr size_t WS_A1 = 64 * MiB;
constexpr size_t WS_Z = 208 * MiB;
constexpr size_t WS_AP = 640 * MiB;
constexpr size_t WS_X1B = 676 * MiB;
constexpr size_t WS_EA = 676 * MiB;
constexpr size_t WS_KKINV = 1036 * MiB;
constexpr size_t WS_UT = 1540 * MiB;
constexpr size_t WS_X0T = 1604 * MiB;
constexpr size_t WS_YCT = 1668 * MiB;
constexpr size_t WS_YS = 1040 * MiB;
constexpr size_t WS_A2 = 208 * MiB;
constexpr size_t WS_ZC = 1296 * MiB;
constexpr size_t WS_H2 = 336 * MiB;
constexpr size_t WS_BTGU = 1732 * MiB;
constexpr size_t WS_BTD = 64 * MiB;
constexpr size_t WS_ACT = 400 * MiB;
constexpr size_t WS_SLOT = 1040 * MiB;
constexpr size_t WS_END = 1988 * MiB;

constexpr int CW_TMO = 0;
constexpr int CW_BAR = 4096;

constexpr int LDS_BYTES = 147456;
constexpr int MISC_OFF = 143360;

__device__ __forceinline__ unsigned f2bf(float f) { unsigned u = __builtin_bit_cast(unsigned, f); return (u + 0x7fffu + ((u >> 16) & 1u)) >> 16; }
typedef __bf16 bf16v2_t __attribute__((ext_vector_type(2)));
__device__ __forceinline__ unsigned pk2(float lo, float hi) { const f32x2 v = {lo, hi}; return __builtin_bit_cast(unsigned, __builtin_convertvector(v, bf16v2_t)); }
__device__ __forceinline__ float bf2f(unsigned b) { return __builtin_bit_cast(float, b << 16); }
__device__ __forceinline__ float bflo(unsigned w) { return __builtin_bit_cast(float, w << 16); }
__device__ __forceinline__ float bfhi(unsigned w) { return __builtin_bit_cast(float, w & 0xffff0000u); }
__device__ __forceinline__ float fsigmoid(float x) { return __builtin_amdgcn_rcpf(1.0f + __builtin_amdgcn_exp2f(-1.4426950408889634f * x)); }
__device__ __forceinline__ float ftanh(float x) { const float e = __builtin_amdgcn_exp2f(2.8853900817779268f * x); return 1.0f - 2.0f * __builtin_amdgcn_rcpf(e + 1.0f); }
#define LDS_WAIT() asm volatile("s_waitcnt lgkmcnt(0)" ::: "memory")
#define VM_WAIT() asm volatile("s_waitcnt vmcnt(0)" ::: "memory")

#define XB_TMO      128
#define XB_XCNT(j)  (256  + 64 * (j))
#define XB_XSUB(j)  (1280 + 64 * (j))
#define XB_XGEN(j)  (2304 + 64 * (j))
#define XB_TOP      3328
#define XB_TOPGEN   3392
#define XCD_BAR_WORDS 3456
#define XB_SPIN_CAP (1u << 20)

__device__ __forceinline__ unsigned xb_ld(unsigned* p)              { return __hip_atomic_load(p, __ATOMIC_RELAXED, __HIP_MEMORY_SCOPE_AGENT); }
__device__ __forceinline__ unsigned xb_add(unsigned* p, unsigned v) { return __hip_atomic_fetch_add(p, v, __ATOMIC_RELAXED, __HIP_MEMORY_SCOPE_AGENT); }
__device__ __forceinline__ unsigned xb_xcc_id() { return (unsigned)__builtin_amdgcn_s_getreg((3 << 11) | 20) & 0xFu; }
#define XB_SPIN(cond, bar) do { unsigned _sp = 0; while (cond) { __builtin_amdgcn_s_sleep(1); \
    if ((++_sp & 255u) == 0u) { if (xb_ld(&(bar)[XB_TMO])) break; if (_sp > XB_SPIN_CAP) { atomicAdd(&(bar)[XB_TMO], 1u); break; } } } } while (0)

struct XcdBarrier { unsigned* bar; unsigned x; volatile LAS unsigned* st; };

__device__ __forceinline__ XcdBarrier xcd_barrier_post(unsigned* bar, volatile LAS unsigned* st) {
    XcdBarrier b; b.bar = bar; b.x = xb_xcc_id(); b.st = st;
    if (threadIdx.x == 0) (void)xb_add(&bar[XB_XCNT(b.x)], 1u);
    return b;
}
__device__ __forceinline__ void xcd_barrier_complete(unsigned* bar, unsigned x, unsigned& nloc, unsigned& nx) {
    const unsigned G = gridDim.x * gridDim.y * gridDim.z;
    unsigned sum, cnt, mine, sp = 0u;
    for (;;) {
        sum = 0u; cnt = 0u; mine = 0u;
#pragma unroll
        for (unsigned j = 0; j < 16; ++j) { const unsigned c = xb_ld(&bar[XB_XCNT(j)]); sum += c; cnt += (c > 0u) ? 1u : 0u; mine = (j == x) ? c : mine; }
        if (sum == G) break;
        __builtin_amdgcn_s_sleep(1);
        if ((++sp & 255u) == 0u) { if (xb_ld(&bar[XB_TMO])) break; if (sp > XB_SPIN_CAP) { atomicAdd(&bar[XB_TMO], 1u); break; } }
    }
    nloc = mine > 0u ? mine : 1u; nx = cnt > 0u ? cnt : 1u;
}
__device__ __forceinline__ void xcd_barrier(const XcdBarrier& b) {
    asm volatile("s_waitcnt vmcnt(0)" ::: "memory");
    __syncthreads();
    if (threadIdx.x == 0) {
        unsigned* bar = b.bar;
        __builtin_amdgcn_s_waitcnt(0);
        unsigned nloc = b.st[0], nx = b.st[1];
        if (nloc == 0u) { xcd_barrier_complete(bar, b.x, nloc, nx); b.st[0] = nloc; b.st[1] = nx; }
        const unsigned old = xb_add(&bar[XB_XSUB(b.x)], 1u);
        const unsigned gen = old / nloc;
        if (old + 1u == (gen + 1u) * nloc) {
            __builtin_amdgcn_fence(__ATOMIC_RELEASE, "agent");
            asm volatile("s_waitcnt vmcnt(0)" ::: "memory");
            const unsigned og = xb_add(&bar[XB_TOP], 1u);
            const unsigned tg = og / nx;
            if (og + 1u == (tg + 1u) * nx) xb_add(&bar[XB_TOPGEN], 1u);
            else XB_SPIN(xb_ld(&bar[XB_TOPGEN]) == tg, bar);
            __builtin_amdgcn_fence(__ATOMIC_ACQUIRE, "agent");
            xb_add(&bar[XB_XGEN(b.x)], 1u);
            asm volatile("s_waitcnt vmcnt(0)" ::: "memory");
        } else {
            XB_SPIN(xb_ld(&bar[XB_XGEN(b.x)]) == gen, bar);
            __builtin_amdgcn_fence(__ATOMIC_ACQUIRE, "agent");
            asm volatile("s_waitcnt vmcnt(0)" ::: "memory");
        }
    }
    __syncthreads();
}

namespace pg8 {
constexpr int BM = 256, BK = 64, HALF = 128, HTB = HALF * BK * 2, STAGE_BYTES = 8 * HTB, NXCD = 8, WGM = 8;
__device__ __forceinline__ int lds_byte(int r, int c) { const int st = (r >> 4) * 2 + (c >> 5), rr = r & 15, cc = c & 31, ob = rr * 64 + cc * 2; return st * 1024 + (ob ^ (((ob >> 9) & 1) << 5)); }
__device__ __forceinline__ void stage_rc(int b, int& R, int& C) { const int st = b / 1024, sb = b % 1024, swz = sb ^ (((sb >> 9) & 1) << 5); R = (st >> 1) * 16 + swz / 64; C = (st & 1) * 32 + (swz % 64) / 2; }
__device__ __forceinline__ int perm32(int rho) { const int n = rho >> 4, i = rho & 15; return 8 * (i >> 2) + 4 * n + (i & 3); }

typedef int i32x4 __attribute__((ext_vector_type(4)));
typedef int i32x8 __attribute__((ext_vector_type(8)));
__device__ __forceinline__ i32x8 cat_i8(bf16x8 a, bf16x8 b) { return __builtin_shufflevector(__builtin_bit_cast(i32x4, a), __builtin_bit_cast(i32x4, b), 0, 1, 2, 3, 4, 5, 6, 7); }
struct Unit { int pm, pn, e; };
struct Gemm { const bf16* A; const bf16* Bt; int K; size_t bstrideE; int lda, ldb; };

__device__ __forceinline__ unsigned cvt_pk_bf16(float lo, float hi) { return pk2(lo, hi); }

template <bool GATHER, bool FP8, class Epi, class Sched>
__device__ __forceinline__ void gemm_phase(LAS unsigned char* lds, const Gemm g, const Sched& S, const Epi& E) {
    const int tid = threadIdx.x, wid = __builtin_amdgcn_readfirstlane(tid >> 6), lane = tid & 63, wr = wid >> 2, wc = wid & 3, fr = lane & 15, fq = lane >> 4;
    const int K = g.K, nt = K / BK, lda = g.lda, ldb = g.ldb;
    unsigned voffB[2]; int RA[2], CA[2];
#pragma unroll
    for (int i = 0; i < 2; ++i) { int R, C; stage_rc(tid * 16 + i * 8192, R, C); const int Rb = Epi::PERM ? ((R & ~31) + perm32(R & 31)) : R;
        RA[i] = R; CA[i] = C; voffB[i] = (unsigned)(Rb * ldb + C) * 2u; }
    const size_t kstep = (size_t)(BK * 2);
    const size_t hstep = (size_t)HALF * ldb * 2, tstep = 2 * hstep;
    const size_t hstepA = (size_t)HALF * lda * 2, tstepA = 2 * hstepA;
    const unsigned ldsw = (unsigned)wid * 1024u;
    const int aoff = lds_byte(wr * 64 + fr, fq * 8), boff = lds_byte(wc * 32 + fr, fq * 8);
#define PG8_SA(b, h) (((b) * 2 + (h)) * HTB)
#define PG8_SB(b, h) ((4 + (b) * 2 + (h)) * HTB)
#define PG8_STAGE(bufoff, gbase, voff) do { _Pragma("unroll") for (int _i = 0; _i < 2; ++_i) \
        __builtin_amdgcn_global_load_lds((const unsigned*)((const char*)(gbase) + (voff)[_i]), (LAS unsigned*)(lds + (bufoff) + ldsw + _i * 8192), 16, 0, 0); } while (0)
#define PG8_LDA(dst, b, h) do { _Pragma("unroll") for (int m = 0; m < 4; ++m) { if constexpr (FP8) dst##8[m] = cat_i8(*(const LAS bf16x8*)(lds + PG8_SA(b, h) + aoff + m * 2048), *(const LAS bf16x8*)(lds + PG8_SA(b, h) + aoff + m * 2048 + 1024)); \
        else { _Pragma("unroll") for (int k = 0; k < 2; ++k) dst[m][k] = *(const LAS bf16x8*)(lds + PG8_SA(b, h) + aoff + m * 2048 + k * 1024); } } } while (0)
#define PG8_LDB(dst, b, h) do { _Pragma("unroll") for (int n = 0; n < 2; ++n) { if constexpr (FP8) dst##8[n] = cat_i8(*(const LAS bf16x8*)(lds + PG8_SB(b, h) + boff + n * 2048), *(const LAS bf16x8*)(lds + PG8_SB(b, h) + boff + n * 2048 + 1024)); \
        else { _Pragma("unroll") for (int k = 0; k < 2; ++k) dst[n][k] = *(const LAS bf16x8*)(lds + PG8_SB(b, h) + boff + n * 2048 + k * 1024); } } } while (0)
#define PG8_F8STR(d, a, b) "v_mfma_scale_f32_16x16x128_f8f6f4 %" #d ", %" #a ", %" #b ", %" #d ", %14, %14 op_sel_hi:[0,0,0]\n\t"
#define PG8_MMA(ai, bj, At, Bt) do { __builtin_amdgcn_s_setprio(1); \
        if constexpr (FP8) { asm volatile("s_nop 1\n\t" PG8_F8STR(0, 12, 8) PG8_F8STR(1, 13, 8) PG8_F8STR(2, 12, 9) PG8_F8STR(3, 13, 9) PG8_F8STR(4, 12, 10) PG8_F8STR(5, 13, 10) PG8_F8STR(6, 12, 11) PG8_F8STR(7, 13, 11) \
            : "+v"(acc[ai][bj][0][0]), "+v"(acc[ai][bj][0][1]), "+v"(acc[ai][bj][1][0]), "+v"(acc[ai][bj][1][1]), "+v"(acc[ai][bj][2][0]), "+v"(acc[ai][bj][2][1]), "+v"(acc[ai][bj][3][0]), "+v"(acc[ai][bj][3][1]) \
            : "v"(At##8[0]), "v"(At##8[1]), "v"(At##8[2]), "v"(At##8[3]), "v"(Bt##8[0]), "v"(Bt##8[1]), "v"(f8scale)); } \
        else { _Pragma("unroll") for (int m = 0; m < 4; ++m) _Pragma("unroll") for (int n = 0; n < 2; ++n) _Pragma("unroll") for (int k = 0; k < 2; ++k) \
            acc[ai][bj][m][n] = __builtin_amdgcn_mfma_f32_16x16x32_bf16(Bt[n][k], At[m][k], acc[ai][bj][m][n], 0, 0, 0); } __builtin_amdgcn_s_setprio(0); } while (0)
#define PG8_WAIT_V(n) asm volatile("s_waitcnt vmcnt(" #n ")" ::: "memory")
#define PG8_WAIT_L(n) asm volatile("s_waitcnt lgkmcnt(" #n ")" ::: "memory")
#define PG8_BAR __builtin_amdgcn_s_barrier()
#define PG8_SCHED __builtin_amdgcn_sched_barrier(0)
    Unit cur, nxt; int ui = 0;
    if (!S.next(0, cur)) return;
    f32x4 acc[2][2][4][2];
#pragma unroll
    for (int a = 0; a < 2; ++a)
#pragma unroll
        for (int b = 0; b < 2; ++b)
#pragma unroll
            for (int m = 0; m < 4; ++m)
#pragma unroll
                for (int n = 0; n < 2; ++n) acc[a][b][m][n] = (f32x4){0.f, 0.f, 0.f, 0.f};
    bf16x8 At[4][2], B0[2][2], B1[2][2]; i32x8 At8[4], B08[2], B18[2]; int f8scale = 0x7f7f7f7f; asm volatile("" : "+v"(f8scale));
    unsigned vA0[2], vA1[2], vN0[2], vN1[2];
    const char* cA; const char* cB;
    if constexpr (GATHER) {
        cA = (const char*)g.A;
#pragma unroll
        for (int i = 0; i < 2; ++i) { vA0[i] = (unsigned)(S.arow(cur, RA[i]) * lda + CA[i]) * 2u; vA1[i] = (unsigned)(S.arow(cur, HALF + RA[i]) * lda + CA[i]) * 2u; }
    } else {
        cA = (const char*)g.A + (size_t)cur.pm * tstepA;
#pragma unroll
        for (int i = 0; i < 2; ++i) { vA0[i] = (unsigned)(RA[i] * lda + CA[i]) * 2u; vA1[i] = vA0[i] + (unsigned)hstepA; }
    }
#pragma unroll
    for (int i = 0; i < 2; ++i) { vN0[i] = vA0[i]; vN1[i] = vA1[i]; }
    cB = (const char*)g.Bt + (size_t)cur.e * g.bstrideE + (size_t)cur.pn * tstep;
    PG8_STAGE(PG8_SB(0, 0), cB, voffB); PG8_STAGE(PG8_SA(0, 0), cA, vA0); PG8_STAGE(PG8_SB(0, 1), cB + hstep, voffB); PG8_STAGE(PG8_SA(0, 1), cA, vA1);
    if (wr == 1) PG8_BAR;
    PG8_WAIT_V(4); PG8_BAR;
    PG8_STAGE(PG8_SB(1, 0), cB + kstep, voffB); PG8_STAGE(PG8_SA(1, 0), cA + kstep, vA0); PG8_STAGE(PG8_SB(1, 1), cB + hstep + kstep, voffB);
    PG8_WAIT_V(6); PG8_BAR;
    for (;;) {
        const bool has_next = S.next(ui + 1, nxt);
        const char* nA; const char* nB;
        if (has_next) {
            nB = (const char*)g.Bt + (size_t)nxt.e * g.bstrideE + (size_t)nxt.pn * tstep;
            if constexpr (GATHER) { nA = cA;
#pragma unroll
                for (int i = 0; i < 2; ++i) { vN0[i] = (unsigned)(S.arow(nxt, RA[i]) * lda + CA[i]) * 2u; vN1[i] = (unsigned)(S.arow(nxt, HALF + RA[i]) * lda + CA[i]) * 2u; }
            } else nA = (const char*)g.A + (size_t)nxt.pm * tstepA;
        } else { nA = cA; nB = cB;
#pragma unroll
            for (int i = 0; i < 2; ++i) { vN0[i] = vA0[i]; vN1[i] = vA1[i]; } }
#pragma unroll 1
        for (int t = 0; t < nt; t += 2) {
            const bool last = (t == nt - 2);
            const char* a1 = cA + (size_t)(t + 1) * kstep;
            const char* a2 = last ? nA : cA + (size_t)(t + 2) * kstep; const char* b2 = last ? nB : cB + (size_t)(t + 2) * kstep;
            const char* a3 = a2 + kstep; const char* b3 = b2 + kstep;
            unsigned w0[2], w1[2];
#pragma unroll
            for (int i = 0; i < 2; ++i) { if constexpr (GATHER) { w0[i] = last ? vN0[i] : vA0[i]; w1[i] = last ? vN1[i] : vA1[i]; } else { w0[i] = vA0[i]; w1[i] = vA1[i]; } }
            PG8_LDB(B0, 0, 0); PG8_SCHED; PG8_LDA(At, 0, 0); PG8_STAGE(PG8_SA(1, 1), a1, vA1);
            PG8_WAIT_L(8); PG8_BAR; PG8_WAIT_L(0); PG8_MMA(0, 0, At, B0); PG8_BAR; PG8_SCHED;
            PG8_LDB(B1, 0, 1); PG8_STAGE(PG8_SB(0, 0), b2, voffB);
            PG8_BAR; PG8_WAIT_L(0); PG8_MMA(0, 1, At, B1); PG8_BAR;
            PG8_LDA(At, 0, 1); PG8_STAGE(PG8_SA(0, 0), a2, w0);
            PG8_BAR; PG8_WAIT_L(0); PG8_MMA(1, 0, At, B0); PG8_BAR; PG8_SCHED;
            PG8_STAGE(PG8_SB(0, 1), b2 + hstep, voffB);
            PG8_WAIT_V(6); PG8_BAR; PG8_MMA(1, 1, At, B1); PG8_BAR;
            PG8_LDB(B0, 1, 0); PG8_SCHED; PG8_LDA(At, 1, 0); PG8_STAGE(PG8_SA(0, 1), a2, w1);
            PG8_WAIT_L(8); PG8_BAR; PG8_WAIT_L(0); PG8_MMA(0, 0, At, B0); PG8_BAR; PG8_SCHED;
            PG8_LDB(B1, 1, 1); PG8_STAGE(PG8_SB(1, 0), b3, voffB);
            PG8_BAR; PG8_WAIT_L(0); PG8_MMA(0, 1, At, B1); PG8_BAR;
            PG8_LDA(At, 1, 1); PG8_STAGE(PG8_SA(1, 0), a3, w0);
            PG8_BAR; PG8_WAIT_L(0); PG8_MMA(1, 0, At, B0); PG8_BAR; PG8_SCHED;
            PG8_STAGE(PG8_SB(1, 1), b3 + hstep, voffB);
            PG8_WAIT_V(6); PG8_BAR; PG8_MMA(1, 1, At, B1); PG8_BAR;
        }
        if constexpr (FP8) asm volatile("s_nop 15\n\ts_nop 15" ::: "memory");
        E(acc, cur, wr, wc, fr, fq);
        if (!has_next) break;
#pragma unroll
        for (int a = 0; a < 2; ++a)
#pragma unroll
            for (int b = 0; b < 2; ++b)
#pragma unroll
                for (int m = 0; m < 4; ++m)
#pragma unroll
                    for (int n = 0; n < 2; ++n) acc[a][b][m][n] = (f32x4){0.f, 0.f, 0.f, 0.f};
        cur = nxt; cA = nA; cB = nB; ++ui;
#pragma unroll
        for (int i = 0; i < 2; ++i) { vA0[i] = vN0[i]; vA1[i] = vN1[i]; }
    }
    PG8_WAIT_V(0);
    if (wr == 0) PG8_BAR;
    PG8_BAR;
#undef PG8_SA
#undef PG8_SB
#undef PG8_STAGE
#undef PG8_LDA
#undef PG8_LDB
#undef PG8_MMA
#undef PG8_WAIT_V
#undef PG8_WAIT_L
#undef PG8_BAR
#undef PG8_SCHED
}
}

struct Args { const float* in[44]; float* out; unsigned char* ws; int ph_lo, ph_hi; };
enum InIdx { I_X = 0, I_C, I_CTX, I_CCTX, I_ADAW, I_ADAB, I_N1G, I_N2G, I_INW, I_CONVW, I_CONVB, I_HW1, I_HB1, I_HW2, I_HB2, I_HW3, I_HB3, I_HFREQ, I_HW4, I_HBIAS, I_HNG,
             I_RW0, I_RW1, I_RW2, I_RA0, I_RA1, I_RA2, I_RKK, I_RKA, I_RRK, I_RG1, I_RG2, I_LNG, I_LNB, I_OUTW, I_ROUTW, I_ROUTB, I_EWG, I_EBG, I_EWU, I_EBU, I_EWD, I_EBD, I_FING };

struct Frame {
    LAS unsigned char* lds;
    const float* const* in;
    float* out; unsigned char* ws;
    int tid, lane, wave, G, bid;
};
template <class T> __device__ __forceinline__ T* wsp(const Frame& F, size_t off) { return (T*)(F.ws + off); }

template <int CTRL> __device__ __forceinline__ float dpp_mov(float x) { return __builtin_bit_cast(float, __builtin_amdgcn_update_dpp(0, __builtin_bit_cast(int, x), CTRL, 0xF, 0xF, true)); }
__device__ __forceinline__ float row16_sum(float v) {
    v += dpp_mov<0x128>(v);
    v += dpp_mov<0x124>(v);
    v += dpp_mov<0x122>(v);
    v += dpp_mov<0x121>(v);
    return v;
}

__device__ __forceinline__ float rdlane(float v, int l) { return __builtin_bit_cast(float, __builtin_amdgcn_readlane(__builtin_bit_cast(int, v), l)); }
__device__ __forceinline__ float wave_sum(float v) { v = row16_sum(v); return (rdlane(v, 0) + rdlane(v, 16)) + (rdlane(v, 32) + rdlane(v, 48)); }

__device__ __forceinline__ void tr_item(const float* src, size_t ld_src, int k0, int n0, bf16* dst, bf16* dlo, size_t ld_dst, int drow0, int dk0, LAS float* scr, int lane) {
    const int c = lane & 7;
    if (src == nullptr) {
#pragma unroll
        for (int j = 0; j < 4; ++j) { const int n = (lane >> 3) + 8 * j; *(GAS v4u*)(dst + (size_t)(drow0 + n) * ld_dst + dk0 + 8 * c) = (v4u){0u, 0u, 0u, 0u}; }
        return;
    }
#pragma unroll 8
    for (int i = 0; i < 32; ++i) { const int kk = 2 * i + (lane >> 5); scr[kk * 33 + (lane & 31)] = src[(size_t)(k0 + kk) * ld_src + n0 + (lane & 31)]; }
    LDS_WAIT(); asm volatile("" ::: "memory");
#pragma unroll
    for (int j = 0; j < 4; ++j) { const int n = (lane >> 3) + 8 * j; const LAS float* s = scr + (8 * c) * 33 + n;
        float v[8];
#pragma unroll
        for (int q = 0; q < 8; ++q) v[q] = s[q * 33];
        v4u o; o.x = pk2(v[0], v[1]); o.y = pk2(v[2], v[3]); o.z = pk2(v[4], v[5]); o.w = pk2(v[6], v[7]);
        *(GAS v4u*)(dst + (size_t)(drow0 + n) * ld_dst + dk0 + 8 * c) = o;
        if (dlo) { float r[8];
#pragma unroll
            for (int q = 0; q < 8; ++q) r[q] = v[q] - bf2f(f2bf(v[q]));
            v4u p; p.x = pk2(r[0], r[1]); p.y = pk2(r[2], r[3]); p.z = pk2(r[4], r[5]); p.w = pk2(r[6], r[7]);
            *(GAS v4u*)(dlo + (size_t)(drow0 + n) * ld_dst + dk0 + 8 * c) = p; } }
    LDS_WAIT(); asm volatile("" ::: "memory");
}

struct ConvItem { const float* src; unsigned char* dst; };
__device__ __forceinline__ ConvItem conv_item(const Frame& F, int it) {
    const int e = it / 6144, r = it % 6144; ConvItem c;
    if (r < 4096) { const int s = r / 2048, rr = r % 2048, kb = rr / 64, nb = rr % 64;
        c.src = (s ? F.in[I_EWU] : F.in[I_EWG]) + (size_t)e * D * D + (size_t)(64 * kb) * D + 32 * nb;
        c.dst = F.ws + WS_BTGU + ((size_t)e * 4096 + 256 * (nb / 4) + 128 * s + 32 * (nb % 4)) * D + 64 * kb; }
    else { const int rr = r - 4096, kb = rr / 64, nb = rr % 64;
        c.src = F.in[I_EWD] + (size_t)e * D * D + (size_t)(64 * kb) * D + 32 * nb;
        c.dst = F.ws + WS_BTD + ((size_t)e * D + 32 * nb) * D + 64 * kb; }
    return c;
}
__device__ __forceinline__ void conv_issue(const ConvItem& c, f32x4 (&cv)[8], int lane) {
#pragma unroll
    for (int i = 0; i < 8; ++i) cv[i] = *(const GAS f32x4*)(c.src + (size_t)(8 * i + (lane >> 3)) * D + 4 * (lane & 7));
}
__device__ __forceinline__ void conv_finish(const ConvItem& c, const f32x4 (&cv)[8], LAS float* scr, int lane) {
#pragma unroll
    for (int i = 0; i < 8; ++i) { LAS float* d = scr + (8 * i + (lane >> 3)) * 33 + 4 * (lane & 7); d[0] = cv[i].x; d[1] = cv[i].y; d[2] = cv[i].z; d[3] = cv[i].w; }
    LDS_WAIT(); asm volatile("" ::: "memory");
    const int cc = lane & 7;
#pragma unroll
    for (int j = 0; j < 4; ++j) { const int n = (lane >> 3) + 8 * j; const LAS float* s = scr + (8 * cc) * 33 + n;
        float v[8];
#pragma unroll
        for (int q = 0; q < 8; ++q) v[q] = s[q * 33] * 64.0f;
        int w0 = __builtin_amdgcn_cvt_pk_fp8_f32(v[0], v[1], 0, false); w0 = __builtin_amdgcn_cvt_pk_fp8_f32(v[2], v[3], w0, true);
        int w1 = __builtin_amdgcn_cvt_pk_fp8_f32(v[4], v[5], 0, false); w1 = __builtin_amdgcn_cvt_pk_fp8_f32(v[6], v[7], w1, true);
        v2u o; o.x = (unsigned)w0; o.y = (unsigned)w1;
        *(GAS v2u*)(c.dst + (size_t)n * D + 8 * cc) = o; }
    LDS_WAIT(); asm volatile("" ::: "memory");
}

typedef short bf16x8_t __attribute__((ext_vector_type(8)));
struct ConvSel { bf16x8_t b0, b1; };
__device__ __forceinline__ ConvSel conv_sel(int lane) {
    const int c = lane & 15, qd = lane >> 4, e = c & 3; const bool on = (c >> 2) == qd; const unsigned val = on ? ((e & 1) ? 0x42800000u : 0x00004280u) : 0u;
    v4u s0, s1; s0.x = (e >> 1) == 0 ? val : 0u; s0.y = (e >> 1) == 1 ? val : 0u; s0.z = 0u; s0.w = 0u; s1.x = 0u; s1.y = 0u; s1.z = s0.x; s1.w = s0.y;
    ConvSel r; r.b0 = __builtin_bit_cast(bf16x8_t, s0); r.b1 = __builtin_bit_cast(bf16x8_t, s1); return r;
}
__device__ __forceinline__ void conv_issue_m(const ConvItem& c, f32x4 (&cv)[8], int lane) {
    const int r = lane & 15, qd = lane >> 4; const float* p = c.src + (size_t)(16 * (r >> 2) + (r & 3)) * D + 4 * qd;
#pragma unroll
    for (int blk = 0; blk < 4; ++blk) { cv[2 * blk] = *(const GAS f32x4*)(p + (size_t)(4 * blk) * D); cv[2 * blk + 1] = *(const GAS f32x4*)(p + (size_t)(4 * blk) * D + 16); }
}
__device__ __forceinline__ void conv_finish_m(const ConvItem& c, const f32x4 (&cv)[8], const ConvSel& sel, int lane) {
    const int cc = lane & 15, mg = lane >> 4; unsigned w0[4], w1[4]; const f32x4 z4 = (f32x4){0.f, 0.f, 0.f, 0.f};
#pragma unroll
    for (int blk = 0; blk < 4; ++blk) { v4u a; a.x = pk2(cv[2 * blk].x, cv[2 * blk].y); a.y = pk2(cv[2 * blk].z, cv[2 * blk].w); a.z = pk2(cv[2 * blk + 1].x, cv[2 * blk + 1].y); a.w = pk2(cv[2 * blk + 1].z, cv[2 * blk + 1].w);
        const bf16x8_t A = __builtin_bit_cast(bf16x8_t, a);
        const f32x4 d0 = __builtin_amdgcn_mfma_f32_16x16x32_bf16(A, sel.b0, z4, 0, 0, 0), d1 = __builtin_amdgcn_mfma_f32_16x16x32_bf16(A, sel.b1, z4, 0, 0, 0);
        int t0 = __builtin_amdgcn_cvt_pk_fp8_f32(d0.x, d0.y, 0, false); t0 = __builtin_amdgcn_cvt_pk_fp8_f32(d0.z, d0.w, t0, true);
        int t1 = __builtin_amdgcn_cvt_pk_fp8_f32(d1.x, d1.y, 0, false); t1 = __builtin_amdgcn_cvt_pk_fp8_f32(d1.z, d1.w, t1, true);
        w0[blk] = (unsigned)t0; w1[blk] = (unsigned)t1; }
    unsigned char* dp = c.dst + (size_t)cc * D + 16 * mg;
    *(GAS v4u*)dp = (v4u){w0[0], w0[1], w0[2], w0[3]}; *(GAS v4u*)(dp + (size_t)16 * D) = (v4u){w1[0], w1[1], w1[2], w1[3]};
}

__device__ __forceinline__ void p0_small_weights(Frame& F) {
    LAS float* scr = (LAS float*)(F.lds + F.wave * 8448);
    if (F.bid < 96) return;
    const int gw = (F.bid - 96) * 8 + F.wave, NGW = (F.G - 96) * 8;
    constexpr int I_T1 = 32 * 192, I_T2 = 128, I_T3 = 128, I_T4 = 128, I_T5 = 128, I_T6 = 32 * 64, I_T7 = 160 * 8, I_T8 = 32;
    constexpr int NITEMS = I_T1 + I_T2 + I_T3 + I_T4 + I_T5 + I_T6 + I_T7 + I_T8;
    bf16* BtIn = wsp<bf16>(F, WS_BTIN); bf16* BtL = wsp<bf16>(F, WS_BTL); bf16* BtOut = wsp<bf16>(F, WS_BTOUT); bf16* Wr = wsp<bf16>(F, WS_WR);
    for (int it = gw; it < NITEMS; it += NGW) {
        int r = it;
        if (r < I_T1) { const int kb = r / 192, nb = r % 192; tr_item(F.in[I_INW], PW, 64 * kb, 32 * nb, BtIn, nullptr, D, 32 * nb, 64 * kb, scr, F.lane); continue; } r -= I_T1;
        if (r < I_T2) { const int dir = r / 64, q = r % 64, kb = q / 2, nb = q % 2; tr_item(F.in[I_RW1] + (size_t)dir * D * 64, 64, 64 * kb, 32 * nb, BtIn, nullptr, D, 6144 + 64 * dir + 32 * nb, 64 * kb, scr, F.lane); continue; } r -= I_T2;
        if (r < I_T3) { const int dir = r / 64, q = r % 64, kb = q / 2, nb = q % 2; tr_item(F.in[I_RA1] + (size_t)dir * D * 64, 64, 64 * kb, 32 * nb, BtIn, nullptr, D, 6272 + 64 * dir + 32 * nb, 64 * kb, scr, F.lane); continue; } r -= I_T3;
        if (r < I_T4) { const int kb = r / 4, nb = r % 4; tr_item(F.in[I_RG1], 128, 64 * kb, 32 * nb, BtIn, nullptr, D, 6400 + 32 * nb, 64 * kb, scr, F.lane); continue; } r -= I_T4;
        if (r < I_T5) { const int kb = r / 4, nb = r % 4; tr_item(nullptr, 0, 0, 0, BtIn, nullptr, D, 6528 + 32 * nb, 64 * kb, scr, F.lane); continue; } r -= I_T5;
        if (r < I_T6) { const int kb = r / 64, nb = r % 64; f32x4 cv[8];
            ConvItem c; c.src = F.in[I_OUTW] + (size_t)(64 * kb) * D + 32 * nb; c.dst = (unsigned char*)BtOut + (size_t)(32 * nb) * D + 64 * kb;
            conv_issue(c, cv, F.lane); conv_finish(c, cv, scr, F.lane); continue; } r -= I_T6;
        if (r < I_T7) { const int nb = r / 8, kb = r % 8, j = nb / 32, n0 = (nb % 32) * 32; const float* src = nullptr; int k0 = 0;
            if (j == 0 && kb == 0) src = F.in[I_RW2];
            else if (j == 1 && kb == 1) src = F.in[I_RW2] + 64 * 1024;
            else if (j == 2 && kb == 2) src = F.in[I_RA2];
            else if (j == 3 && kb == 3) src = F.in[I_RA2] + 64 * 1024;
            else if (j == 4 && (kb == 4 || kb == 5)) { src = F.in[I_RG2]; k0 = 64 * (kb - 4); }
            tr_item(src, 1024, k0, n0, BtL, nullptr, KLORA, 32 * nb, 64 * kb, scr, F.lane); continue; } r -= I_T7;
        { const int kb = r; tr_item(F.in[I_ROUTW], 32, 64 * kb, 0, Wr, Wr + 32 * D, D, 0, 64 * kb, scr, F.lane); }
    }
}

__device__ __forceinline__ void p0_adaln(Frame& F) {
    if (F.bid >= 96) return;
    const int kh = F.bid / 48, cg = F.bid % 48, k0 = 1024 * kh + 128 * F.wave;
    LAS float* sc = (LAS float*)(F.lds + F.wave * 8704);
    for (int i = F.lane; i < 17 * 128; i += 64) { const int b = i / 128, k = i % 128; const float c = (b < 16) ? F.in[I_C][b * D + k0 + k] : F.in[I_CCTX][k0 + k]; sc[i] = c * fsigmoid(c); }
    LDS_WAIT(); asm volatile("" ::: "memory");
    const int col = cg * 256 + F.lane * 4;
    f32x4 acc[17];
#pragma unroll
    for (int b = 0; b < 17; ++b) acc[b] = (f32x4){0.f, 0.f, 0.f, 0.f};
    const float* W = F.in[I_ADAW] + (size_t)k0 * 12288 + col;
#pragma unroll 2
    for (int k = 0; k < 128; k += 4) {
        f32x4 w[4];
#pragma unroll
        for (int j = 0; j < 4; ++j) w[j] = *(const GAS f32x4*)(W + (size_t)(k + j) * 12288);
#pragma unroll
        for (int b = 0; b < 17; ++b) { const f32x4 s = *(const LAS f32x4*)(sc + b * 128 + k);
            acc[b] += s.x * w[0]; acc[b] += s.y * w[1]; acc[b] += s.z * w[2]; acc[b] += s.w * w[3]; }
    }
    __syncthreads();
    LAS f32x4* red = (LAS f32x4*)F.lds;
#pragma unroll
    for (int st = 4; st >= 1; st >>= 1) {
        if (F.wave >= st && F.wave < 2 * st) {
#pragma unroll
            for (int b = 0; b < 17; ++b) red[((F.wave - st) * 17 + b) * 64 + F.lane] = acc[b]; }
        __syncthreads();
        if (F.wave < st) {
#pragma unroll
            for (int b = 0; b < 17; ++b) acc[b] += red[(F.wave * 17 + b) * 64 + F.lane]; }
        __syncthreads();
    }
    if (F.wave == 0) { float* mp = wsp<float>(F, WS_MODACC) + (size_t)kh * 17 * 12288;
#pragma unroll
        for (int b = 0; b < 17; ++b) *(GAS f32x4*)(mp + (size_t)b * 12288 + col) = acc[b]; }
}
__device__ __forceinline__ f32x4 modv(const float* mp, const float* adab, int b, int idx) {
    return (*(const GAS f32x4*)(mp + (size_t)b * 12288 + idx) + *(const GAS f32x4*)(mp + (size_t)(17 + b) * 12288 + idx)) + *(const GAS f32x4*)(adab + idx);
}

__device__ __forceinline__ void p0_filter(Frame& F) {
    LAS float* hs = (LAS float*)(F.lds + 81920 + F.wave * 256);
    const int gw = F.bid * 8 + F.wave, NGW = F.G * 8, j = F.lane;
    const float freq = F.in[I_HFREQ][j];
    bf16* Gt = wsp<bf16>(F, WS_G);
    for (int t = gw; t < SEQ; t += NGW) {
        const float tl = (float)t * (1.0f / 2047.0f);
        float pre = F.in[I_HB1][j] + tl * F.in[I_HW1][j];
#pragma unroll 4
        for (int i = 0; i < 16; ++i) {
            const float band = 1e-4f + (float)i * ((15.0f - 1e-4f) / 15.0f);
            float rev = band * (float)t * (1.0f / 2048.0f); rev = rev - floorf(rev);
            const float cs = __builtin_amdgcn_cosf(rev), sn = __builtin_amdgcn_sinf(rev);
            pre += cs * F.in[I_HW1][(1 + i) * 64 + j] - sn * F.in[I_HW1][(17 + i) * 64 + j];
        }
        float h = __sinf(freq * pre);
        hs[j] = h; LDS_WAIT(); asm volatile("" ::: "memory");
        pre = F.in[I_HB2][j];
#pragma unroll 8
        for (int i = 0; i < 64; ++i) pre += hs[i] * F.in[I_HW2][i * 64 + j];
        h = __sinf(freq * pre);
        LDS_WAIT(); asm volatile("" ::: "memory");
        hs[j] = h; LDS_WAIT(); asm volatile("" ::: "memory");
        pre = F.in[I_HB3][j];
#pragma unroll 8
        for (int i = 0; i < 64; ++i) pre += hs[i] * F.in[I_HW3][i * 64 + j];
        h = __sinf(freq * pre);
        LDS_WAIT(); asm volatile("" ::: "memory");
        hs[j] = h; LDS_WAIT(); asm volatile("" ::: "memory");
        wsp<float>(F, WS_H3T)[(size_t)j * SEQ + t] = h;
        LDS_WAIT(); asm volatile("" ::: "memory");
    }
}
__device__ __forceinline__ void p1_filter_out(Frame& F) {
    LAS float* ws4 = (LAS float*)(F.lds + F.wave * 8192);
    const int gw = F.bid * 8 + F.wave, NGW = F.G * 8, lane = F.lane;
    const float* H3T = wsp<float>(F, WS_H3T); bf16* Gt = wsp<bf16>(F, WS_G);
    for (int u = gw; u < 64 * 32; u += NGW) {
        const int cb = u >> 5, tb = u & 31, c0 = 16 * cb, t = 64 * tb + lane;
#pragma unroll
        for (int k = 0; k < 8; ++k) { const int n = (k < 4) ? c0 + 4 * k : 1024 + c0 + 4 * (k - 4);
            *(LAS f32x4*)(ws4 + lane * 32 + 4 * k) = *(const GAS f32x4*)(F.in[I_HW4] + (size_t)lane * 2048 + n); }
        LDS_WAIT(); asm volatile("" ::: "memory");
        f32x4 o[8];
#pragma unroll
        for (int k = 0; k < 8; ++k) o[k] = (f32x4){0.f, 0.f, 0.f, 0.f};
#pragma unroll 1
        for (int ig = 0; ig < 8; ++ig) { float hh[8];
#pragma unroll
            for (int i = 0; i < 8; ++i) hh[i] = H3T[(size_t)(8 * ig + i) * SEQ + t];
#pragma unroll
            for (int i = 0; i < 8; ++i) {
#pragma unroll
                for (int k = 0; k < 8; ++k) o[k] += hh[i] * *(const LAS f32x4*)(ws4 + (8 * ig + i) * 32 + 4 * k); } }
        const float tl = (float)t * (1.0f / 2047.0f);
        const float dlo = -3.0701134573253945f, dhi = -15.350567286626973f;
#pragma unroll
        for (int k = 0; k < 8; ++k)
#pragma unroll
            for (int q = 0; q < 4; ++q) { const int c = c0 + 4 * (k & 3) + q;
                const float delta = fabsf(dlo + (dhi - dlo) * ((float)c * (1.0f / 1023.0f)));
                const float val = o[k][q] * __expf(-tl * delta);
                if (k < 4) Gt[(size_t)c * 4096 + (2048 - t)] = (bf16)f2bf(val);
                else if (t > 0) Gt[(size_t)c * 4096 + (2048 + t)] = (bf16)f2bf(val);
                else Gt[(size_t)c * 4096] = 0; }
        LDS_WAIT(); asm volatile("" ::: "memory");
    }
}

__device__ __forceinline__ void p1_norm1(Frame& F) {
    const int lane = F.lane;
    const float* macc = wsp<float>(F, WS_MODACC); const float* adab = F.in[I_ADAB];
    bf16* A1 = wsp<bf16>(F, WS_A1);
    constexpr int RPB = MROWS / 256; static_assert(RPB * 256 == MROWS && RPB == 144, "rows per workgroup");
    const int rbase = RPB * F.bid, blo = rbase < NLAT ? rbase / SEQ : 16;
    LAS float* TL = (LAS float*)(F.lds + 65536);
    { const int c = 4 * F.tid; const f32x4 g = *(const GAS f32x4*)(F.in[I_N1G] + c);
#pragma unroll
        for (int tb = 0; tb < 2; ++tb) { const int b = blo + tb < 16 ? blo + tb : 16;
            const f32x4 sh = modv(macc, adab, b, c), sc = modv(macc, adab, b, 2048 + c);
            *(LAS f32x4*)(TL + (tb * 2 + 0) * 2048 + c) = g * (1.0f + sc); *(LAS f32x4*)(TL + (tb * 2 + 1) * 2048 + c) = sh; } }
    __syncthreads();
    f32x4 va[2][8], vb[2][8];
#define N1_XROW(row) ((row) < NLAT ? F.in[I_X] + (size_t)(row) * D : F.in[I_CTX] + (size_t)((row) - NLAT) * D)
#define N1_LOAD(buf, it_) do { _Pragma("unroll") for (int r = 0; r < 2; ++r) { const int row = rbase + 8 * ((it_) + r) + F.wave; const float* xr = N1_XROW(row) + 8 * lane; \
        _Pragma("unroll") for (int j = 0; j < 4; ++j) { buf[r][2 * j] = *(const GAS f32x4*)(xr + 512 * j); buf[r][2 * j + 1] = *(const GAS f32x4*)(xr + 512 * j + 4); } } } while (0)
#define N1_PROC(buf, it_) do { _Pragma("unroll") for (int r = 0; r < 2; ++r) { const int row = rbase + 8 * ((it_) + r) + F.wave; const int b = row < NLAT ? row / SEQ : 16; \
        const LAS float* T0 = TL + (b - blo) * 4096 + 8 * lane; float ss = 0.f; \
        _Pragma("unroll") for (int j = 0; j < 8; ++j) ss += (buf[r][j].x * buf[r][j].x + buf[r][j].y * buf[r][j].y) + (buf[r][j].z * buf[r][j].z + buf[r][j].w * buf[r][j].w); \
        const float rstd = __builtin_amdgcn_rsqf(wave_sum(ss) * (1.0f / D) + 1e-6f); \
        _Pragma("unroll") for (int j = 0; j < 4; ++j) { \
            const f32x4 y0 = buf[r][2 * j] * rstd * *(const LAS f32x4*)(T0 + 512 * j) + *(const LAS f32x4*)(T0 + 2048 + 512 * j); \
            const f32x4 y1 = buf[r][2 * j + 1] * rstd * *(const LAS f32x4*)(T0 + 512 * j + 4) + *(const LAS f32x4*)(T0 + 2048 + 512 * j + 4); \
            v4u o; o.x = pk2(y0.x, y0.y); o.y = pk2(y0.z, y0.w); o.z = pk2(y1.x, y1.y); o.w = pk2(y1.z, y1.w); \
            *(GAS v4u*)(A1 + (size_t)row * D + 8 * lane + 512 * j) = o; } } } while (0)
    N1_LOAD(va, 0);
    for (int it = 0; it < 16; it += 4) { N1_LOAD(vb, it + 2); N1_PROC(va, it); N1_LOAD(va, it + 4); N1_PROC(vb, it + 2); }
    N1_PROC(va, 16);
#undef N1_XROW
#undef N1_LOAD
#undef N1_PROC
    if (F.bid < 16) { const int b = F.bid; float* T = wsp<float>(F, WS_MODT) + (size_t)b * 6144;
        for (int k = 4 * F.tid; k < D; k += 2048) { const f32x4 sh = modv(macc, adab, b, 3 * 2048 + k), sc = modv(macc, adab, b, 4 * 2048 + k);
            *(GAS f32x4*)(T + k) = *(const GAS f32x4*)(F.in[I_N2G] + k) * (1.0f + sc); *(GAS f32x4*)(T + 2048 + k) = sh; *(GAS f32x4*)(T + 4096 + k) = modv(macc, adab, b, 5 * 2048 + k); } }
}

namespace pg8 {
__device__ __forceinline__ void static_unit(int L, int nM, int nN, Unit& u) {
    const int nwg = nM * nN; int wgid = L;
    { const int q = nwg / NXCD, r = nwg % NXCD, xcd = wgid % NXCD, off = wgid / NXCD; wgid = (xcd < r ? xcd * (q + 1) : r * (q + 1) + (xcd - r) * q) + off; }
    const int nig = WGM * nN, gid = wgid / nig, fm = gid * WGM, gsz = (nM - fm) < WGM ? (nM - fm) : WGM;
    u.pm = fm + ((wgid % nig) % gsz); u.pn = (wgid % nig) / gsz; u.e = 0;
}
struct StaticOrder {
    int nM, nN, nwg, G, c;
    __device__ void init(int M, int N, int G_, int c_) { nM = M / BM; nN = N / BM; nwg = nM * nN; G = G_; c = c_; }
    __device__ __forceinline__ bool next(int i, Unit& u) const { const long L = (long)i * G + c; if (L >= nwg) return false; static_unit((int)L, nM, nN, u); return true; }
    __device__ __forceinline__ int arow(const Unit&, int) const { return 0; }
};
struct InProjOrder {
    int G, c;
    __device__ __forceinline__ bool next(int i, Unit& u) const {
        long L = (long)i * G + c;
        if (L < 128 * 26) { static_unit((int)L, 128, 26, u); return true; }
        L -= 128 * 26; if (L >= 16 * 13) return false;
        u.pm = 128 + (int)(L % 16); u.pn = 12 + (int)(L / 16); u.e = 0; return true;
    }
    __device__ __forceinline__ int arow(const Unit&, int) const { return 0; }
};
struct MoeOrder {
    int G, c, nN, ntiles; unsigned char* ws;
    __device__ __forceinline__ bool next(int i, Unit& u) const {
        const int x = c % 8, idx = c / 8, TR = 256 / nN, th = TR / 4, pw = nN / 2;
        u.pm = i * TR + (x >> 1) * th + idx / pw; u.pn = (x & 1) * pw + idx % pw;
        if (u.pm >= ntiles) return false;
        u.e = ((const int*)(ws + WS_ETAB))[256 + u.pm]; return true;
    }
    __device__ __forceinline__ int arow(const Unit& u, int r) const { const int* et = (const int*)(ws + WS_ETAB); const int row = u.pm * 256 + r; const bool valid = (row - et[u.e]) < et[64 + u.e]; return valid ? ((const int*)(ws + WS_ROWTOK))[row] : 0; }
};

struct EpiInProj {
    static constexpr bool PERM = true;
    bf16* Z; bf16* AP;
    __device__ __forceinline__ void operator()(const f32x4 (&acc)[2][2][4][2], const Unit& u, int wr, int wc, int fr, int fq) const {
        const int row0 = u.pm * BM + wr * 64 + fr;
        const bool lora = u.pn >= 24;
        bf16* base = lora ? AP + (u.pn - 24) * BM : Z + (size_t)u.pn * MROWS * 256; const int ldc = lora ? KLORA : 256;
        const int col0 = wc * 32 + 8 * fq;
#pragma unroll
        for (int ai = 0; ai < 2; ++ai)
#pragma unroll
            for (int m = 0; m < 4; ++m) { bf16* rowp = base + (size_t)(row0 + ai * HALF + m * 16) * ldc + col0;
#pragma unroll
                for (int bj = 0; bj < 2; ++bj) { f32x4 v0 = acc[ai][bj][m][0], v1 = acc[ai][bj][m][1];
                    if (lora) { const int act = (u.pn == 24) ? (bj == 0 ? 1 : 0) : (bj == 0 ? 2 : 0);
                        if (act == 1) {
#pragma unroll
                            for (int j = 0; j < 4; ++j) { v0[j] = ftanh(v0[j]); v1[j] = ftanh(v1[j]); } }
                        if (act == 2) {
#pragma unroll
                            for (int j = 0; j < 4; ++j) { v0[j] = fsigmoid(v0[j]); v1[j] = fsigmoid(v1[j]); } } }
                    v4u w; w.x = cvt_pk_bf16(v0[0], v0[1]); w.y = cvt_pk_bf16(v0[2], v0[3]); w.z = cvt_pk_bf16(v1[0], v1[1]); w.w = cvt_pk_bf16(v1[2], v1[3]);
                    *(v4u*)(rowp + bj * HALF) = w; } }
    }
};
struct EpiLora {
    static constexpr bool PERM = true;
    bf16* EA; const float* w0; const float* a0; int pn0;
    __device__ __forceinline__ void operator()(const f32x4 (&acc)[2][2][4][2], const Unit& u, int wr, int wc, int fr, int fq) const {
        const int pn = u.pn + pn0, row0 = u.pm * BM + wr * 64 + fr, col0 = pn * BM + wc * 32 + 8 * fq;
        const int blk = pn >> 2;
        const float* bias = blk < 2 ? w0 + col0 : (blk < 4 ? a0 + (col0 - 2048) : nullptr);
        const float scale = blk < 2 ? 0.60653065971263342f * 1.4426950408889634f : 1.0f;
        f32x4 bv[2][2];
#pragma unroll
        for (int bj = 0; bj < 2; ++bj)
#pragma unroll
            for (int n = 0; n < 2; ++n) bv[bj][n] = bias ? *(const f32x4*)(bias + bj * HALF + 4 * n) : (f32x4){0.f, 0.f, 0.f, 0.f};
#pragma unroll
        for (int ai = 0; ai < 2; ++ai)
#pragma unroll
            for (int m = 0; m < 4; ++m) { bf16* rowp = EA + (size_t)(row0 + ai * HALF + m * 16) * NLORA + col0;
#pragma unroll
                for (int bj = 0; bj < 2; ++bj) { f32x4 v0 = acc[ai][bj][m][0] + bv[bj][0], v1 = acc[ai][bj][m][1] + bv[bj][1];
                    if (blk < 4) {
#pragma unroll
                        for (int j = 0; j < 4; ++j) { v0[j] = scale * fsigmoid(v0[j]); v1[j] = scale * fsigmoid(v1[j]); } }
                    v4u w; w.x = cvt_pk_bf16(v0[0], v0[1]); w.y = cvt_pk_bf16(v0[2], v0[3]); w.z = cvt_pk_bf16(v1[0], v1[1]); w.w = cvt_pk_bf16(v1[2], v1[3]);
                    *(v4u*)(rowp + bj * HALF) = w; } }
    }
};
struct EpiOutProj {
    static constexpr bool PERM = false;
    const float* X; bf16* X1; const float* macc; const float* adab; float* SSQ;
    __device__ __forceinline__ void operator()(const f32x4 (&acc)[2][2][4][2], const Unit& u, int wr, int wc, int fr, int fq) const {
        const int row0 = u.pm * BM + wr * 64 + fr, col0 = u.pn * BM + wc * 32 + 4 * fq;
        const int b = (u.pm * BM) / SEQ;
        f32x4 gv[2][2];
#pragma unroll
        for (int bj = 0; bj < 2; ++bj)
#pragma unroll
            for (int n = 0; n < 2; ++n) { const int c = col0 + bj * HALF + n * 16; gv[bj][n] = modv(macc, adab, b, 2 * 2048 + c) * (1.0f / 256.0f); }
#pragma unroll
        for (int ai = 0; ai < 2; ++ai) {
            f32x4 xq[4][2][2];
#pragma unroll
            for (int m = 0; m < 4; ++m) { const size_t off = (size_t)(row0 + ai * HALF + m * 16) * D + col0;
#pragma unroll
                for (int bj = 0; bj < 2; ++bj)
#pragma unroll
                    for (int n = 0; n < 2; ++n) xq[m][bj][n] = *(const f32x4*)(X + off + bj * HALF + n * 16); }
            asm volatile("" ::: "memory");
#pragma unroll
            for (int m = 0; m < 4; ++m) { const int row = row0 + ai * HALF + m * 16; const size_t off = (size_t)row * D + col0; float sq[2] = {0.f, 0.f};
#pragma unroll
                for (int bj = 0; bj < 2; ++bj)
#pragma unroll
                    for (int n = 0; n < 2; ++n) { const f32x4 xv = xq[m][bj][n]; const f32x4 o = xv + gv[bj][n] * acc[ai][bj][m][n]; { v2u ob; ob.x = pk2(o.x, o.y); ob.y = pk2(o.z, o.w); *(v2u*)(X1 + off + bj * HALF + n * 16) = ob; }
                        sq[bj] += (o.x * o.x + o.y * o.y) + (o.z * o.z + o.w * o.w); }
#pragma unroll
                for (int bj = 0; bj < 2; ++bj) { float t = sq[bj]; t += __shfl_xor(t, 16); t += __shfl_xor(t, 32); if (fq == 0) SSQ[(size_t)row * 64 + u.pn * 8 + bj * 4 + wc] = t; } } }
    }
};
__device__ __forceinline__ unsigned pk4_fp8(float a, float b, float c, float d) { int w = __builtin_amdgcn_cvt_pk_fp8_f32(a, b, 0, false); w = __builtin_amdgcn_cvt_pk_fp8_f32(c, d, w, true); return (unsigned)w; }
struct EpiSwiglu {
    static constexpr bool PERM = true;
    unsigned char* ws; const float* bg; const float* bu;
    __device__ __forceinline__ void operator()(const f32x4 (&acc)[2][2][4][2], const Unit& u, int wr, int wc, int fr, int fq) const {
        const int row0 = u.pm * BM + wr * 64 + fr, col0 = u.pn * HALF + wc * 32 + 8 * fq;
        const float* pg = bg + (size_t)u.e * 2048 + col0; const float* pu = bu + (size_t)u.e * 2048 + col0;
        f32x4 bgv[2], buv[2];
#pragma unroll
        for (int n = 0; n < 2; ++n) { bgv[n] = *(const f32x4*)(pg + 4 * n); buv[n] = *(const f32x4*)(pu + 4 * n); }
#pragma unroll
        for (int ai = 0; ai < 2; ++ai)
#pragma unroll
            for (int m = 0; m < 4; ++m) { unsigned char* rowp = ws + WS_ACT + (size_t)(row0 + ai * HALF + m * 16) * 2048 + col0; float o[8];
#pragma unroll
                for (int n = 0; n < 2; ++n) { const f32x4 gq = acc[ai][0][m][n] * (1.0f / 64.0f) + bgv[n], uq = acc[ai][1][m][n] * (1.0f / 64.0f) + buv[n];
#pragma unroll
                    for (int j = 0; j < 4; ++j) { const float gg = fminf(gq[j], 7.0f), uu = fminf(fmaxf(uq[j], -7.0f), 7.0f);
                        const float t = gg * __builtin_amdgcn_rcpf(1.0f + __builtin_amdgcn_exp2f(-2.4554669595930156f * gg));
                        o[4 * n + j] = __builtin_fmaf(uu, t, t); } }
                v2u w; w.x = pk4_fp8(o[0], o[1], o[2], o[3]); w.y = pk4_fp8(o[4], o[5], o[6], o[7]);
                *(v2u*)rowp = w; }
    }
};
struct EpiDown {
    static constexpr bool PERM = true;
    unsigned char* ws; const float* bd;
    __device__ __forceinline__ void operator()(const f32x4 (&acc)[2][2][4][2], const Unit& u, int wr, int wc, int fr, int fq) const {
        const int row0 = u.pm * BM + wr * 64 + fr, col0 = u.pn * BM + wc * 32 + 8 * fq;
        const float* pb = bd + (size_t)u.e * 2048 + col0;
        const int* et = (const int*)(ws + WS_ETAB); const int lim = et[u.e] + et[64 + u.e];
        const int* rowdst = (const int*)(ws + WS_ROWDST); const float* rowgate = (const float*)(ws + WS_ROWGATE); unsigned char* SLOT = ws + WS_SLOT;
        f32x4 bv[2][2];
#pragma unroll
        for (int bj = 0; bj < 2; ++bj)
#pragma unroll
            for (int n = 0; n < 2; ++n) bv[bj][n] = *(const f32x4*)(pb + bj * HALF + 4 * n);
        int dsts[8]; float gts[8];
#pragma unroll
        for (int i = 0; i < 8; ++i) { const int row = row0 + (i >> 2) * HALF + (i & 3) * 16, rc = row < lim ? row : lim - 1; dsts[i] = rowdst[rc]; gts[i] = 16.0f * rowgate[rc]; }
#pragma unroll
        for (int ai = 0; ai < 2; ++ai)
#pragma unroll
            for (int m = 0; m < 4; ++m) { const int row = row0 + ai * HALF + m * 16;
                if (row < lim) { const float gt = gts[ai * 4 + m]; unsigned char* rowp = SLOT + (size_t)dsts[ai * 4 + m] * 2048 + col0;
#pragma unroll
                    for (int bj = 0; bj < 2; ++bj) { const f32x4 v0 = (acc[ai][bj][m][0] * (1.0f / 64.0f) + bv[bj][0]) * gt, v1 = (acc[ai][bj][m][1] * (1.0f / 64.0f) + bv[bj][1]) * gt;
                        v2u w; w.x = pk4_fp8(v0[0], v0[1], v0[2], v0[3]); w.y = pk4_fp8(v1[0], v1[1], v1[2], v1[3]);
                        *(v2u*)(rowp + bj * HALF) = w; } } }
    }
};
}

__device__ __forceinline__ f32x4 unpk4(v2u w) { return (f32x4){bflo(w.x), bfhi(w.x), bflo(w.y), bfhi(w.y)}; }
__device__ __forceinline__ v2u pk4(f32x4 v) { v2u o; o.x = pk2(v.x, v.y); o.y = pk2(v.z, v.w); return o; }
__device__ __forceinline__ f32x4 ldz4(const bf16* p, bool ok) { return ok ? unpk4(*(const GAS v2u*)p) : (f32x4){0.f, 0.f, 0.f, 0.f}; }

__device__ __forceinline__ void p4_prep(Frame& F) {
    const int gw = F.bid * 8 + F.wave, NGW = F.G * 8, lane = F.lane;
    const bf16* Z = wsp<bf16>(F, WS_Z); const bf16* EA = wsp<bf16>(F, WS_EA); float* KI = wsp<float>(F, WS_KKINV); bf16* ZC = wsp<bf16>(F, WS_ZC);
    bf16* UT = wsp<bf16>(F, WS_UT); bf16* X0T = wsp<bf16>(F, WS_X0T); float* BS = wsp<float>(F, WS_BS);
    const float* cw = F.in[I_CONVW]; const float* cb = F.in[I_CONVB];
#define ZB(cblk, row) (Z + ((size_t)(cblk) * MROWS + (size_t)(row)) * 256 + 4 * lane)
    constexpr int NU_LAT = 16 * 64 * 8, NU = NU_LAT + 16 * 32 * 4;
    for (int u = gw; u < NU; u += NGW) {
        int b, t0, slice, ng8; bool lat;
        if (u < NU_LAT) { lat = true; const int w = u % 8, blk = u / 8, sp = blk % 4, cg = (blk / 4) % 16; b = blk / 64;
            t0 = (4 * cg + (w % 4)) * 32; slice = sp + 4 * (w / 4); ng8 = 4; }
        else { lat = false; const int v = u - NU_LAT; b = v / 128; t0 = ((v % 128) / 4) * 8; slice = 4 + (v % 4); ng8 = 1; }
        const int Ls = lat ? SEQ : CTXL, rowbase = lat ? b * SEQ : NLAT + b * CTXL;
        if (slice < 4) {
            const int c0 = 256 * slice + 4 * lane;
            f32x4 w[3][3], bi[3];
#pragma unroll
            for (int a = 0; a < 3; ++a) { bi[a] = *(const GAS f32x4*)(cb + a * 1024 + c0);
#pragma unroll
                for (int tp = 0; tp < 3; ++tp) w[a][tp] = *(const GAS f32x4*)(cw + (size_t)tp * PW + a * 1024 + c0); }
            f32x4 pv[3], cu[3];
#pragma unroll
            for (int a = 0; a < 3; ++a) { pv[a] = ldz4(ZB(a * 4 + slice, rowbase + t0 - 1), t0 > 0); cu[a] = ldz4(ZB(a * 4 + slice, rowbase + t0), true); }
            v2u raw[8][3];
#define PZ_LD(cblk, tt) (*(const GAS v2u*)ZB((cblk), rowbase + ((tt) < Ls ? (tt) : Ls - 1)))
#pragma unroll
            for (int i = 0; i < 8; ++i)
#pragma unroll
                for (int a = 0; a < 3; ++a) raw[i][a] = PZ_LD(a * 4 + slice, t0 + i + 1);
#define HY_GROUP(G8, REFILL) { float x0v[4][8], uv[4][8]; \
                _Pragma("unroll") for (int i = 0; i < 8; ++i) { const int t = t0 + 8 * (G8) + i; f32x4 zc[3]; \
                    _Pragma("unroll") for (int a = 0; a < 3; ++a) { f32x4 nx = unpk4(raw[i][a]); if (!(t + 1 < Ls)) nx = (f32x4){0.f, 0.f, 0.f, 0.f}; \
                        if (REFILL) raw[i][a] = PZ_LD(a * 4 + slice, t + 9); \
                        zc[a] = pv[a] * w[a][0] + cu[a] * w[a][1] + nx * w[a][2] + bi[a]; pv[a] = cu[a]; cu[a] = nx; } \
                    const f32x4 uu = zc[2] * zc[1]; \
                    _Pragma("unroll") for (int j = 0; j < 4; ++j) { x0v[j][i] = zc[0][j]; uv[j][i] = uu[j]; } } \
                _Pragma("unroll") for (int j = 0; j < 4; ++j) { const size_t o = ((size_t)(c0 + j) * 16 + b) * SEQ + t0 + 8 * (G8); \
                    v4u a, c; a.x = pk2(x0v[j][0], x0v[j][1]); a.y = pk2(x0v[j][2], x0v[j][3]); a.z = pk2(x0v[j][4], x0v[j][5]); a.w = pk2(x0v[j][6], x0v[j][7]); \
                    c.x = pk2(uv[j][0], uv[j][1]); c.y = pk2(uv[j][2], uv[j][3]); c.z = pk2(uv[j][4], uv[j][5]); c.w = pk2(uv[j][6], uv[j][7]); \
                    *(GAS v4u*)(X0T + o) = a; *(GAS v4u*)(UT + o) = c; } }
            for (int g8 = 0; g8 < 3; ++g8) HY_GROUP(g8, true)
            HY_GROUP(3, false)
#undef HY_GROUP
        } else {
            const int q = slice - 4, c0 = 256 * q + 4 * lane;
            f32x4 w[3][3], bi[3];
#pragma unroll
            for (int a = 0; a < 3; ++a) { bi[a] = *(const GAS f32x4*)(cb + 3072 + a * 1024 + c0);
#pragma unroll
                for (int tp = 0; tp < 3; ++tp) w[a][tp] = *(const GAS f32x4*)(cw + (size_t)tp * PW + 3072 + a * 1024 + c0); }
            const f32x4 kkw = *(const GAS f32x4*)(F.in[I_RKK] + c0), kaw = *(const GAS f32x4*)(F.in[I_RKA] + c0), rkw = *(const GAS f32x4*)(F.in[I_RRK] + c0);
            f32x4 pv[3], cu[3];
#pragma unroll
            for (int a = 0; a < 3; ++a) { pv[a] = ldz4(ZB(12 + a * 4 + q, rowbase + t0 - 1), t0 > 0); cu[a] = ldz4(ZB(12 + a * 4 + q, rowbase + t0), true); }
            v2u raw[8][3], ra[8][2];
#pragma unroll
            for (int i = 0; i < 8; ++i) { const bf16* ep = EA + (size_t)(rowbase + t0 + i) * NLORA + 2048 + c0;
#pragma unroll
                for (int a = 0; a < 3; ++a) raw[i][a] = PZ_LD(12 + a * 4 + q, t0 + i + 1);
                ra[i][0] = *(const GAS v2u*)ep; ra[i][1] = *(const GAS v2u*)(ep + 1024); }
#define RW_GROUP(G8, REFILL) { \
                _Pragma("unroll") for (int i = 0; i < 8; ++i) { const int t = t0 + 8 * (G8) + i, row = rowbase + t; f32x4 zc[3]; \
                    _Pragma("unroll") for (int a = 0; a < 3; ++a) { f32x4 nx = unpk4(raw[i][a]); if (!(t + 1 < Ls)) nx = (f32x4){0.f, 0.f, 0.f, 0.f}; \
                        if (REFILL) raw[i][a] = PZ_LD(12 + a * 4 + q, t + 9); \
                        zc[a] = pv[a] * w[a][0] + cu[a] * w[a][1] + nx * w[a][2] + bi[a]; pv[a] = cu[a]; cu[a] = nx; } \
                    const f32x4 a0 = unpk4(ra[i][0]), a1 = unpk4(ra[i][1]); \
                    if (REFILL) { const bf16* ep = EA + (size_t)(row + 8) * NLORA + 2048 + c0; ra[i][0] = *(const GAS v2u*)ep; ra[i][1] = *(const GAS v2u*)(ep + 1024); } \
                    const f32x4 zr = zc[0], zk = zc[1]; \
                    const f32x4 kk = zk * kkw; \
                    const float n2 = row16_sum((kk.x * kk.x + kk.y * kk.y) + (kk.z * kk.z + kk.w * kk.w)); \
                    const float inv = 1.0f / fmaxf(sqrtf(n2), 1e-12f); \
                    const f32x4 bt = zr * zk * (2.0f + (a0 + a1 - 2.0f) * kaw) * rkw; \
                    const float bsum = row16_sum((bt.x + bt.y) + (bt.z + bt.w)); \
                    bf16* zo = ZC + ((size_t)(4 * q + (lane >> 4)) * MROWS + row) * 192 + 4 * (lane & 15);         \
                    *(GAS v2u*)(zo) = pk4(zr); *(GAS v2u*)(zo + 64) = pk4(zk); *(GAS v2u*)(zo + 128) = pk4(zc[2]); \
                    if ((lane & 15) == 0) { KI[(size_t)row * 16 + 4 * q + (lane >> 4)] = inv; if (lat) BS[(size_t)row * 16 + 4 * q + (lane >> 4)] = bsum; } } }
            for (int g8 = 0; g8 < ng8 - 1; ++g8) RW_GROUP(g8, true)
            RW_GROUP(ng8 - 1, false)
#undef RW_GROUP
#undef PZ_LD
        }
    }
}
#undef ZB

typedef short bf16x4 __attribute__((ext_vector_type(4)));
__device__ __forceinline__ int scan_row(int s, int dir, int b) {
    return s < CTXL ? NLAT + b * CTXL + (dir ? CTXL - 1 - s : s) : b * SEQ + (dir ? SEQ - 1 - (s - CTXL) : (s - CTXL));
}
__device__ __forceinline__ bf16x4 pack4(f32x4 v) { v2u o; o.x = pk2(v.x, v.y); o.y = pk2(v.z, v.w); return __builtin_bit_cast(bf16x4, o); }
__device__ __forceinline__ bf16x8 cat8(bf16x4 a, bf16x4 b) { return __builtin_shufflevector(a, b, 0, 1, 2, 3, 4, 5, 6, 7); }
#define MF16(a, b, c) __builtin_amdgcn_mfma_f32_16x16x32_bf16(cat8((a), (bf16x4){0, 0, 0, 0}), cat8((b), (bf16x4){0, 0, 0, 0}), (c), 0, 0, 0)
#define MF32(a, b, c) __builtin_amdgcn_mfma_f32_16x16x32_bf16((a), (b), (c), 0, 0, 0)
template <int CTRL> __device__ __forceinline__ float dpp_shr0(float x) { return __builtin_bit_cast(float, __builtin_amdgcn_update_dpp(0, __builtin_bit_cast(int, x), CTRL, 0xF, 0xF, true)); }
__device__ __forceinline__ float dpp_swap1(float x) { return __builtin_bit_cast(float, __builtin_amdgcn_update_dpp(0, __builtin_bit_cast(int, x), 0xB1, 0xF, 0xF, true)); }
__device__ __forceinline__ float row16_incl_scan(float x) { x += dpp_shr0<0x111>(x); x += dpp_shr0<0x112>(x); x += dpp_shr0<0x114>(x); x += dpp_shr0<0x118>(x); return x; }
constexpr int SC_AT = 0, SC_RT = 2304, SC_BT = 4608, SC_KT = 6912, SC_BHT = 9216, SC_KHT = 11264, SC_VT = 13312, SC_GC = 15360, SC_BUF = 15616, SC_CW = 2 * SC_BUF, SC_CHAIN = 2 * SC_BUF + 14 * 256;
#define SCAN_BODY(CKX, ldcur, ldnext, KQ) { const int ck = (CKX); const int p = ck & 1; if (ck + 3 < NCK) SCAN_ISSUE(ldcur, ck + 3); \
              \
            ConvItem cvi; cvi.src = csrc[KQ] + (size_t)eg * D * D; cvi.dst = cdst[KQ] + (size_t)eg * ((KQ) == 2 ? (size_t)D * D : (size_t)4096 * D); const bool cvon = ck < NCONV; if (cvon) conv_issue_m(cvi, cv, lane); \
            const LAS unsigned char* d = cb + p * SC_BUF; \
            bf16x8 Af[2], Rf[2], Bf[2], Kf[2]; \
_Pragma("unroll") \
            for (int m = 0; m < 2; ++m) { const int o = lr * 144 + m * 64 + q * 16; \
                Af[m] = *(const LAS bf16x8*)(d + SC_AT + o); Rf[m] = *(const LAS bf16x8*)(d + SC_RT + o); Bf[m] = *(const LAS bf16x8*)(d + SC_BT + o); Kf[m] = *(const LAS bf16x8*)(d + SC_KT + o); } \
            const bf16x4 Vf = *(const LAS bf16x4*)(d + SC_VT + (16 * w4 + lr) * 32 + 8 * q); \
            f32x4 GabT = MF32(Bf[0], Af[0], zero4); GabT = MF32(Bf[1], Af[1], GabT); \
            f32x4 Gab = MF32(Af[0], Bf[0], zero4); Gab = MF32(Af[1], Bf[1], Gab); \
            f32x4 GakT = MF32(Kf[0], Af[0], zero4); GakT = MF32(Kf[1], Af[1], GakT); \
            f32x4 GrbT = MF32(Bf[0], Rf[0], zero4); GrbT = MF32(Bf[1], Rf[1], GrbT); \
            f32x4 GrkT = MF32(Kf[0], Rf[0], zero4); GrkT = MF32(Kf[1], Rf[1], GrkT); \
_Pragma("unroll") \
            for (int j = 0; j < 4; ++j) { const int i = 4 * q + j; \
                GabT[j] = (i < lr) ? GabT[j] : 0.f; GakT[j] = (i < lr) ? GakT[j] : 0.f; GrbT[j] = (i <= lr) ? GrbT[j] : 0.f; GrkT[j] = (i <= lr) ? GrkT[j] : 0.f; \
                Gab[j] = (lr < i) ? Gab[j] : 0.f; } \
            const bf16x4 LakA = pack4(GakT), LrbA = pack4(GrbT), LrkA = pack4(GrkT); \
            f32x4 X = GabT, Y = Gab, Tt = GabT; \
_Pragma("unroll") \
            for (int j = 0; j < 4; ++j) Tt[j] += (4 * q + j == lr) ? 1.0f : 0.f; \
_Pragma("unroll") \
            for (int lv = 0; lv < 3; ++lv) { const bf16x4 x = pack4(X), y = pack4(Y); \
                const f32x4 Y2 = MF16(x, y, zero4), X2 = MF16(y, x, zero4); \
                Tt = MF16(pack4(Y2), pack4(Tt), Tt); \
                X = X2; Y = Y2; } \
            const bf16x4 TinvA = pack4(Tt); \
            bf16x4 Sb[4]; \
_Pragma("unroll") \
            for (int kb = 0; kb < 4; ++kb) Sb[kb] = pack4(ST[kb]); \
            const bf16x8 SB0 = cat8(Sb[0], Sb[1]), SB1 = cat8(Sb[2], Sb[3]); \
            f32x4 W = MF16(LakA, Vf, zero4); W = MF32(Af[0], SB0, W); W = MF32(Af[1], SB1, W); \
            const f32x4 U = MF16(TinvA, pack4(W), zero4); \
            const bf16x4 Ub = pack4(U); \
            const bf16x8 UV = cat8(Ub, Vf);                              \
            f32x4 Yt = MF32(Rf[0], SB0, zero4); Yt = MF32(Rf[1], SB1, Yt); Yt = MF32(cat8(LrbA, LrkA), UV, Yt); \
_Pragma("unroll") \
            for (int kb = 0; kb < 4; ++kb) { const f32x4 g = *(const LAS f32x4*)(d + SC_GC + (16 * kb + 4 * q) * 4); \
                const bf16x4 bh = *(const LAS bf16x4*)(d + SC_BHT + (16 * kb + lr) * 32 + 8 * q), kh = *(const LAS bf16x4*)(d + SC_KHT + (16 * kb + lr) * 32 + 8 * q); \
                f32x4 s = ST[kb] * g; s = MF32(cat8(bh, kh), UV, s); ST[kb] = s; } \
            if (ck >= CTXL / 16) { \
                { const bool ev_ = (lr & 1) == 0; const float r0_ = dpp_swap1(ev_ ? Yt[2] : Yt[0]), r1_ = dpp_swap1(ev_ ? Yt[3] : Yt[1]); \
                  const unsigned p0_ = ev_ ? pk2(Yt[0], r0_) : pk2(r0_, Yt[2]), p1_ = ev_ ? pk2(Yt[1], r1_) : pk2(r1_, Yt[3]); const int s0_ = ck * 16 + 4 * q + (ev_ ? 0 : 2); \
                  char* yb_ = (char*)YS + ((unsigned)(dir * 16 + h) * NLAT) * 128u + 2u * (unsigned)(16 * w4 + (lr & ~1)); \
                  *(GAS unsigned*)(yb_ + (unsigned)scan_row(s0_, dir, b) * 128u) = p0_; *(GAS unsigned*)(yb_ + (unsigned)scan_row(s0_ + 1, dir, b) * 128u) = p1_; } } \
            __syncthreads();                                           \
            if (cvon) conv_finish_m(cvi, cv, csel, lane); \
            if (ck + 1 < NCK) SCAN_COMMIT(ldnext, p ^ 1); \
            __syncthreads(); }
__device__ __forceinline__ void p5_scan(Frame& F) {
    const int cwv = F.wave >> 2, w4 = F.wave & 3, lane = F.lane, tc = F.tid & 255, q = lane >> 4, lr = lane & 15;
    const bf16* ZC = wsp<bf16>(F, WS_ZC); const bf16* EA = wsp<bf16>(F, WS_EA); const float* KI = wsp<float>(F, WS_KKINV); bf16* YS = wsp<bf16>(F, WS_YS);
    for (int cp = F.bid; cp < 256; cp += F.G) {
        const int chain = cp * 2 + cwv, dir = chain >> 8, b = (chain >> 4) & 15, h = chain & 15;
        LAS unsigned char* cb = F.lds + cwv * SC_CHAIN;
        const int sl = lr, jc = 4 * w4 + q, coff = h * 64 + 4 * jc;
        const int ppos = 32 * (jc >> 3) + 8 * (jc & 3) + 4 * ((jc >> 2) & 1);
        v2u ld0[6], ld1[6], ld2[6];
#define SCAN_ISSUE(ld, ck_) do { const unsigned row_ = (unsigned)scan_row((ck_) * 16 + sl, dir, b); const char* zp_ = (const char*)ZC + (((unsigned)h * MROWS + row_) * 384u + 8u * (unsigned)jc); \
            ld[0] = *(const GAS v2u*)(zp_); ld[1] = *(const GAS v2u*)(zp_ + 128); ld[2] = *(const GAS v2u*)(zp_ + 256); \
            const char* ep_ = (const char*)EA + (row_ * (2u * NLORA) + 2u * (unsigned)(dir * 1024 + coff)); \
            ld[3] = *(const GAS v2u*)(ep_); ld[4] = *(const GAS v2u*)(ep_ + 4096); \
            ld[5].x = *(const GAS unsigned*)((const char*)KI + (row_ * 64u + 4u * (unsigned)h)); ld[5].y = 0u; } while (0)
#define SCAN_COMMIT(ld, p_) do { LAS unsigned char* d_ = cb + (p_) * SC_BUF; const LAS f32x4* cw_ = (const LAS f32x4*)(cb + SC_CW) + jc; \
            const f32x4 r_ = unpk4(ld[0]), zk_ = unpk4(ld[1]), v_ = unpk4(ld[2]); \
            const f32x4 e_ = unpk4(ld[3]), as_ = unpk4(ld[4]); const float inv_ = __builtin_bit_cast(float, ld[5].x); \
            const f32x4 kk_ = zk_ * cw_[0] * inv_, kd_ = zk_ * (1.0f + (as_ - 1.0f) * cw_[16]), b_ = kk_ * as_; \
            f32x4 Ei_, Et_; \
            _Pragma("unroll") for (int i_ = 0; i_ < 4; ++i_) { Ei_[i_] = row16_incl_scan(e_[i_]); Et_[i_] = row16_sum(e_[i_]); } \
            f32x4 gin_, gex_, ginv_, grem_, gct_; \
            _Pragma("unroll") for (int i_ = 0; i_ < 4; ++i_) { gin_[i_] = __builtin_amdgcn_exp2f(-Ei_[i_]); gex_[i_] = __builtin_amdgcn_exp2f(e_[i_] - Ei_[i_]); ginv_[i_] = __builtin_amdgcn_exp2f(Ei_[i_]); gct_[i_] = __builtin_amdgcn_exp2f(-Et_[i_]); } \
            grem_ = ginv_ * gct_;                                        \
            *(LAS v2u*)(d_ + SC_AT + sl * 144 + 2 * ppos) = pk4(-kk_ * gex_); \
            *(LAS v2u*)(d_ + SC_RT + sl * 144 + 2 * ppos) = pk4(r_ * gin_); \
            *(LAS v2u*)(d_ + SC_BT + sl * 144 + 2 * ppos) = pk4(b_ * ginv_); \
            *(LAS v2u*)(d_ + SC_KT + sl * 144 + 2 * ppos) = pk4(kd_ * ginv_); \
            const f32x4 bh_ = b_ * grem_, kh_ = kd_ * grem_; \
            { const v2u bhp_ = pk4(bh_), khp_ = pk4(kh_); const unsigned bw_[2] = {bhp_.x, bhp_.y}, kw_[2] = {khp_.x, khp_.y}, vw_[2] = {ld[2].x, ld[2].y}; \
            _Pragma("unroll") for (int i_ = 0; i_ < 4; ++i_) { const int sh_ = 16 * (i_ & 1); \
                *(LAS bf16*)(d_ + SC_BHT + (4 * jc + i_) * 32 + 2 * sl) = (bf16)(bw_[i_ >> 1] >> sh_); \
                *(LAS bf16*)(d_ + SC_KHT + (4 * jc + i_) * 32 + 2 * sl) = (bf16)(kw_[i_ >> 1] >> sh_); \
                *(LAS bf16*)(d_ + SC_VT + (4 * jc + i_) * 32 + 2 * sl) = (bf16)(vw_[i_ >> 1] >> sh_); } } \
            if (sl == 0) *(LAS f32x4*)(d_ + SC_GC + 16 * jc) = gct_; } while (0)
        if (tc < 32) { const int a_ = tc >> 4, j_ = tc & 15; ((LAS f32x4*)(cb + SC_CW))[a_ * 16 + j_] = *(const GAS f32x4*)(F.in[a_ == 0 ? I_RKK : I_RKA] + h * 64 + 4 * j_); }
        __syncthreads();
        f32x4 cv[8]; const ConvSel csel = conv_sel(lane); LAS float* cscr = (LAS float*)(F.lds + 2 * SC_CHAIN + F.wave * 8448); const int gwv = F.bid * 8 + F.wave, NGWV = F.G * 8;
        constexpr int NCONV = NE * 6144 / 2048; static_assert(NCONV <= (CTXL + SEQ) / 16, "one expert-weight item per chunk");
        f32x4 ST[4];
#pragma unroll
        for (int i = 0; i < 4; ++i) ST[i] = (f32x4){0.f, 0.f, 0.f, 0.f};
        SCAN_ISSUE(ld0, 0); SCAN_ISSUE(ld1, 1); SCAN_ISSUE(ld2, 2); SCAN_COMMIT(ld0, 0); __syncthreads();
        constexpr int NCK = (CTXL + SEQ) / 16; static_assert(NCK % 3 == 0, "chunk loop unrolled by 3");
        const f32x4 zero4 = (f32x4){0.f, 0.f, 0.f, 0.f};
        if (cwv == 1) __syncthreads();
        const float* csrc[3]; unsigned char* cdst[3];
        { const int kb = gwv >> 6, nb = gwv & 63; const size_t so = (size_t)(64 * kb) * D + 32 * nb;
          csrc[0] = F.in[I_EWG] + so; csrc[1] = F.in[I_EWU] + so; csrc[2] = F.in[I_EWD] + so;
          cdst[0] = F.ws + WS_BTGU + (size_t)(256 * (nb / 4) + 32 * (nb % 4)) * D + 64 * kb; cdst[1] = cdst[0] + (size_t)128 * D; cdst[2] = F.ws + WS_BTD + (size_t)(32 * nb) * D + 64 * kb; }
        int eg = 0;
        for (int ck3 = 0; ck3 < NCK; ck3 += 3, ++eg) { SCAN_BODY(ck3, ld0, ld1, 0) SCAN_BODY(ck3 + 1, ld1, ld2, 1) SCAN_BODY(ck3 + 2, ld2, ld0, 2) }
        if (cwv == 0) __syncthreads();
    }
}

constexpr int HY_UROW = 4128, HY_GOFF = 16 * HY_UROW, HY_CS = 8208;
__device__ __forceinline__ void p6_hyena(Frame& F) {
    const int lane = F.lane, tl = lane & 15, q = lane >> 4, wave = F.wave, tid = F.tid;
    const bf16* UT = wsp<bf16>(F, WS_UT); const bf16* Gt = wsp<bf16>(F, WS_G); bf16* YCT = wsp<bf16>(F, WS_YCT);
    LAS unsigned char* lds = F.lds;
    const int r = (8 - (tl & 7)) & 7;
    const int abase = HY_GOFF + r * HY_CS + 2 * (2048 + 8 * q - (tl + r)) - 32 * (16 * wave);
    const int bbase = tl * HY_UROW + 16 * q;
    for (int c = F.bid; c < 1024; c += F.G) {
#pragma unroll
        for (int i = 0; i < 8; ++i) { const int id = tid + 512 * i, bb = id >> 8, ch = id & 255;
            const v4u v = *(const GAS v4u*)(UT + ((size_t)c * 16 + bb) * SEQ + 8 * ch); *(LAS v4u*)(lds + bb * HY_UROW + 16 * ch) = v; }
        { const v4u v = *(const GAS v4u*)(Gt + (size_t)c * 4096 + 8 * tid); *(LAS v4u*)(lds + HY_GOFF + 16 * tid) = v; }
        __syncthreads();
        { unsigned d[8]; const v4u lo = *(const LAS v4u*)(lds + HY_GOFF + 16 * tid); const v4u hi = tid < 511 ? *(const LAS v4u*)(lds + HY_GOFF + 16 * tid + 16) : (v4u){0u, 0u, 0u, 0u};
            d[0] = lo.x; d[1] = lo.y; d[2] = lo.z; d[3] = lo.w; d[4] = hi.x; d[5] = hi.y; d[6] = hi.z; d[7] = hi.w;
#pragma unroll
            for (int rr = 1; rr < 8; ++rr) { v4u o;
                if ((rr & 1) == 0) { o.x = d[rr / 2]; o.y = d[rr / 2 + 1]; o.z = d[rr / 2 + 2]; o.w = d[rr / 2 + 3]; }
                else { const int e = (rr - 1) / 2; o.x = __builtin_amdgcn_alignbit(d[e + 1], d[e], 16); o.y = __builtin_amdgcn_alignbit(d[e + 2], d[e + 1], 16);
                       o.z = __builtin_amdgcn_alignbit(d[e + 3], d[e + 2], 16); o.w = __builtin_amdgcn_alignbit(d[e + 4], d[e + 3], 16); }
                *(LAS v4u*)(lds + HY_GOFF + rr * HY_CS + 16 * tid) = o; } }
        __syncthreads();
        f32x4 acc[16]; bf16x8 P[16];
#pragma unroll
        for (int it = 0; it < 16; ++it) acc[it] = (f32x4){0.f, 0.f, 0.f, 0.f};
#pragma unroll
        for (int it = 2; it < 16; ++it) P[it] = *(const LAS bf16x8*)(lds + abase - 32 * it);
        for (int i8 = 0; i8 < 8; ++i8) {
#pragma unroll
            for (int u = 0; u < 8; ++u) {
                const int isb = i8 * 8 + u;
                const bf16x8 bf = *(const LAS bf16x8*)(lds + bbase + 64 * isb);
                P[(16 - 2 * u) & 15] = *(const LAS bf16x8*)(lds + abase + 64 * isb);
                P[(17 - 2 * u) & 15] = *(const LAS bf16x8*)(lds + abase + 64 * isb - 32);
#pragma unroll
                for (int k = 0; k < 16; ++k) { const int it = (k + 2) & 15;
                    acc[it] = __builtin_amdgcn_mfma_f32_16x16x32_bf16(P[(it - 2 * u) & 15], bf, acc[it], 0, 0, 0); }
            }
        }
#pragma unroll
        for (int it = 0; it < 16; ++it) { v2u o; o.x = pk2(acc[it].x, acc[it].y); o.y = pk2(acc[it].z, acc[it].w);
            *(GAS v2u*)(YCT + ((size_t)c * 16 + tl) * SEQ + 256 * wave + 16 * it + 4 * q) = o; }
        __syncthreads();
    }
}

__device__ __forceinline__ void p7_assemble(Frame& F) {
    const int gw = F.bid * 8 + F.wave, NGW = F.G * 8, lane = F.lane;
    unsigned char* A2 = wsp<unsigned char>(F, WS_A2);
    const bf16* YCT = wsp<bf16>(F, WS_YCT); const bf16* X0T = wsp<bf16>(F, WS_X0T); const bf16* UT = wsp<bf16>(F, WS_UT);
    const bf16* YS = wsp<bf16>(F, WS_YS); const float* BS = wsp<float>(F, WS_BS); const bf16* ZC = wsp<bf16>(F, WS_ZC); const bf16* EA = wsp<bf16>(F, WS_EA);
    LAS unsigned char* tile = F.lds + F.wave * 9216;
    constexpr int NU_H = 16 * 32 * 16, NU = NU_H + (NLAT / 16) * 4;
    for (int u = gw; u < NU; u += NGW) {
        if (u < NU_H) {
            const int b = u / 512, rem = u % 512, tb = rem / 16, g = rem % 16, ci = lane >> 3, tq = lane & 7;
            float val[8][8]; float ss[8];
#pragma unroll
            for (int k = 0; k < 8; ++k) ss[k] = 0.f;
#pragma unroll
            for (int i = 0; i < 8; ++i) { const int ch = g * 64 + 8 * ci + i; const size_t o = ((size_t)ch * 16 + b) * SEQ + 64 * tb + 8 * tq;
                const v4u yc = *(const GAS v4u*)(YCT + o), x0 = *(const GAS v4u*)(X0T + o), uu = *(const GAS v4u*)(UT + o); const float bias = F.in[I_HBIAS][ch];
                const unsigned ycw[4] = {yc.x, yc.y, yc.z, yc.w}, x0w[4] = {x0.x, x0.y, x0.z, x0.w}, uw[4] = {uu.x, uu.y, uu.z, uu.w};
#pragma unroll
                for (int k = 0; k < 4; ++k) { const float v0 = bflo(x0w[k]) * (bflo(ycw[k]) + bias * bflo(uw[k])), v1 = bfhi(x0w[k]) * (bfhi(ycw[k]) + bias * bfhi(uw[k]));
                    val[i][2 * k] = v0; val[i][2 * k + 1] = v1; ss[2 * k] += v0 * v0; ss[2 * k + 1] += v1 * v1; } }
#pragma unroll
            for (int k = 0; k < 8; ++k) { float s = ss[k]; s += __shfl_xor(s, 8); s += __shfl_xor(s, 16); s += __shfl_xor(s, 32); ss[k] = 1.0f / sqrtf(s * (1.0f / 64.0f) + 1e-6f); }
            float ng[8];
#pragma unroll
            for (int i = 0; i < 8; ++i) ng[i] = 4.0f * F.in[I_HNG][g * 64 + 8 * ci + i];
#pragma unroll
            for (int k = 0; k < 8; ++k) { v2u o; o.x = pg8::pk4_fp8(val[0][k] * ss[k] * ng[0], val[1][k] * ss[k] * ng[1], val[2][k] * ss[k] * ng[2], val[3][k] * ss[k] * ng[3]);
                o.y = pg8::pk4_fp8(val[4][k] * ss[k] * ng[4], val[5][k] * ss[k] * ng[5], val[6][k] * ss[k] * ng[6], val[7][k] * ss[k] * ng[7]);
                *(LAS v2u*)(tile + (8 * tq + k) * 72 + 8 * ci) = o; }
            LDS_WAIT(); asm volatile("" ::: "memory");
#pragma unroll
            for (int i = 0; i < 8; ++i) { const int t = (lane >> 3) + 8 * i, pc = lane & 7; const v2u o = *(const LAS v2u*)(tile + t * 72 + 8 * pc);
                *(GAS v2u*)(A2 + (size_t)(b * SEQ + 64 * tb + t) * D + g * 64 + 8 * pc) = o; }
            LDS_WAIT(); asm volatile("" ::: "memory");
        } else {
            const int v = u - NU_H, tk = v / 4, q = v % 4, c0 = 256 * q + 4 * lane;
            const f32x4 lg = *(const GAS f32x4*)(F.in[I_LNG] + c0), lb = *(const GAS f32x4*)(F.in[I_LNB] + c0);
            for (int i = 0; i < 16; ++i) { const int row = tk * 16 + i;
                const bf16* yp = YS + ((size_t)(4 * q + (lane >> 4)) * NLAT + row) * 64 + 4 * (lane & 15);
                const f32x4 y = unpk4(*(const GAS v2u*)yp) + unpk4(*(const GAS v2u*)(yp + (size_t)16 * NLAT * 64));
                const float mu = row16_sum((y.x + y.y) + (y.z + y.w)) * (1.0f / 64.0f);
                const f32x4 d = y - mu;
                const float var = row16_sum((d.x * d.x + d.y * d.y) + (d.z * d.z + d.w * d.w)) * (1.0f / 64.0f);
                const float rs = 1.0f / sqrtf(var + 64e-5f);
                const f32x4 vv = unpk4(*(const GAS v2u*)(ZC + ((size_t)(4 * q + (lane >> 4)) * MROWS + row) * 192 + 128 + 4 * (lane & 15))), gt = unpk4(*(const GAS v2u*)(EA + (size_t)row * NLORA + 4096 + c0));
                const float bsc = BS[(size_t)row * 16 + 4 * q + (lane >> 4)];
                const f32x4 o = (d * rs * lg + lb + bsc * vv) * gt;
                *(GAS unsigned*)(A2 + (size_t)row * D + 1024 + c0) = pg8::pk4_fp8(4.0f * o.x, 4.0f * o.y, 4.0f * o.z, 4.0f * o.w); }
        }
    }
}

__device__ __forceinline__ void p9_router(Frame& F) {
    const int lane = F.lane, rw = lane & 15, q = lane >> 4, wave = F.wave;
    const bf16* X1 = wsp<bf16>(F, WS_X1B); const float* MT = wsp<float>(F, WS_MODT); unsigned char* H2 = wsp<unsigned char>(F, WS_H2); const bf16* Wr = wsp<bf16>(F, WS_WR);
    int* TOKE = wsp<int>(F, WS_TOKE); float* TOKG = wsp<float>(F, WS_TOKG); int* WCNT = wsp<int>(F, WS_WCNT); int* BCNT = wsp<int>(F, WS_BCNT);
    LAS float* lg = (LAS float*)(F.lds + wave * 2048);
    LAS int* wc = (LAS int*)(F.lds + 16384 + wave * 128);
    {
        const int gw = F.bid * 8 + wave, tok0 = gw * 16, token = tok0 + rw, b = token / SEQ;
        const bf16* xr = X1 + (size_t)token * D + 8 * q;
        float ss = 0.f;
        { const float* sp = wsp<float>(F, WS_SSQ) + (size_t)token * 64 + 16 * q;
#pragma unroll
            for (int i = 0; i < 4; ++i) { const f32x4 a = *(const GAS f32x4*)(sp + 4 * i); ss += (a.x + a.y) + (a.z + a.w); } }
        ss += __shfl_xor(ss, 16); ss += __shfl_xor(ss, 32);
        const float rstd = 1.0f / sqrtf(ss * (1.0f / D) + 1e-6f);
        LAS float* TB = (LAS float*)(F.lds + 32768);
#pragma unroll
        for (int k = 0; k < 2; ++k) { const int idx = F.tid + 512 * k; *(LAS f32x4*)(TB + 4 * idx) = *(const GAS f32x4*)(MT + (size_t)b * 6144 + 4 * idx); }
        __syncthreads();
        f32x4 acc[2] = {(f32x4){0.f, 0.f, 0.f, 0.f}, (f32x4){0.f, 0.f, 0.f, 0.f}};
        v4u X0, X1r, X2, X3; bf16x8 W0[4], W1[4], W2[4], W3[4];
#define RT_LDX(buf, ks_) do { buf = *(const GAS v4u*)(xr + 32 * (ks_)); } while (0)
#define RT_LDW(buf, ks_) do { _Pragma("unroll") for (int nb = 0; nb < 2; ++nb) { const bf16* wp = Wr + (size_t)(16 * nb + rw) * D + 32 * (ks_) + 8 * q; \
            buf[2 * nb] = *(const GAS bf16x8*)wp; buf[2 * nb + 1] = *(const GAS bf16x8*)(wp + 32 * D); } } while (0)
#define RT_STEP(xc, xn, wcur, wnx, ks_) do { const int ks = (ks_); { RT_LDW(wnx, (ks + 3) & 63); RT_LDX(xn, (ks + 3) & 63); } \
            const LAS float* tp = TB + 32 * ks + 8 * q; \
            const f32x4 ma = *(const LAS f32x4*)tp, mb = *(const LAS f32x4*)(tp + 4), sa = *(const LAS f32x4*)(tp + 2048), sb = *(const LAS f32x4*)(tp + 2052); \
            const f32x4 xa = (f32x4){bflo(xc.x), bfhi(xc.x), bflo(xc.y), bfhi(xc.y)}, xb = (f32x4){bflo(xc.z), bfhi(xc.z), bflo(xc.w), bfhi(xc.w)}; \
            const f32x4 ha = xa * rstd * ma + sa, hb = xb * rstd * mb + sb; \
            const float hv[8] = {ha.x, ha.y, ha.z, ha.w, hb.x, hb.y, hb.z, hb.w}; \
            unsigned ph[4], pl[4]; \
            _Pragma("unroll") for (int p_ = 0; p_ < 4; ++p_) { ph[p_] = pk2(hv[2 * p_], hv[2 * p_ + 1]); \
                pl[p_] = pk2(hv[2 * p_] - __builtin_bit_cast(float, ph[p_] << 16), hv[2 * p_ + 1] - __builtin_bit_cast(float, ph[p_] & 0xffff0000u)); } \
            { v2u h8; h8.x = pg8::pk4_fp8(hv[0], hv[1], hv[2], hv[3]); h8.y = pg8::pk4_fp8(hv[4], hv[5], hv[6], hv[7]); *(GAS v2u*)(H2 + (size_t)token * D + 32 * ks + 8 * q) = h8; } \
            const bf16x8 Ah = __builtin_bit_cast(bf16x8, (v4u){ph[0], ph[1], ph[2], ph[3]}), Al = __builtin_bit_cast(bf16x8, (v4u){pl[0], pl[1], pl[2], pl[3]}); \
            _Pragma("unroll") for (int nb = 0; nb < 2; ++nb) { \
                acc[nb] = __builtin_amdgcn_mfma_f32_16x16x32_bf16(Ah, wcur[2 * nb], acc[nb], 0, 0, 0); \
                acc[nb] = __builtin_amdgcn_mfma_f32_16x16x32_bf16(Ah, wcur[2 * nb + 1], acc[nb], 0, 0, 0); \
                acc[nb] = __builtin_amdgcn_mfma_f32_16x16x32_bf16(Al, wcur[2 * nb], acc[nb], 0, 0, 0); } } while (0)
        RT_LDW(W0, 0); RT_LDX(X0, 0); RT_LDW(W1, 1); RT_LDX(X1r, 1); RT_LDW(W2, 2); RT_LDX(X2, 2);
        for (int ks4 = 0; ks4 < 64; ks4 += 4) { RT_STEP(X0, X3, W0, W3, ks4); RT_STEP(X1r, X0, W1, W0, ks4 + 1); RT_STEP(X2, X1r, W2, W1, ks4 + 2); RT_STEP(X3, X2, W3, W2, ks4 + 3); }
#undef RT_LDX
#undef RT_LDW
#undef RT_STEP
#pragma unroll
        for (int nb = 0; nb < 2; ++nb) { const float rb = F.in[I_ROUTB][16 * nb + rw];
#pragma unroll
            for (int j = 0; j < 4; ++j) lg[(4 * q + j) * 32 + 16 * nb + rw] = acc[nb][j] + rb; }
        if (lane < 32) wc[lane] = 0;
        LDS_WAIT(); asm volatile("" ::: "memory");
        if (lane < 16) {
            float lv[32];
#pragma unroll
            for (int e4 = 0; e4 < 8; ++e4) { const f32x4 t = *(const LAS f32x4*)(lg + lane * 32 + 4 * e4); lv[4 * e4] = t.x; lv[4 * e4 + 1] = t.y; lv[4 * e4 + 2] = t.z; lv[4 * e4 + 3] = t.w; }
            int sel[4]; float sv[4];
#pragma unroll
            for (int k = 0; k < 4; ++k) { float best = -3.0e38f; int bi = 0;
#pragma unroll
                for (int e = 0; e < 32; ++e) { bool taken = false;
#pragma unroll
                    for (int kk = 0; kk < k; ++kk) taken = taken || (sel[kk] == e);
                    if (!taken && lv[e] > best) { best = lv[e]; bi = e; } }
                sel[k] = bi; sv[k] = best; }
            const float e1 = __expf(sv[1] - sv[0]), e2 = __expf(sv[2] - sv[0]), e3 = __expf(sv[3] - sv[0]), inv = 1.0f / (1.0f + e1 + e2 + e3);
            const int tk = tok0 + lane;
            *(GAS v4u*)(TOKE + (size_t)tk * 4) = (v4u){(unsigned)sel[0], (unsigned)sel[1], (unsigned)sel[2], (unsigned)sel[3]};
            *(GAS f32x4*)(TOKG + (size_t)tk * 4) = (f32x4){inv, e1 * inv, e2 * inv, e3 * inv};
#pragma unroll
            for (int k = 0; k < 4; ++k) __hip_atomic_fetch_add(&wc[sel[k]], 1, __ATOMIC_RELAXED, __HIP_MEMORY_SCOPE_WORKGROUP);
        }
        LDS_WAIT(); asm volatile("" ::: "memory");
        if (lane < 32) WCNT[(size_t)gw * 32 + lane] = wc[lane];
        __syncthreads();
        if (wave == 0 && lane < 32) { int s = 0;
#pragma unroll
            for (int w = 0; w < 8; ++w) s += ((LAS int*)(F.lds + 16384 + w * 128))[lane];
            BCNT[F.bid * 32 + lane] = s; }
        __syncthreads();
    }
}

__device__ __forceinline__ void p10_sort(Frame& F) {
    const int lane = F.lane, wave = F.wave, gw = F.bid * 8 + wave;
    const int* TOKE = wsp<int>(F, WS_TOKE); const float* TOKG = wsp<float>(F, WS_TOKG); const int* WCNT = wsp<int>(F, WS_WCNT); const int* BCNT = wsp<int>(F, WS_BCNT);
    int* ETAB = wsp<int>(F, WS_ETAB); int* ROWTOK = wsp<int>(F, WS_ROWTOK); int* ROWDST = wsp<int>(F, WS_ROWDST); float* ROWGATE = wsp<float>(F, WS_ROWGATE);
    const int e = lane & 31, half = lane >> 5;
    int tot = 0, pre = 0;
#pragma unroll 32
    for (int bb = half; bb < 256; bb += 2) { const int c = BCNT[bb * 32 + e]; tot += c; pre += (bb < F.bid) ? c : 0; }
    tot += __shfl_xor(tot, 32); pre += __shfl_xor(pre, 32);
    { int wcn[7];
#pragma unroll
        for (int w = 0; w < 7; ++w) wcn[w] = WCNT[(size_t)(F.bid * 8 + w) * 32 + e];
#pragma unroll
        for (int w = 0; w < 7; ++w) pre += (w < wave) ? wcn[w] : 0; }
    const int padded = ((tot + 255) / 256) * 256;
    int incl = padded;
#pragma unroll
    for (int o = 1; o < 32; o <<= 1) { const int t = __shfl_up(incl, o, 32); if (e >= o) incl += t; }
    const int pstart = incl - padded;
    if (F.bid == 0) {
        LAS int* tb = (LAS int*)F.lds;
        if (wave == 0 && lane < 32) { ETAB[e] = pstart; ETAB[64 + e] = tot; tb[e] = pstart; tb[32 + e] = padded; if (e == 31) { ETAB[32] = incl; ETAB[128] = incl / 256; } }
        __syncthreads();
        for (int t = F.tid; t < MAXTILES; t += 512) { int te = 0;
#pragma unroll 8
            for (int x = 0; x < 32; ++x) { const int ps = tb[x], pd = tb[32 + x]; if (t * 256 >= ps && t * 256 < ps + pd) te = x; }
            ETAB[256 + t] = te; }
    }
    const int token = 16 * gw + (lane >> 2), slot = lane & 3;
    const int me = TOKE[(size_t)token * 4 + slot]; const float mg = TOKG[(size_t)token * 4 + slot];
    int rank = 0;
    for (int x = 0; x < 32; ++x) { const unsigned long long m = __ballot(me == x); if (me == x) rank = __popcll(m & ((1ull << lane) - 1ull)); }
    const int row = __shfl(pstart, me) + __shfl(pre, me) + rank;
    ROWTOK[row] = token; ROWDST[row] = token * 4 + slot; ROWGATE[row] = mg;
}

__device__ __forceinline__ void p13_final(Frame& F) {
    const int gw = F.bid * 8 + F.wave, NGW = F.G * 8, lane = F.lane;
    const float* MT = wsp<float>(F, WS_MODT); const unsigned char* SLOT = wsp<unsigned char>(F, WS_SLOT);
    for (int row = gw; row < NLAT; row += NGW) {
        int l4 = 4 * lane; asm volatile("" : "+v"(l4));
        const int b = row / SEQ; float* xr = F.out + (size_t)row * D; const bf16* x1r = wsp<bf16>(F, WS_X1B) + (size_t)row * D;
        f32x4 v[8]; float ss = 0.f;
#pragma unroll
        for (int j = 0; j < 8; ++j) { const int c = l4 + 256 * j;
            f32x4 m = (f32x4){0.f, 0.f, 0.f, 0.f};
#pragma unroll
            for (int s = 0; s < 4; ++s) { const int w8 = *(const GAS int*)(SLOT + ((size_t)row * 4 + s) * D + c); const f32x2 lo = __builtin_amdgcn_cvt_pk_f32_fp8(w8, false), hi = __builtin_amdgcn_cvt_pk_f32_fp8(w8, true); m += (f32x4){lo.x, lo.y, hi.x, hi.y}; }
            const f32x4 g5 = *(const GAS f32x4*)(MT + (size_t)b * 6144 + 4096 + c);
            v[j] = unpk4(*(const GAS v2u*)(x1r + c)) + g5 * m * (1.0f / 16.0f);
            ss += (v[j].x * v[j].x + v[j].y * v[j].y) + (v[j].z * v[j].z + v[j].w * v[j].w); }
        const float rstd = 1.0f / sqrtf(wave_sum(ss) * (1.0f / D) + 1e-6f);
#pragma unroll
        for (int j = 0; j < 8; ++j) *(GAS f32x4*)(xr + l4 + 256 * j) = v[j] * rstd * *(const GAS f32x4*)(F.in[I_FING] + l4 + 256 * j);
    }
}

constexpr int NPH = 13;
__global__ void __launch_bounds__(512, 2) mk_fwd(Args args) {
    extern __shared__ __attribute__((aligned(16))) unsigned char lds_raw[];
    Frame F;
    F.lds = (LAS unsigned char*)lds_raw; F.in = args.in; F.out = args.out; F.ws = args.ws;
    F.tid = threadIdx.x; F.lane = F.tid & 63; F.wave = __builtin_amdgcn_readfirstlane(F.tid >> 6); F.G = gridDim.x; F.bid = blockIdx.x;
    volatile LAS unsigned* MISC = (volatile LAS unsigned*)(F.lds + MISC_OFF);
    if (F.tid < 32) MISC[F.tid] = 0u;
    __syncthreads();
    const int lo = args.ph_lo, hi = args.ph_hi;
    unsigned* ctl = (unsigned*)(F.ws + WS_CTL);
    XcdBarrier bar; bar.bar = ctl + CW_BAR; bar.x = 0; bar.st = nullptr;
    if (hi - lo > 1) bar = xcd_barrier_post(ctl + CW_BAR, MISC + 8);
#ifndef PH_MASK
#define PH_MASK 0x1FFF
#endif
#define IN(k) (((PH_MASK >> (k)) & 1) && lo <= (k) && (k) < hi)
#ifndef REP_PH
#define REP_PH -1
#endif
#define SEAM(k) do { if (IN(k) && IN((k) + 1)) xcd_barrier(bar); } while (0)

    if (IN(0)) { p0_adaln(F); p0_small_weights(F); p0_filter(F); }
    if (REP_PH == 0 && IN(0)) { p0_adaln(F); p0_small_weights(F); p0_filter(F); }
    if (REP_PH == 100 && IN(0)) { p0_adaln(F); }
    if (REP_PH == 101 && IN(0)) { p0_small_weights(F); }
    if (REP_PH == 102 && IN(0)) { p0_filter(F); }
    SEAM(0);
#define PHBODY_1  p1_norm1(F); p1_filter_out(F);
    if (IN(1)) { PHBODY_1 }
    if (REP_PH == 1 && IN(1)) { PHBODY_1 }
    SEAM(1);
#define PHBODY_2     \
        pg8::Gemm g{wsp<bf16>(F, WS_A1), wsp<bf16>(F, WS_BTIN), D, 0, D, D}; \
        pg8::InProjOrder S{F.G, F.bid}; \
        pg8::EpiInProj E{wsp<bf16>(F, WS_Z), wsp<bf16>(F, WS_AP)}; \
        pg8::gemm_phase<false, false>(F.lds, g, S, E); \

    if (IN(2)) { PHBODY_2 }
    if (REP_PH == 2 && IN(2)) { PHBODY_2 }
    SEAM(2);
#define PHBODY_3     \
        { pg8::Gemm g{wsp<bf16>(F, WS_AP), wsp<bf16>(F, WS_BTL), 256, 0, KLORA, KLORA}; \
          pg8::StaticOrder S; S.init(MROWS, 4096, F.G, F.bid); \
          pg8::EpiLora E{wsp<bf16>(F, WS_EA), F.in[I_RW0], F.in[I_RA0], 0}; \
          pg8::gemm_phase<false, false>(F.lds, g, S, E); } \
        { pg8::Gemm g{wsp<bf16>(F, WS_AP) + 256, wsp<bf16>(F, WS_BTL) + (size_t)4096 * KLORA + 256, 256, 0, KLORA, KLORA}; \
          pg8::StaticOrder S; S.init(NLAT, 1024, F.G, F.bid); \
          pg8::EpiLora E{wsp<bf16>(F, WS_EA), F.in[I_RW0], F.in[I_RA0], 16}; \
          pg8::gemm_phase<false, false>(F.lds, g, S, E); } \

    if (IN(3)) { PHBODY_3 }
    if (REP_PH == 3 && IN(3)) { PHBODY_3 }
    SEAM(3);
#define PHBODY_4  p4_prep(F);
    if (IN(4)) { PHBODY_4 }
    if (REP_PH == 4 && IN(4)) { PHBODY_4 }
    SEAM(4);
#define PHBODY_5  p5_scan(F); p6_hyena(F);
    if (IN(5)) { PHBODY_5 }
    if (REP_PH == 5 && IN(5)) { PHBODY_5 }
    if (REP_PH == 50 && IN(5)) { p5_scan(F); }
    if (REP_PH == 51 && IN(5)) { p6_hyena(F); }
    SEAM(5);
#define PHBODY_6  p7_assemble(F);
    if (IN(6)) { PHBODY_6 }
    if (REP_PH == 6 && IN(6)) { PHBODY_6 }
    SEAM(6);
#define PHBODY_7     \
        pg8::Gemm g{wsp<bf16>(F, WS_A2), wsp<bf16>(F, WS_BTOUT), D / 2, 0, D / 2, D / 2}; \
        pg8::StaticOrder S; S.init(NLAT, D, F.G, F.bid); \
        pg8::EpiOutProj E{F.in[I_X], wsp<bf16>(F, WS_X1B), wsp<float>(F, WS_MODACC), F.in[I_ADAB], wsp<float>(F, WS_SSQ)}; \
        pg8::gemm_phase<false, true>(F.lds, g, S, E); \

    if (IN(7)) { PHBODY_7 }
    if (REP_PH == 7 && IN(7)) { PHBODY_7 }
    SEAM(7);
#define PHBODY_8  p9_router(F);
    if (IN(8)) { PHBODY_8 }
    if (REP_PH == 8 && IN(8)) { PHBODY_8 }
    SEAM(8);
#define PHBODY_9  p10_sort(F);
    if (IN(9)) { PHBODY_9 }
    if (REP_PH == 9 && IN(9)) { PHBODY_9 }
    SEAM(9);
#define PHBODY_10    \
        const int* ET = wsp<int>(F, WS_ETAB); \
        pg8::Gemm g{wsp<bf16>(F, WS_H2), wsp<bf16>(F, WS_BTGU), D / 2, (size_t)4096 * D, D / 2, D / 2}; \
        pg8::MoeOrder S{F.G, F.bid, 16, ET[128], F.ws}; \
        pg8::EpiSwiglu E{F.ws, F.in[I_EBG], F.in[I_EBU]}; \
        pg8::gemm_phase<true, true>(F.lds, g, S, E); \

    if (IN(10)) { PHBODY_10 }
    if (REP_PH == 10 && IN(10)) { PHBODY_10 }
#ifdef SHADOW10
    if (IN(10)) { const int* ET = wsp<int>(F, WS_ETAB); pg8::Gemm g{wsp<bf16>(F, WS_H2), wsp<bf16>(F, WS_BTGU), D / 2, (size_t)4096 * D, D / 2, D / 2};
        pg8::MoeOrderT<SHADOW10 == 1> S{F.G, F.bid, 16, ET[128], F.ws}; pg8::EpiSwigluT<(SHADOW10 == 1 ? 1 : 2)> E{F.ws, F.in[I_EBG], F.in[I_EBU]};
        pg8::gemm_phase<true, true>(F.lds, g, S, E); }
#endif
    SEAM(10);
#define PHBODY_11    \
        const int* ET = wsp<int>(F, WS_ETAB); \
        pg8::Gemm g{wsp<bf16>(F, WS_ACT), wsp<bf16>(F, WS_BTD), D / 2, (size_t)D * D, D / 2, D / 2}; \
        pg8::MoeOrder S{F.G, F.bid, 8, ET[128], F.ws}; \
        pg8::EpiDown E{F.ws, F.in[I_EBD]}; \
        pg8::gemm_phase<false, true>(F.lds, g, S, E); \

    if (IN(11)) { PHBODY_11 }
    if (REP_PH == 11 && IN(11)) { PHBODY_11 }
    SEAM(11);
    if (IN(12)) { p13_final(F); }
#undef IN
#undef SEAM
}

extern "C" void kernel_launch(void* const* d_in, const int* in_sizes, int n_in, void* d_out, int out_size, void* d_ws, size_t ws_size, hipStream_t stream) {
    static int grid = 0;
    if (grid == 0) {
        if (n_in != 44 || out_size != NLAT * D || ws_size < WS_END) { fprintf(stderr, "kernel_launch: unexpected problem (n_in %d, out %d, ws %zu)\n", n_in, out_size, ws_size); grid = -1; return; }
        if (hipFuncSetAttribute((const void*)mk_fwd, hipFuncAttributeMaxDynamicSharedMemorySize, LDS_BYTES) != hipSuccess) { fprintf(stderr, "kernel_launch: hipFuncSetAttribute failed\n"); grid = -1; return; }
        int per_cu = 0;
        if (hipOccupancyMaxActiveBlocksPerMultiprocessor(&per_cu, (const void*)mk_fwd, 512, LDS_BYTES) != hipSuccess || per_cu < 1) fprintf(stderr, "kernel_launch: occupancy query says %d blocks per CU\n", per_cu);
        (void)hipGetLastError();
        grid = 256;
    }
    if (grid < 0) return;
    (void)hipMemsetAsync((char*)d_ws + WS_CTL, 0, CTL_ZERO_BYTES, stream);
    Args a{};
    for (int i = 0; i < 44; ++i) a.in[i] = (const float*)d_in[i];
    a.out = (float*)d_out; a.ws = (unsigned char*)d_ws;
#if MK_PER_PHASE
    for (int ph = 0; ph < NPH; ++ph) { a.ph_lo = ph; a.ph_hi = ph + 1; hipLaunchKernelGGL(mk_fwd, dim3(grid), dim3(512), LDS_BYTES, stream, a); }
#else
    a.ph_lo = 0; a.ph_hi = NPH;
    hipLaunchKernelGGL(mk_fwd, dim3(grid), dim3(512), LDS_BYTES, stream, a);
#endif
    const hipError_t le = hipPeekAtLastError();
    if (le != hipSuccess) fprintf(stderr, "kernel_launch: launch failed: %s\n", hipGetErrorName(le));
}
```
